# Optimizing an MI355X kernel written in HIP

```python
import math
import jax, jax.numpy as jnp
from jax import lax
import numpy as np

D_MODEL = 1024
BATCH = 16
SEQ = 2048
DEPTH = 2

CTX_LEN = 256
GRID_W = 64
CHUNK = 128
ROWS_PER_CHUNK = CHUNK // GRID_W
EPS = 1e-6

SSD_HEAD_DIM = 64
SSD_HEADS = D_MODEL // SSD_HEAD_DIM
SSD_WIDTH = SSD_HEADS * SSD_HEAD_DIM
SSD_GROUPS = 4
SSD_STATE = 128
SSD_CONV = 3
DT_MIN = 0.001
DT_MAX = 0.1
GN = SSD_GROUPS * SSD_STATE
N_XBC = SSD_WIDTH + 2 * GN
N_SCAN = N_XBC + 2 * SSD_HEADS

MLP_WIDTH = D_MODEL
MLP_GROUP_DIM = 128
MLP_GROUPS = MLP_WIDTH // MLP_GROUP_DIM

N_IN = N_SCAN + SSD_WIDTH + 2 * MLP_WIDTH + 2 * D_MODEL

N_EXPERTS = 16
EXPERT_FF = D_MODEL
CAPACITY_FACTOR = 2

kernel_name = 'hybrid_ssd_gmlp_ecmoe_dit_prefix'


def split_cols(p, sizes):
    idx = np.cumsum(sizes)[:-1].tolist()
    return jnp.split(p, idx, axis=-1)


def rmsnorm(x, w):
    xf = x.astype(jnp.float32)
    y = xf * lax.rsqrt(jnp.mean(xf * xf, axis=-1, keepdims=True) + EPS)
    return (y * w.astype(jnp.float32)).astype(x.dtype)


def layernorm(x, w, b):
    xf = x.astype(jnp.float32)
    mu = jnp.mean(xf, axis=-1, keepdims=True)
    var = jnp.mean(jnp.square(xf - mu), axis=-1, keepdims=True)
    y = (xf - mu) * lax.rsqrt(var + EPS)
    return (y * w.astype(jnp.float32) + b.astype(jnp.float32)).astype(x.dtype)


def dwconv_centred(x, w, b):
    ch = x.shape[-1]
    k = w.shape[0]
    y = lax.conv_general_dilated(x, w[:, None, :].astype(x.dtype), window_strides=(1,),
                                 padding=[(k // 2, k // 2)],
                                 dimension_numbers=('NWC', 'WIO', 'NWC'),
                                 feature_group_count=ch)
    return y + b.astype(x.dtype)


def ssd_chunked(xh, dt, A, bm, cm, h0):
    b, l, H, P = xh.shape
    G, N = bm.shape[2], bm.shape[3]
    R = H // G
    nc = l // CHUNK
    x = xh.reshape(b, nc, CHUNK, G, R, P)
    dt_c = dt.reshape(b, nc, CHUNK, G, R)
    a_cum = jnp.cumsum(dt_c * A.reshape(G, R), axis=2)
    Bc = bm.reshape(b, nc, CHUNK, G, N)
    Cc = cm.reshape(b, nc, CHUNK, G, N)
    xdt = x * dt_c[..., None].astype(x.dtype)
    lower = jnp.tril(jnp.ones((CHUNK, CHUNK), dtype=bool))[None, None, :, :, None, None]
    seg = a_cum[:, :, :, None] - a_cum[:, :, None, :]
    decay = jnp.exp(jnp.where(lower, seg, -jnp.inf))
    cb = jnp.einsum('bcign,bcjgn->bcijg', Cc, Bc)
    y_diag = jnp.einsum('bcijg,bcijgr,bcjgrp->bcigrp', cb, decay, xdt)
    decay_to_end = jnp.exp(a_cum[:, :, -1:] - a_cum)
    states = jnp.einsum('bcjgn,bcjgr,bcjgrp->bcgrpn', Bc, decay_to_end, xdt)
    chunk_decay = jnp.exp(a_cum[:, :, -1])

    def step(h, inp):
        st, dcy = inp
        return h * dcy[..., None, None] + st, h

    h_final, h_in = lax.scan(step, h0, (jnp.moveaxis(states, 1, 0).astype(jnp.float32),
                                        jnp.moveaxis(chunk_decay, 1, 0)))
    y_off = jnp.einsum('bcign,bcigr,cbgrpn->bcigrp', Cc, jnp.exp(a_cum), h_in)
    y = (y_diag + y_off).reshape(b, l, H, P).astype(xh.dtype)
    return y, h_final


def ssd_scan_bidir(p_scan, conv_w, conv_b, dt_bias, a_log, h0_f, h0_b):
    xbc, dt_raw = p_scan[..., :N_XBC], p_scan[..., N_XBC:]
    xbc = jax.nn.silu(dwconv_centred(xbc, conv_w, conv_b))
    xs, bm, cm = split_cols(xbc, [SSD_WIDTH, GN, GN])
    b, l, _ = xs.shape
    xh = xs.reshape(b, l, SSD_HEADS, SSD_HEAD_DIM)
    bm = bm.reshape(b, l, SSD_GROUPS, SSD_STATE)
    cm = cm.reshape(b, l, SSD_GROUPS, SSD_STATE)
    dt = jax.nn.softplus(dt_raw.astype(jnp.float32).reshape(b, l, 2, SSD_HEADS)
                         + dt_bias.astype(jnp.float32))
    A = -jnp.exp(a_log.astype(jnp.float32))
    y_f, st_f = ssd_chunked(xh, dt[:, :, 0], A[0], bm, cm, h0_f)
    rev = lambda t: jnp.flip(t, axis=1)
    y_b, st_b = ssd_chunked(rev(xh), rev(dt[:, :, 1]), A[1], rev(bm), rev(cm), h0_b)
    return y_f + rev(y_b), xh, st_f, st_b


def ssd_output(y, xh, z, d_skip, norm_w):
    b, l, H, P = xh.shape
    y = y + d_skip.astype(xh.dtype)[:, None] * xh
    g = y.reshape(b, l, SSD_WIDTH) * jax.nn.silu(z)
    g = rmsnorm(g.reshape(b, l, SSD_GROUPS, SSD_WIDTH // SSD_GROUPS),
                norm_w.reshape(SSD_GROUPS, SSD_WIDTH // SSD_GROUPS))
    return g.reshape(b, l, SSD_WIDTH)


def spatial_gating(u, v, n_chunks, ln_w, ln_b, w_s, b_s):
    b, l, _ = v.shape
    v = layernorm(v, ln_w, ln_b)
    vc = v.reshape(b, n_chunks, CHUNK, MLP_GROUPS, MLP_GROUP_DIM)
    mixed = jnp.einsum('gij,bcjgd->bcigd', w_s, vc) + b_s.T[None, None, :, :, None]
    return u * mixed.reshape(b, l, MLP_WIDTH)


def mixer_out(y, xh, p_rest, n_chunks, d_skip, ssd_norm_w, ln_w, ln_b, w_s, b_s, w_pa, w_pb, w_o):
    z, uv, gate_a, gate_b = split_cols(p_rest, [SSD_WIDTH, 2 * MLP_WIDTH, D_MODEL, D_MODEL])
    ssd = ssd_output(y, xh, z, d_skip, ssd_norm_w)
    u, v = jnp.split(jax.nn.gelu(uv), 2, axis=-1)
    sgu = spatial_gating(u, v, n_chunks, ln_w, ln_b, w_s, b_s)
    merged = jax.nn.sigmoid(gate_a) * (ssd @ w_pa) + jax.nn.sigmoid(gate_b) * (sgu @ w_pb)
    return merged @ w_o


def expert_choice_ffn(xn, router_w, w_gate, w_up, w_down):
    b, n, d = xn.shape
    cap = CAPACITY_FACTOR * n // N_EXPERTS
    logits = jnp.einsum('bnd,de->ben', xn, router_w).astype(jnp.float32)
    aff = jax.nn.softmax(logits, axis=1)
    gate, idx = lax.top_k(aff, cap)
    xg = jax.vmap(lambda xs, ix: xs[ix])(xn, idx)
    hid = jax.nn.silu(jnp.einsum('becd,edf->becf', xg, w_gate)) * jnp.einsum('becd,edf->becf', xg, w_up)
    y = jnp.einsum('becf,efd->becd', hid, w_down) * gate[..., None].astype(xn.dtype)
    scatter = lambda ix, ys: jnp.zeros((n, d), ys.dtype).at[ix.reshape(-1)].add(ys.reshape(-1, d))
    return jax.vmap(scatter)(idx, y)


def setup_inputs(seed: int = 0) -> dict:
    key = jax.random.key(seed)
    ks = jax.random.split(key, 32)
    f32 = jnp.float32
    L = DEPTH
    nrm = lambda k, shape, s: jax.random.normal(k, shape, f32) * s
    gain = lambda k, shape: 1.0 + 0.01 * jax.random.normal(k, shape, f32)
    dt0 = jnp.exp(jax.random.uniform(ks[12], (L, 2, SSD_HEADS), f32, math.log(DT_MIN), math.log(DT_MAX)))
    return {
        'x': nrm(ks[0], (BATCH, SEQ, D_MODEL), 1.0),
        'c': nrm(ks[1], (BATCH, D_MODEL), 1.0),
        'ctx': nrm(ks[2], (BATCH, CTX_LEN, D_MODEL), 1.0),
        'c_ctx': nrm(ks[3], (D_MODEL,), 1.0),
        'ada_w': nrm(ks[4], (L, D_MODEL, 6 * D_MODEL), 0.5 * D_MODEL ** -0.5),
        'ada_b': nrm(ks[5], (L, 6 * D_MODEL), 0.01),
        'norm1_w': gain(ks[6], (L, D_MODEL)),
        'norm2_w': gain(ks[7], (L, D_MODEL)),
        'w_in': nrm(ks[8], (L, D_MODEL, N_IN), D_MODEL ** -0.5),
        'conv_w': nrm(ks[9], (L, SSD_CONV, N_XBC), SSD_CONV ** -0.5),
        'conv_b': nrm(ks[10], (L, N_XBC), 0.01),
        'dt_bias': dt0 + jnp.log(-jnp.expm1(-dt0)),
        'a_log': jnp.log(jax.random.uniform(ks[13], (L, 2, SSD_HEADS), f32, 1.0, 16.0)),
        'd_skip': gain(ks[14], (L, SSD_HEADS)),
        'ssd_norm_w': gain(ks[15], (L, SSD_WIDTH)),
        'sgu_ln_w': gain(ks[16], (L, MLP_WIDTH)),
        'sgu_ln_b': nrm(ks[17], (L, MLP_WIDTH), 0.01),
        'w_s': nrm(ks[18], (L, MLP_GROUPS, CHUNK, CHUNK), CHUNK ** -0.5),
        'b_s': gain(ks[19], (L, MLP_GROUPS, CHUNK)),
        'w_pa': nrm(ks[20], (L, SSD_WIDTH, D_MODEL), SSD_WIDTH ** -0.5),
        'w_pb': nrm(ks[21], (L, MLP_WIDTH, D_MODEL), MLP_WIDTH ** -0.5),
        'w_o': nrm(ks[22], (L, D_MODEL, D_MODEL), D_MODEL ** -0.5),
        'router_w': nrm(ks[23], (L, D_MODEL, N_EXPERTS), D_MODEL ** -0.5),
        'w_gate': nrm(ks[24], (L, N_EXPERTS, D_MODEL, EXPERT_FF), D_MODEL ** -0.5),
        'w_up': nrm(ks[25], (L, N_EXPERTS, D_MODEL, EXPERT_FF), D_MODEL ** -0.5),
        'w_down': nrm(ks[26], (L, N_EXPERTS, EXPERT_FF, D_MODEL), EXPERT_FF ** -0.5),
        'final_norm_w': gain(ks[27], (D_MODEL,)),
    }


def reference(x, c, ctx, c_ctx, ada_w, ada_b, norm1_w, norm2_w, w_in, conv_w, conv_b, dt_bias, a_log,
              d_skip, ssd_norm_w, sgu_ln_w, sgu_ln_b, w_s, b_s, w_pa, w_pb, w_o, router_w,
              w_gate, w_up, w_down, final_norm_w):
    bsz, n_lat, _ = x.shape
    rows = n_lat // GRID_W
    lat_chunks = rows // ROWS_PER_CHUNK
    ctx_chunks = ctx.shape[1] // CHUNK
    h0 = jnp.zeros((bsz, SSD_GROUPS, SSD_HEADS // SSD_GROUPS, SSD_HEAD_DIM, SSD_STATE), jnp.float32)
    h, hc = x, ctx
    for layer in range(DEPTH):
        last = layer == DEPTH - 1
        mod_l = (jax.nn.silu(c) @ ada_w[layer] + ada_b[layer])[:, None, :]
        mod_c = (jax.nn.silu(c_ctx) @ ada_w[layer] + ada_b[layer])[None, None, :]
        sh1_l, sc1_l, g1_l, sh2_l, sc2_l, g2_l = jnp.split(mod_l, 6, axis=-1)
        sh1_c, sc1_c, g1_c, sh2_c, sc2_c, g2_c = jnp.split(mod_c, 6, axis=-1)
        w_in_l = w_in[layer]
        mix_args = (d_skip[layer], ssd_norm_w[layer], sgu_ln_w[layer], sgu_ln_b[layer],
                    w_s[layer], b_s[layer], w_pa[layer], w_pb[layer], w_o[layer])
        xm_c = rmsnorm(hc, norm1_w[layer]) * (1 + sc1_c) + sh1_c
        xm_l = rmsnorm(h, norm1_w[layer]) * (1 + sc1_l) + sh1_l
        y_c, xh_c, st_f, st_b = ssd_scan_bidir(xm_c @ w_in_l[:, :N_SCAN], conv_w[layer], conv_b[layer],
                                               dt_bias[layer], a_log[layer], h0, h0)
        p_l = xm_l @ w_in_l
        y_l, xh_l, _, _ = ssd_scan_bidir(p_l[..., :N_SCAN], conv_w[layer], conv_b[layer],
                                         dt_bias[layer], a_log[layer], st_f, st_b)
        h = h + g1_l * mixer_out(y_l, xh_l, p_l[..., N_SCAN:], lat_chunks, *mix_args)
        if not last:
            hc = hc + g1_c * mixer_out(y_c, xh_c, xm_c @ w_in_l[:, N_SCAN:], ctx_chunks, *mix_args)
        moe_args = (router_w[layer], w_gate[layer], w_up[layer], w_down[layer])
        xf_l = rmsnorm(h, norm2_w[layer]) * (1 + sc2_l) + sh2_l
        h = h + g2_l * expert_choice_ffn(xf_l, *moe_args)
        if not last:
            xf_c = rmsnorm(hc, norm2_w[layer]) * (1 + sc2_c) + sh2_c
            hc = hc + g2_c * expert_choice_ffn(xf_c, *moe_args)
    return rmsnorm(h, final_norm_w)
```

```cpp
#include <hip/hip_runtime.h>
#include <cstdio>
#include <cstdint>

#define GAS __attribute__((address_space(1)))
#define LAS __attribute__((address_space(3)))
typedef unsigned short bf16;
typedef unsigned v4u __attribute__((ext_vector_type(4)));
typedef unsigned v2u __attribute__((ext_vector_type(2)));
typedef float f32x4 __attribute__((ext_vector_type(4)));
typedef float f32x2 __attribute__((ext_vector_type(2)));
typedef short bf16x8 __attribute__((ext_vector_type(8)));

constexpr int D = 1024, NB = 16, SEQ = 2048, CTXL = 256, NLAT = NB * SEQ, NCTX = NB * CTXL, NROW = NLAT + NCTX;
constexpr int HEADS = 16, HD = 64, NST = 128, NIN = 7200;
constexpr int NEXP = 16, CAP_L = 256, CAP_C = 32;
constexpr float EPS = 1e-6f;
constexpr int PW = 7168, PX = 0, PB = 1024, PC = 1536, PZ = 2048, PU = 3072, PV = 4096, PGA = 5120, PGB = 6144;
constexpr int WIN_ROWS = 7424;
constexpr int NLIST = NB * NEXP * CAP_L + NEXP * NB * CAP_C;
constexpr int LIST_C0 = NB * NEXP * CAP_L;

constexpr size_t MiB = 1u << 20;
constexpr size_t WS_CTL = 0, CTL_ZERO_BYTES = 1 * MiB;
constexpr size_t WS_MOD = 1 * MiB;
constexpr size_t WS_WST = 2 * MiB;
constexpr size_t WS_DT = 3 * MiB;
constexpr size_t WS_AFF = 8 * MiB;
constexpr size_t WS_INV = 11 * MiB;
constexpr size_t WS_IDX = 14 * MiB;
constexpr size_t WS_GATE = 14 * MiB + 512 * 1024;
constexpr size_t WS_WIN = 16 * MiB;
constexpr size_t WS_WMIX = 45 * MiB;
constexpr size_t WS_HC = 57 * MiB;
constexpr size_t WS_XM = 73 * MiB;
constexpr size_t WS_P = 145 * MiB;
constexpr size_t WS_END = 649 * MiB;
constexpr size_t PO_WGU = 0, PO_WD = 64 * MiB, PO_HID = 96 * MiB, PO_YM = 240 * MiB;

__device__ __forceinline__ unsigned f2bf(float f) { unsigned u = __builtin_bit_cast(unsigned, f); return (u + 0x7fffu + ((u >> 16) & 1u)) >> 16; }
__device__ __forceinline__ unsigned pk2(float lo, float hi) { return f2bf(lo) | (f2bf(hi) << 16); }
__device__ __forceinline__ float bflo(unsigned w) { return __builtin_bit_cast(float, w << 16); }
__device__ __forceinline__ float bfhi(unsigned w) { return __builtin_bit_cast(float, w & 0xffff0000u); }
__device__ __forceinline__ float bf2f(bf16 b) { return __builtin_bit_cast(float, ((unsigned)b) << 16); }
__device__ __forceinline__ float sigmoidf_(float x) { return 1.0f / (1.0f + __expf(-x)); }
__device__ __forceinline__ float siluf_(float x) { return x / (1.0f + __expf(-x)); }
__device__ __forceinline__ float gelu_tanh(float x) { const float u = 1.5957691216057308f * (x + 0.044715f * x * x * x); return x / (1.0f + __expf(-u)); }
__device__ __forceinline__ float softplusf_(float x) { return fmaxf(x, 0.f) + log1pf(__expf(-fabsf(x))); }
__device__ __forceinline__ float wave_sum(float v) {
#pragma unroll
    for (int o = 1; o < 64; o <<= 1) v += __shfl_xor(v, o);
    return v;
}
__device__ __forceinline__ v2u pack4(f32x4 v) { v2u r; r.x = pk2(v.x, v.y); r.y = pk2(v.z, v.w); return r; }
__device__ __forceinline__ f32x4 unpack4(v2u w) { return (f32x4){bflo(w.x), bfhi(w.x), bflo(w.y), bfhi(w.y)}; }

struct Args { const float* in[27]; float* out; unsigned char* ws; int ph_lo, ph_hi; };
enum { I_X = 0, I_C, I_CTX, I_CCTX, I_ADAW, I_ADAB, I_N1W, I_N2W, I_WIN, I_CONVW, I_CONVB, I_DTB, I_ALOG, I_DSKIP, I_SSDNW, I_LNW, I_LNB, I_WS, I_BS, I_WPA, I_WPB, I_WO, I_RW, I_WG, I_WU, I_WD, I_FNW };

struct Frame {
    LAS unsigned char* lds; int tid, lane, wave, nw, G, bid;
    const Args* a;
};
__device__ __forceinline__ const float* modp(const Args& a, int l, int br) { return (const float*)(a.ws + WS_MOD) + (size_t)(l * 17 + br) * 6144; }
__device__ __forceinline__ int batch_row(int r) { return r < NLAT ? (r >> 11) : 16; }

struct Unit { const bf16* A; const bf16* B; const int* gidx; int lda, a_row0, pm, pn, aux; };

struct ProbIn {
    const Args* a; int l;
    __device__ int nunits() const { return l == 0 ? 144 * 29 : 128 * 29 + 16 * 9; }
    __device__ void unit(int L, Unit& u) const {
        int pm, pn;
        const int nfull = (l == 0 ? 144 : 128);
        if (L < nfull * 29) { const int grp = L / (8 * 29), w = L % (8 * 29); pm = grp * 8 + (w & 7); pn = w >> 3; }
        else { const int w = L - nfull * 29; pm = 128 + (w & 15); const int q = w >> 4; pn = q < 8 ? q : 28; }
        u.A = (const bf16*)(a->ws + WS_XM); u.lda = D; u.a_row0 = pm * 256; u.gidx = nullptr; u.pm = pm; u.pn = pn; u.aux = 0;
        u.B = (const bf16*)(a->ws + WS_WIN) + ((size_t)l * WIN_ROWS + (size_t)pn * 256) * D;
    }
    __device__ __forceinline__ void epi(const Unit& u, int r, int c, f32x4 lo0, f32x4 lo1, f32x4 hi0, f32x4 hi1) const {
        const int row = u.pm * 256 + r, pn = u.pn;
        if (pn == 28) {
            if (c < 32) { float* dt = (float*)(a->ws + WS_DT) + (size_t)row * 32 + c; const float* db = a->in[I_DTB] + l * 32 + c;
                f32x4 o0, o1;
#pragma unroll
                for (int i = 0; i < 4; ++i) { o0[i] = softplusf_(lo0[i] + db[i]); o1[i] = softplusf_(lo1[i] + db[4 + i]); }
                *(f32x4*)dt = o0; *(f32x4*)(dt + 4) = o1; }
            return;
        }
        if (pn >= 8 && pn < 12) {
#pragma unroll
            for (int i = 0; i < 4; ++i) { lo0[i] = siluf_(lo0[i]); lo1[i] = siluf_(lo1[i]); hi0[i] = siluf_(hi0[i]); hi1[i] = siluf_(hi1[i]); } }
        else if (pn >= 12 && pn < 20) {
#pragma unroll
            for (int i = 0; i < 4; ++i) { lo0[i] = gelu_tanh(lo0[i]); lo1[i] = gelu_tanh(lo1[i]); hi0[i] = gelu_tanh(hi0[i]); hi1[i] = gelu_tanh(hi1[i]); } }
        else if (pn >= 20) {
#pragma unroll
            for (int i = 0; i < 4; ++i) { lo0[i] = sigmoidf_(lo0[i]); lo1[i] = sigmoidf_(lo1[i]); hi0[i] = sigmoidf_(hi0[i]); hi1[i] = sigmoidf_(hi1[i]); } }
        bf16* o = (bf16*)(a->ws + WS_P) + (size_t)row * PW + pn * 256 + c;
        v4u w; w.x = pk2(lo0[0], lo0[1]); w.y = pk2(lo0[2], lo0[3]); w.z = pk2(lo1[0], lo1[1]); w.w = pk2(lo1[2], lo1[3]); *(v4u*)o = w;
        w.x = pk2(hi0[0], hi0[1]); w.y = pk2(hi0[2], hi0[3]); w.z = pk2(hi1[0], hi1[1]); w.w = pk2(hi1[2], hi1[3]); *(v4u*)(o + 128) = w;
    }
};

template <int MODE> struct ProbMix {
    const Args* a; int l;
    __device__ int nunits() const { return (l == 0 ? 144 : 128) * 4; }
    __device__ void unit(int L, Unit& u) const {
        const int grp = L / 32, w = L % 32; const int pm = grp * 8 + (w & 7), pn = w >> 3;
        u.pm = pm; u.pn = pn; u.aux = 0; u.gidx = nullptr; u.a_row0 = pm * 256;
        if (MODE == 0) { u.A = (const bf16*)(a->ws + WS_P) + PZ; u.lda = PW; }
        else if (MODE == 1) { u.A = (const bf16*)(a->ws + WS_P) + PU; u.lda = PW; }
        else { u.A = (const bf16*)(a->ws + WS_XM); u.lda = D; }
        u.B = (const bf16*)(a->ws + WS_WMIX) + ((size_t)(l * 3 + MODE) * D + (size_t)pn * 256) * D;
    }
    __device__ __forceinline__ void epi(const Unit& u, int r, int c, f32x4 lo0, f32x4 lo1, f32x4 hi0, f32x4 hi1) const {
        const int row = u.pm * 256 + r, col = u.pn * 256 + c;
        if (MODE == 0) {
            bf16* g = (bf16*)(a->ws + WS_P) + (size_t)row * PW + PGA + col;
            v4u gl = *(const v4u*)g, gh = *(const v4u*)(g + 128), w;
            w.x = pk2(bflo(gl.x) * lo0[0], bfhi(gl.x) * lo0[1]); w.y = pk2(bflo(gl.y) * lo0[2], bfhi(gl.y) * lo0[3]); w.z = pk2(bflo(gl.z) * lo1[0], bfhi(gl.z) * lo1[1]); w.w = pk2(bflo(gl.w) * lo1[2], bfhi(gl.w) * lo1[3]); *(v4u*)g = w;
            w.x = pk2(bflo(gh.x) * hi0[0], bfhi(gh.x) * hi0[1]); w.y = pk2(bflo(gh.y) * hi0[2], bfhi(gh.y) * hi0[3]); w.z = pk2(bflo(gh.z) * hi1[0], bfhi(gh.z) * hi1[1]); w.w = pk2(bflo(gh.w) * hi1[2], bfhi(gh.w) * hi1[3]); *(v4u*)(g + 128) = w;
        } else if (MODE == 1) {
            const bf16* t = (const bf16*)(a->ws + WS_P) + (size_t)row * PW + PGA + col; const bf16* g = t + (PGB - PGA);
            bf16* o = (bf16*)(a->ws + WS_XM) + (size_t)row * D + col;
            v4u tl = *(const v4u*)t, th = *(const v4u*)(t + 128), gl = *(const v4u*)g, gh = *(const v4u*)(g + 128), w;
            w.x = pk2(bflo(tl.x) + bflo(gl.x) * lo0[0], bfhi(tl.x) + bfhi(gl.x) * lo0[1]); w.y = pk2(bflo(tl.y) + bflo(gl.y) * lo0[2], bfhi(tl.y) + bfhi(gl.y) * lo0[3]);
            w.z = pk2(bflo(tl.z) + bflo(gl.z) * lo1[0], bfhi(tl.z) + bfhi(gl.z) * lo1[1]); w.w = pk2(bflo(tl.w) + bflo(gl.w) * lo1[2], bfhi(tl.w) + bfhi(gl.w) * lo1[3]); *(v4u*)o = w;
            w.x = pk2(bflo(th.x) + bflo(gh.x) * hi0[0], bfhi(th.x) + bfhi(gh.x) * hi0[1]); w.y = pk2(bflo(th.y) + bflo(gh.y) * hi0[2], bfhi(th.y) + bfhi(gh.y) * hi0[3]);
            w.z = pk2(bflo(th.z) + bflo(gh.z) * hi1[0], bfhi(th.z) + bfhi(gh.z) * hi1[1]); w.w = pk2(bflo(th.w) + bflo(gh.w) * hi1[2], bfhi(th.w) + bfhi(gh.w) * hi1[3]); *(v4u*)(o + 128) = w;
        } else {
            const bool lat = row < NLAT;
            const float* hin = (l == 0) ? (lat ? a->in[I_X] + (size_t)row * D : a->in[I_CTX] + (size_t)(row - NLAT) * D) : (lat ? a->out + (size_t)row * D : (const float*)(a->ws + WS_HC) + (size_t)(row - NLAT) * D);
            float* hout = lat ? a->out + (size_t)row * D : (float*)(a->ws + WS_HC) + (size_t)(row - NLAT) * D;
            const float* g1 = modp(*a, l, batch_row(row)) + 2048 + col;
            hin += col; hout += col;
            *(f32x4*)hout = *(const f32x4*)hin + *(const f32x4*)g1 * lo0; *(f32x4*)(hout + 4) = *(const f32x4*)(hin + 4) + *(const f32x4*)(g1 + 4) * lo1;
            *(f32x4*)(hout + 128) = *(const f32x4*)(hin + 128) + *(const f32x4*)(g1 + 128) * hi0; *(f32x4*)(hout + 132) = *(const f32x4*)(hin + 132) + *(const f32x4*)(g1 + 132) * hi1;
        }
    }
};

template <int MODE> struct ProbMoe {
    const Args* a; int l;
    __device__ int nunits() const { const int per = MODE == 0 ? 8 : 4; return (256 + (l == 0 ? 32 : 0)) * per; }
    __device__ void unit(int L, Unit& u) const {
        constexpr int per = MODE == 0 ? 8 : 4;
        const int pn = L % per, t = L / per;
        const int e = t < 256 ? (t & 15) : ((t - 256) >> 1);
        const int list0 = t < 256 ? t * 256 : LIST_C0 + (t - 256) * 256;
        u.pm = t; u.pn = pn; u.aux = list0;
        if (MODE == 0) { u.A = (const bf16*)(a->ws + WS_XM); u.lda = D; u.a_row0 = 0; u.gidx = (const int*)(a->ws + WS_IDX) + list0;
            u.B = (const bf16*)(a->ws + WS_P + PO_WGU) + ((size_t)e * 2048 + (size_t)pn * 256) * D; }
        else { u.A = (const bf16*)(a->ws + WS_P + PO_HID); u.lda = D; u.a_row0 = list0; u.gidx = nullptr;
            u.B = (const bf16*)(a->ws + WS_P + PO_WD) + ((size_t)e * 1024 + (size_t)pn * 256) * D; }
    }
    __device__ __forceinline__ void epi(const Unit& u, int r, int c, f32x4 lo0, f32x4 lo1, f32x4 hi0, f32x4 hi1) const {
        const size_t hrow = (size_t)u.aux + r;
        if (MODE == 0) {
            bf16* o = (bf16*)(a->ws + WS_P + PO_HID) + hrow * D + u.pn * 128 + c;
            v4u w; w.x = pk2(siluf_(lo0[0]) * hi0[0], siluf_(lo0[1]) * hi0[1]); w.y = pk2(siluf_(lo0[2]) * hi0[2], siluf_(lo0[3]) * hi0[3]);
            w.z = pk2(siluf_(lo1[0]) * hi1[0], siluf_(lo1[1]) * hi1[1]); w.w = pk2(siluf_(lo1[2]) * hi1[2], siluf_(lo1[3]) * hi1[3]); *(v4u*)o = w;
        } else {
            const float gt = ((const float*)(a->ws + WS_GATE))[hrow];
            bf16* o = (bf16*)(a->ws + WS_P + PO_YM) + hrow * D + u.pn * 256 + c;
            v4u w; w.x = pk2(gt * lo0[0], gt * lo0[1]); w.y = pk2(gt * lo0[2], gt * lo0[3]); w.z = pk2(gt * lo1[0], gt * lo1[1]); w.w = pk2(gt * lo1[2], gt * lo1[3]); *(v4u*)o = w;
            w.x = pk2(gt * hi0[0], gt * hi0[1]); w.y = pk2(gt * hi0[2], gt * hi0[3]); w.z = pk2(gt * hi1[0], gt * hi1[1]); w.w = pk2(gt * hi1[2], gt * hi1[3]); *(v4u*)(o + 128) = w;
        }
    }
};

template <class P> __global__ void __launch_bounds__(256) k_gemm_simple(Args args, int layer) {
    __shared__ float As[32][68]; __shared__ float Bs[32][260];
    P prob{&args, layer};
    const int L = blockIdx.x >> 2, rb = blockIdx.x & 3, tid = threadIdx.x, ty = tid >> 4, tx = tid & 15;
    if (L >= prob.nunits()) return;
    Unit u; prob.unit(L, u);
    const int ar = tid >> 2, aq = tid & 3;
    int arow = u.gidx ? u.gidx[rb * 64 + ar] : (u.a_row0 + rb * 64 + ar);
    arow = arow < 0 ? 0 : (arow >= NROW + NLIST ? 0 : arow);
    const bf16* ap = u.A + (size_t)arow * u.lda + aq * 8;
    float acc[2][4][8];
#pragma unroll
    for (int h = 0; h < 2; ++h)
#pragma unroll
        for (int i = 0; i < 4; ++i)
#pragma unroll
            for (int j = 0; j < 8; ++j) acc[h][i][j] = 0.f;
    for (int k0 = 0; k0 < D; k0 += 32) {
        v4u av = *(const v4u*)(ap + k0); v4u bv[4];
#pragma unroll
        for (int j = 0; j < 4; ++j) { const int p = tid + 256 * j; bv[j] = *(const v4u*)(u.B + (size_t)(p >> 2) * D + k0 + (p & 3) * 8); }
        __syncthreads();
        { const int kk = aq * 8; As[kk + 0][ar] = bflo(av.x); As[kk + 1][ar] = bfhi(av.x); As[kk + 2][ar] = bflo(av.y); As[kk + 3][ar] = bfhi(av.y); As[kk + 4][ar] = bflo(av.z); As[kk + 5][ar] = bfhi(av.z); As[kk + 6][ar] = bflo(av.w); As[kk + 7][ar] = bfhi(av.w); }
#pragma unroll
        for (int j = 0; j < 4; ++j) { const int p = tid + 256 * j, br = p >> 2, kk = (p & 3) * 8; Bs[kk + 0][br] = bflo(bv[j].x); Bs[kk + 1][br] = bfhi(bv[j].x); Bs[kk + 2][br] = bflo(bv[j].y); Bs[kk + 3][br] = bfhi(bv[j].y);
            Bs[kk + 4][br] = bflo(bv[j].z); Bs[kk + 5][br] = bfhi(bv[j].z); Bs[kk + 6][br] = bflo(bv[j].w); Bs[kk + 7][br] = bfhi(bv[j].w); }
        __syncthreads();
#pragma unroll 4
        for (int k = 0; k < 32; ++k) {
            const f32x4 a4 = *(const f32x4*)&As[k][ty * 4];
            const f32x4 b0 = *(const f32x4*)&Bs[k][tx * 8], b1 = *(const f32x4*)&Bs[k][tx * 8 + 4], b2 = *(const f32x4*)&Bs[k][128 + tx * 8], b3 = *(const f32x4*)&Bs[k][128 + tx * 8 + 4];
#pragma unroll
            for (int i = 0; i < 4; ++i)
#pragma unroll
                for (int j = 0; j < 4; ++j) { acc[0][i][j] += a4[i] * b0[j]; acc[0][i][4 + j] += a4[i] * b1[j]; acc[1][i][j] += a4[i] * b2[j]; acc[1][i][4 + j] += a4[i] * b3[j]; }
        }
    }
#pragma unroll
    for (int i = 0; i < 4; ++i)
        prob.epi(u, rb * 64 + ty * 4 + i, tx * 8, (f32x4){acc[0][i][0], acc[0][i][1], acc[0][i][2], acc[0][i][3]}, (f32x4){acc[0][i][4], acc[0][i][5], acc[0][i][6], acc[0][i][7]},
                 (f32x4){acc[1][i][0], acc[1][i][1], acc[1][i][2], acc[1][i][3]}, (f32x4){acc[1][i][4], acc[1][i][5], acc[1][i][6], acc[1][i][7]});
}

__global__ void __launch_bounds__(256) k_ssd_naive(Args args, int l) {
    __shared__ float xs[32][64]; __shared__ float Bsm[32][128]; __shared__ float Csm[32][128]; __shared__ float dts[32];
    const int b = blockIdx.x >> 4, h = blockIdx.x & 15, g = h >> 2, tid = threadIdx.x, p = tid >> 2, nq = tid & 3;
    const bf16* P = (const bf16*)(args.ws + WS_P); bf16* Y = (bf16*)(args.ws + WS_XM); const float* DT = (const float*)(args.ws + WS_DT);
    const float* cw = args.in[I_CONVW] + (size_t)l * 3 * 2048; const float* cb = args.in[I_CONVB] + (size_t)l * 2048;
    const float dskip = args.in[I_DSKIP][l * 16 + h];
    for (int dir = 0; dir < 2; ++dir) {
        float st[32];
#pragma unroll
        for (int i = 0; i < 32; ++i) st[i] = 0.f;
        const float Ah = -__expf(args.in[I_ALOG][(l * 2 + dir) * 16 + h]);
        for (int seg = 0; seg < 2; ++seg) {
            const int base = seg == 0 ? NLAT + b * CTXL : b * SEQ, len = seg == 0 ? CTXL : SEQ;
            const bool wy = !(l == 1 && seg == 0);
            for (int blk = 0; blk < len / 32; ++blk) {
                for (int idx = tid; idx < 32 * 320; idx += 256) {
                    const int tt = idx / 320, ch = idx % 320;
                    const int tok = dir == 0 ? blk * 32 + tt : len - 1 - (blk * 32 + tt);
                    const int col = ch < 64 ? PX + h * 64 + ch : (ch < 192 ? PB + g * 128 + (ch - 64) : PC + g * 128 + (ch - 192));
                    const bf16* pp = P + (size_t)(base + tok) * PW + col;
                    const float cur = bf2f(pp[0]), prv = tok > 0 ? bf2f(pp[-PW]) : 0.f, nxt = tok < len - 1 ? bf2f(pp[PW]) : 0.f;
                    const float v = siluf_(cw[col] * prv + cw[2048 + col] * cur + cw[4096 + col] * nxt + cb[col]);
                    if (ch < 64) xs[tt][ch] = v; else if (ch < 192) Bsm[tt][ch - 64] = v; else Csm[tt][ch - 192] = v;
                }
                if (tid < 32) { const int tok = dir == 0 ? blk * 32 + tid : len - 1 - (blk * 32 + tid); dts[tid] = DT[(size_t)(base + tok) * 32 + dir * 16 + h]; }
                __syncthreads();
                for (int tt = 0; tt < 32; ++tt) {
                    const float dt = dts[tt], dA = __expf(dt * Ah), xr = xs[tt][p], xv = xr * dt;
                    float ys = 0.f;
#pragma unroll
                    for (int i = 0; i < 32; ++i) { const int n = nq * 32 + i; st[i] = st[i] * dA + xv * Bsm[tt][n]; ys += st[i] * Csm[tt][n]; }
                    ys += __shfl_xor(ys, 1); ys += __shfl_xor(ys, 2);
                    if (nq == 0 && wy) { const int tok = dir == 0 ? blk * 32 + tt : len - 1 - (blk * 32 + tt); bf16* yp = Y + (size_t)(base + tok) * D + h * 64 + p;
                        if (dir == 0) *yp = (bf16)f2bf(ys + dskip * xr); else *yp = (bf16)f2bf(bf2f(*yp) + ys); }
                }
                __syncthreads();
            }
        }
    }
}

__global__ void __launch_bounds__(512) k_sgu_naive(Args args, int l) {
    extern __shared__ __attribute__((aligned(16))) unsigned char smem[];
    float* Vn = (float*)smem; float* mu = Vn + 128 * 128; float* rs = mu + 128;
    const int chunk = blockIdx.x >> 3, g = blockIdx.x & 7, tid = threadIdx.x, lane = tid & 63, wave = tid >> 6;
    const int row0 = chunk < 256 ? chunk * 128 : NLAT + (chunk - 256) * 128;
    bf16* P = (bf16*)(args.ws + WS_P);
    for (int rr = 0; rr < 16; ++rr) { const int j = wave * 16 + rr; const bf16* vp = P + (size_t)(row0 + j) * PW + PV;
        float v[16]; float s = 0.f;
#pragma unroll
        for (int q = 0; q < 2; ++q) { const v4u w = *(const v4u*)(vp + lane * 8 + 512 * q); v[q * 8 + 0] = bflo(w.x); v[q * 8 + 1] = bfhi(w.x); v[q * 8 + 2] = bflo(w.y); v[q * 8 + 3] = bfhi(w.y); v[q * 8 + 4] = bflo(w.z); v[q * 8 + 5] = bfhi(w.z); v[q * 8 + 6] = bflo(w.w); v[q * 8 + 7] = bfhi(w.w); }
#pragma unroll
        for (int i = 0; i < 16; ++i) s += v[i];
        const float m = wave_sum(s) * (1.f / D); float s2 = 0.f;
#pragma unroll
        for (int i = 0; i < 16; ++i) { const float d = v[i] - m; s2 += d * d; }
        const float var = wave_sum(s2) * (1.f / D);
        if (lane == 0) { mu[j] = m; rs[j] = rsqrtf(var + EPS); } }
    __syncthreads();
    const float* lnw = args.in[I_LNW] + l * D + g * 128; const float* lnb = args.in[I_LNB] + l * D + g * 128;
    for (int idx = tid; idx < 128 * 128; idx += 512) { const int j = idx >> 7, d = idx & 127; Vn[idx] = (bf2f(P[(size_t)(row0 + j) * PW + PV + g * 128 + d]) - mu[j]) * rs[j] * lnw[d] + lnb[d]; }
    __syncthreads();
    const float* Wsg = args.in[I_WS] + ((size_t)(l * 8 + g) * 128) * 128; const float* bsg = args.in[I_BS] + (l * 8 + g) * 128;
    for (int idx = tid; idx < 128 * 128; idx += 512) { const int i = idx >> 7, d = idx & 127; float s = 0.f;
        for (int j = 0; j < 128; ++j) s += Wsg[i * 128 + j] * Vn[j * 128 + d];
        bf16* up = P + (size_t)(row0 + i) * PW + PU + g * 128 + d; *up = (bf16)f2bf(bf2f(*up) * (s + bsg[i])); }
}

__device__ __forceinline__ void tr_item(const float* W, int ldw, bf16* WT, int K, int k0, int n0, int drow0, LAS float* scr, int lane) {
#pragma unroll 8
    for (int i = 0; i < 32; ++i) { const int kk = 2 * i + (lane >> 5); scr[kk * 33 + (lane & 31)] = W[(size_t)(k0 + kk) * ldw + n0 + (lane & 31)]; }
    asm volatile("s_waitcnt lgkmcnt(0)" ::: "memory");
    const int c = lane & 7;
#pragma unroll
    for (int j = 0; j < 4; ++j) { const int n = (lane >> 3) + 8 * j; const LAS float* s = scr + (8 * c) * 33 + n;
        v4u o; o.x = pk2(s[0 * 33], s[1 * 33]); o.y = pk2(s[2 * 33], s[3 * 33]); o.z = pk2(s[4 * 33], s[5 * 33]); o.w = pk2(s[6 * 33], s[7 * 33]);
        *(v4u*)(WT + (size_t)(drow0 + n) * K + k0 + 8 * c) = o; }
    asm volatile("s_waitcnt lgkmcnt(0)" ::: "memory");
}

__device__ __forceinline__ void phase_prologue(const Frame& F) {
    const Args& a = *F.a;
    LAS float* sc = (LAS float*)F.lds; LAS float* red = sc + 17 * 1024;
    if (F.bid < 192) {
        for (int i = F.tid; i < 17 * 1024; i += 512) { const int r = i >> 10, k = i & 1023; const float v = r < 16 ? a.in[I_C][r * 1024 + k] : a.in[I_CCTX][k]; sc[i] = siluf_(v); }
        __syncthreads();
        for (int it = F.bid; it < 192; it += F.G) {
            const int l = it / 96, nb = it % 96, n = nb * 64 + F.lane;
            float acc[17];
#pragma unroll
            for (int r = 0; r < 17; ++r) acc[r] = 0.f;
            const float* W = a.in[I_ADAW] + (size_t)l * 1024 * 6144 + n;
#pragma unroll 4
            for (int kk = 0; kk < 128; ++kk) { const int k = F.wave * 128 + kk; const float wv = W[(size_t)k * 6144];
#pragma unroll
                for (int r = 0; r < 17; ++r) acc[r] += sc[r * 1024 + k] * wv; }
#pragma unroll
            for (int r = 0; r < 17; ++r) red[(F.wave * 17 + r) * 64 + F.lane] = acc[r];
            __syncthreads();
            for (int i = F.tid; i < 17 * 64; i += 512) { const int r = i >> 6, ln = i & 63; float s = 0.f;
#pragma unroll
                for (int w = 0; w < 8; ++w) s += red[(w * 17 + r) * 64 + ln];
                ((float*)(a.ws + WS_MOD))[(size_t)(l * 17 + r) * 6144 + nb * 64 + ln] = s + a.in[I_ADAB][l * 6144 + nb * 64 + ln]; }
            __syncthreads();
        }
    }
    __syncthreads();
    LAS float* scr = (LAS float*)(F.lds + F.wave * 8448);
    const int gw = F.bid * F.nw + F.wave, NGW = F.G * F.nw;
    constexpr int IT_IN = 16 * 225, IT_MX = 16 * 32, IT_L = IT_IN + 3 * IT_MX;
    for (int it = gw; it < 2 * IT_L; it += NGW) {
        const int l = it / IT_L; int r = it % IT_L;
        if (r < IT_IN) { const int kb = r / 225, nb = r % 225, n0 = nb * 32; const int d0 = n0 < 2048 ? n0 : (n0 < 2080 ? 7168 + (n0 - 2048) : n0 - 32);
            tr_item(a.in[I_WIN] + (size_t)l * D * NIN, NIN, (bf16*)(a.ws + WS_WIN) + (size_t)l * WIN_ROWS * D, D, kb * 64, n0, d0, scr, F.lane); }
        else { r -= IT_IN; const int m = r / IT_MX, q = r % IT_MX, kb = q / 32, nb = q % 32;
            const float* W = (m == 0 ? a.in[I_WPA] : (m == 1 ? a.in[I_WPB] : a.in[I_WO])) + (size_t)l * D * D;
            tr_item(W, D, (bf16*)(a.ws + WS_WMIX) + (size_t)(l * 3 + m) * D * D, D, kb * 64, nb * 32, nb * 32, scr, F.lane); }
    }
    for (int i = F.bid * 512 + F.tid; i < 2 * 224 * 128; i += F.G * 512) { const int l = i / (224 * 128), q = i % (224 * 128);
        *(v4u*)((bf16*)(a.ws + WS_WIN) + ((size_t)l * WIN_ROWS + 7200) * D + (size_t)q * 8) = (v4u){0u, 0u, 0u, 0u}; }
    for (int i = F.bid * 512 + F.tid; i < 2 * 8 * 128 * 128 / 4; i += F.G * 512) { const f32x4 v = *(const f32x4*)(a.in[I_WS] + (size_t)i * 4); *(v2u*)((bf16*)(a.ws + WS_WST) + (size_t)i * 4) = pack4(v); }
}

__device__ __forceinline__ void convert_experts(const Frame& F, int l) {
    const Args& a = *F.a;
    LAS float* scr = (LAS float*)(F.lds + 65536 + F.wave * 8448);
    const int gw = F.bid * F.nw + F.wave, NGW = F.G * F.nw;
    for (int it = gw; it < 16 * 3 * 512; it += NGW) {
        const int e = it / 1536, r = it % 1536, m = r / 512, q = r % 512, kb = q / 32, nb = q % 32, n0 = nb * 32;
        const float* W = (m == 0 ? a.in[I_WG] : (m == 1 ? a.in[I_WU] : a.in[I_WD])) + ((size_t)l * 16 + e) * D * D;
        if (m < 2) tr_item(W, D, (bf16*)(a.ws + WS_P + PO_WGU) + (size_t)e * 2048 * D, D, kb * 64, n0, (n0 >> 7) * 256 + m * 128 + (n0 & 127), scr, F.lane);
        else tr_item(W, D, (bf16*)(a.ws + WS_P + PO_WD) + (size_t)e * 1024 * D, D, kb * 64, n0, n0, scr, F.lane);
    }
}

__device__ __forceinline__ void moe_combine(const Frame& F, int lprev, int r, f32x4 (&v)[4]) {
    const Args& a = *F.a;
    const int* inv = (const int*)(a.ws + WS_INV) + (size_t)r * 16;
    const int myslot = F.lane < 16 ? inv[F.lane] : -1;
    const bool lat = r < NLAT; const int b = lat ? (r >> 11) : ((r - NLAT) >> 8);
    f32x4 s[4];
#pragma unroll
    for (int j = 0; j < 4; ++j) s[j] = (f32x4){0.f, 0.f, 0.f, 0.f};
    const bf16* YM = (const bf16*)(a.ws + WS_P + PO_YM);
    for (int e = 0; e < 16; ++e) {
        const int slot = __builtin_amdgcn_readlane(myslot, e);
        if (slot >= 0) { const size_t hrow = lat ? (size_t)((b * 16 + e) * 256 + slot) : (size_t)(LIST_C0 + e * 512 + b * 32 + slot);
            const bf16* yp = YM + hrow * D + 4 * F.lane;
#pragma unroll
            for (int j = 0; j < 4; ++j) s[j] += unpack4(*(const v2u*)(yp + 256 * j)); }
    }
    const float* g2 = modp(a, lprev, batch_row(r)) + 5120 + 4 * F.lane;
#pragma unroll
    for (int j = 0; j < 4; ++j) v[j] += *(const f32x4*)(g2 + 256 * j) * s[j];
}

__device__ __forceinline__ void phase_norm1(const Frame& F, int l) {
    const Args& a = *F.a;
    const int gw = F.bid * F.nw + F.wave, NGW = F.G * F.nw;
    for (int r = gw; r < NROW; r += NGW) {
        const bool lat = r < NLAT;
        const float* hin = (l == 0) ? (lat ? a.in[I_X] + (size_t)r * D : a.in[I_CTX] + (size_t)(r - NLAT) * D) : (lat ? a.out + (size_t)r * D : (const float*)(a.ws + WS_HC) + (size_t)(r - NLAT) * D);
        f32x4 v[4];
#pragma unroll
        for (int j = 0; j < 4; ++j) v[j] = *(const f32x4*)(hin + 4 * F.lane + 256 * j);
        if (l > 0) { moe_combine(F, l - 1, r, v); float* ho = lat ? a.out + (size_t)r * D : (float*)(a.ws + WS_HC) + (size_t)(r - NLAT) * D;
#pragma unroll
            for (int j = 0; j < 4; ++j) *(f32x4*)(ho + 4 * F.lane + 256 * j) = v[j]; }
        float ss = 0.f;
#pragma unroll
        for (int j = 0; j < 4; ++j) ss += v[j].x * v[j].x + v[j].y * v[j].y + v[j].z * v[j].z + v[j].w * v[j].w;
        const float rstd = rsqrtf(wave_sum(ss) * (1.f / D) + EPS);
        const float* md = modp(a, l, batch_row(r)) + 4 * F.lane; const float* nw = a.in[I_N1W] + l * D + 4 * F.lane;
        bf16* o = (bf16*)(a.ws + WS_XM) + (size_t)r * D + 4 * F.lane;
#pragma unroll
        for (int j = 0; j < 4; ++j) { const f32x4 w = *(const f32x4*)(nw + 256 * j), sh = *(const f32x4*)(md + 256 * j), scl = *(const f32x4*)(md + 1024 + 256 * j);
            *(v2u*)(o + 256 * j) = pack4(v[j] * rstd * w * (scl + 1.0f) + sh); }
    }
}

__device__ __forceinline__ void phase_ssdin(const Frame& F, int l) {
    const Args& a = *F.a;
    const int gw = F.bid * F.nw + F.wave, NGW = F.G * F.nw, nrows = l == 0 ? NROW : NLAT;
    const float* nw = a.in[I_SSDNW] + l * D + 4 * F.lane;
    for (int r = gw; r < nrows; r += NGW) {
        const bf16* y = (const bf16*)(a.ws + WS_XM) + (size_t)r * D + 4 * F.lane; bf16* z = (bf16*)(a.ws + WS_P) + (size_t)r * PW + PZ + 4 * F.lane;
#pragma unroll
        for (int j = 0; j < 4; ++j) { const f32x4 g = unpack4(*(const v2u*)(y + 256 * j)) * unpack4(*(const v2u*)(z + 256 * j));
            const float ms = wave_sum(g.x * g.x + g.y * g.y + g.z * g.z + g.w * g.w) * (1.f / 256.f);
            *(v2u*)(z + 256 * j) = pack4(g * rsqrtf(ms + EPS) * *(const f32x4*)(nw + 256 * j)); }
    }
}

__device__ __forceinline__ void phase_norm2(const Frame& F, int l) {
    const Args& a = *F.a;
    LAS float* rwT = (LAS float*)F.lds;
    for (int i = F.tid; i < 16 * 1024; i += 512) { const int k = i >> 4, e = i & 15; rwT[e * 1024 + k] = a.in[I_RW][(size_t)l * D * 16 + i]; }
    __syncthreads();
    const int gw = F.bid * F.nw + F.wave, NGW = F.G * F.nw, nrows = l == 0 ? NROW : NLAT;
    for (int r = gw; r < nrows; r += NGW) {
        const bool lat = r < NLAT;
        const float* hin = lat ? a.out + (size_t)r * D : (const float*)(a.ws + WS_HC) + (size_t)(r - NLAT) * D;
        f32x4 v[4]; float ss = 0.f;
#pragma unroll
        for (int j = 0; j < 4; ++j) { v[j] = *(const f32x4*)(hin + 4 * F.lane + 256 * j); ss += v[j].x * v[j].x + v[j].y * v[j].y + v[j].z * v[j].z + v[j].w * v[j].w; }
        const float rstd = rsqrtf(wave_sum(ss) * (1.f / D) + EPS);
        const float* md = modp(a, l, batch_row(r)) + 3072 + 4 * F.lane; const float* nw = a.in[I_N2W] + l * D + 4 * F.lane;
        bf16* o = (bf16*)(a.ws + WS_XM) + (size_t)r * D + 4 * F.lane;
#pragma unroll
        for (int j = 0; j < 4; ++j) { const f32x4 w = *(const f32x4*)(nw + 256 * j), sh = *(const f32x4*)(md + 256 * j), scl = *(const f32x4*)(md + 1024 + 256 * j);
            v[j] = v[j] * rstd * w * (scl + 1.0f) + sh; *(v2u*)(o + 256 * j) = pack4(v[j]); }
        float mine = 0.f;
#pragma unroll 1
        for (int e = 0; e < 16; ++e) { float s = 0.f;
#pragma unroll
            for (int j = 0; j < 4; ++j) { const f32x4 w = *(const LAS f32x4*)(rwT + e * 1024 + 4 * F.lane + 256 * j); s += v[j].x * w.x + v[j].y * w.y + v[j].z * w.z + v[j].w * w.w; }
            s = wave_sum(s); mine = (F.lane == e) ? s : mine; }
        float mx = mine;
#pragma unroll
        for (int o = 1; o < 16; o <<= 1) mx = fmaxf(mx, __shfl_xor(mx, o));
        const float ex = __expf(mine - mx); float den = ex;
#pragma unroll
        for (int o = 1; o < 16; o <<= 1) den += __shfl_xor(den, o);
        if (F.lane < 16) ((float*)(a.ws + WS_AFF))[(size_t)r * 16 + F.lane] = ex / den;
    }
    __syncthreads();
    convert_experts(F, l);
}

__device__ __forceinline__ void phase_topk(const Frame& F, int l) {
    const Args& a = *F.a;
    LAS float* vals = (LAS float*)F.lds;
    const int ntask = l == 0 ? 512 : 256;
    const float* AFF = (const float*)(a.ws + WS_AFF); int* INV = (int*)(a.ws + WS_INV); int* IDX = (int*)(a.ws + WS_IDX); float* GATE = (float*)(a.ws + WS_GATE);
    for (int task = F.bid; task < ntask; task += F.G) {
        const bool lat = task < 256; const int t = lat ? task : task - 256, b = t >> 4, e = t & 15;
        const int r0 = lat ? b * SEQ : NLAT + b * CTXL, n = lat ? SEQ : CTXL, cap = lat ? CAP_L : CAP_C;
        const int list0 = lat ? (b * 16 + e) * 256 : LIST_C0 + e * 512 + b * 32;
        for (int i = F.tid; i < n; i += 512) vals[i] = AFF[(size_t)(r0 + i) * 16 + e];
        __syncthreads();
        float av[4]; int rk[4];
#pragma unroll
        for (int q = 0; q < 4; ++q) { const int i = F.tid + 512 * q; av[q] = i < n ? vals[i] : 0.f; rk[q] = 0; }
        for (int j = 0; j < n; j += 4) { const f32x4 w = *(const LAS f32x4*)(vals + j);
#pragma unroll
            for (int q = 0; q < 4; ++q) { const int i = F.tid + 512 * q; const float x = av[q];
                rk[q] += (w.x > x || (w.x == x && j < i)) + (w.y > x || (w.y == x && j + 1 < i)) + (w.z > x || (w.z == x && j + 2 < i)) + (w.w > x || (w.w == x && j + 3 < i)); } }
#pragma unroll
        for (int q = 0; q < 4; ++q) { const int i = F.tid + 512 * q; if (i < n) { const int slot = rk[q] < cap ? rk[q] : -1; INV[(size_t)(r0 + i) * 16 + e] = slot;
            if (slot >= 0) { IDX[list0 + slot] = r0 + i; GATE[list0 + slot] = av[q]; } } }
        __syncthreads();
    }
}

__device__ __forceinline__ void phase_final(const Frame& F) {
    const Args& a = *F.a;
    const int gw = F.bid * F.nw + F.wave, NGW = F.G * F.nw;
    for (int r = gw; r < NLAT; r += NGW) {
        float* h = a.out + (size_t)r * D + 4 * F.lane; f32x4 v[4];
#pragma unroll
        for (int j = 0; j < 4; ++j) v[j] = *(const f32x4*)(h + 256 * j);
        moe_combine(F, 1, r, v);
        float ss = 0.f;
#pragma unroll
        for (int j = 0; j < 4; ++j) ss += v[j].x * v[j].x + v[j].y * v[j].y + v[j].z * v[j].z + v[j].w * v[j].w;
        const float rstd = rsqrtf(wave_sum(ss) * (1.f / D) + EPS);
#pragma unroll
        for (int j = 0; j < 4; ++j) *(f32x4*)(h + 256 * j) = v[j] * rstd * *(const f32x4*)(a.in[I_FNW] + 4 * F.lane + 256 * j);
    }
}

constexpr int LDS_BYTES = 147456;
constexpr int NPHASE = 22;
__global__ void __launch_bounds__(512, 2) mk_fwd(Args args) {
    extern __shared__ __attribute__((aligned(16))) unsigned char lds[];
    Frame F; F.lds = (LAS unsigned char*)lds; F.tid = threadIdx.x; F.lane = F.tid & 63; F.wave = __builtin_amdgcn_readfirstlane(F.tid >> 6); F.nw = 8; F.G = gridDim.x; F.bid = blockIdx.x; F.a = &args;
    const int lo = args.ph_lo, hi = args.ph_hi;
#define IN(k) (lo <= (k) && (k) < hi)
    if (IN(0)) phase_prologue(F);
#pragma unroll
    for (int l = 0; l < 2; ++l) {
        const int base = 1 + 10 * l;
        if (IN(base + 0)) phase_norm1(F, l);
        if (IN(base + 3)) phase_ssdin(F, l);
        if (IN(base + 6)) phase_norm2(F, l);
        if (IN(base + 7)) phase_topk(F, l);
    }
    if (IN(21)) phase_final(F);
#undef IN
}

#ifndef STOP_AT
#define STOP_AT 99
#endif
__global__ void k_dump(float* o, size_t base, const unsigned char* src, int mode, size_t n) { for (size_t i = (size_t)blockIdx.x * blockDim.x + threadIdx.x; i < n; i += (size_t)gridDim.x * blockDim.x) {
    float v = mode == 0 ? bf2f(((const bf16*)src)[i]) : (mode == 1 ? ((const float*)src)[i] : (float)((const int*)src)[i]); o[base + i] = v; } }
#ifndef DUMP_SET
#define DUMP_SET 0
#endif
__global__ void k_fill(float* o, size_t n) { for (size_t i = (size_t)blockIdx.x * blockDim.x + threadIdx.x; i < n; i += (size_t)gridDim.x * blockDim.x) o[i] = 0.f; }
extern "C" void kernel_launch(void* const* d_in, const int* in_sizes, int n_in, void* d_out, int out_size, void* d_ws, size_t ws_size, hipStream_t stream) {
    static int grid = 0;
    if (grid == 0) {
        if (n_in != 27 || out_size != NLAT * D || ws_size < WS_END) { fprintf(stderr, "kernel_launch: unexpected shapes (n_in %d, out %d, ws %zu < %zu)\n", n_in, out_size, ws_size, (size_t)WS_END); grid = -1; return; }
        int dev = 0, cus = 0;
        if (hipGetDevice(&dev) != hipSuccess || hipDeviceGetAttribute(&cus, hipDeviceAttributeMultiprocessorCount, dev) != hipSuccess) { grid = -1; return; }
        if (hipFuncSetAttribute((const void*)mk_fwd, hipFuncAttributeMaxDynamicSharedMemorySize, LDS_BYTES) != hipSuccess) { grid = -1; return; }
        if (hipFuncSetAttribute((const void*)k_sgu_naive, hipFuncAttributeMaxDynamicSharedMemorySize, 128 * 128 * 4 + 1024) != hipSuccess) { grid = -1; return; }
        (void)hipGetLastError();
        grid = cus;
    }
    if (grid < 0) return;
    (void)hipMemsetAsync((char*)d_ws + WS_CTL, 0, CTL_ZERO_BYTES, stream);
    Args a{};
    for (int i = 0; i < 27; ++i) a.in[i] = (const float*)d_in[i];
    a.out = (float*)d_out; a.ws = (unsigned char*)d_ws;
    int stage = 0;
#define DUMP(base, off, mode, n) hipLaunchKernelGGL(k_dump, dim3(1024), dim3(256), 0, stream, (float*)d_out, (size_t)(base), (const unsigned char*)d_ws + (off), mode, (size_t)(n))
#define STAGE_GATE() do { if (++stage > STOP_AT) { hipLaunchKernelGGL(k_fill, dim3(1024), dim3(256), 0, stream, (float*)d_out, (size_t)NLAT * D); \
    if (DUMP_SET == 1) { DUMP(0, WS_AFF, 1, NROW * 16); DUMP(1 << 20, WS_IDX, 2, NLIST); DUMP(2 << 20, WS_GATE, 1, NLIST); DUMP(3 << 20, WS_INV, 2, NROW * 16); } \
    if (DUMP_SET == 2) { DUMP(0, WS_XM, 0, 32 << 20); } \
    if (DUMP_SET == 3) { DUMP(0, WS_MOD, 1, 2 * 17 * 6144); DUMP(1 << 20, WS_DT, 1, NROW * 32); DUMP(4 << 20, WS_HC, 1, NCTX * D);  DUMP(16 << 20, WS_WIN, 0, 15 << 20); } \
    if (DUMP_SET == 5) { DUMP(0, WS_XM, 0, 16 << 20); DUMP(16 << 20, WS_MOD, 1, 2 * 17 * 6144); DUMP(17 << 20, WS_WMIX, 0, 3 << 20); DUMP(20 << 20, WS_WIN, 0, 12 << 20); } \
    if (DUMP_SET == 6) { hipLaunchKernelGGL(k_dump, dim3(1024), dim3(256), 0, stream, (float*)d_out, (size_t)0, (const unsigned char*)d_in[0], 1, (size_t)NLAT * D); } \
    if (DUMP_SET == 7) { DUMP(16 << 20, WS_MOD, 1, 2 * 17 * 6144); } \
    if (DUMP_SET == 8) { DUMP(17 << 20, WS_WMIX, 0, 3 << 20); DUMP(20 << 20, WS_WIN, 0, 12 << 20); } \
    if (DUMP_SET == 10) { hipLaunchKernelGGL(k_dump, dim3(1024), dim3(256), 0, stream, (float*)d_out, (size_t)0, (const unsigned char*)d_in[8], 1, (size_t)14745600); } \
    if (DUMP_SET == 4) { DUMP(0, WS_P, 0, 32 << 20); } \
    return; } } while (0)
    auto run = [&](int lo, int hi) { a.ph_lo = lo; a.ph_hi = hi; hipLaunchKernelGGL(mk_fwd, dim3(grid), dim3(512), LDS_BYTES, stream, a); };
    STAGE_GATE();
    run(0, 1);
    for (int l = 0; l < 2; ++l) {
        const int base = 1 + 10 * l;
        STAGE_GATE();
        run(base + 0, base + 1);
        STAGE_GATE();
        hipLaunchKernelGGL(k_gemm_simple<ProbIn>, dim3((l == 0 ? 144 * 29 : 128 * 29 + 144) * 4), dim3(256), 0, stream, a, l);
        STAGE_GATE();
        hipLaunchKernelGGL(k_ssd_naive, dim3(256), dim3(256), 0, stream, a, l);
        STAGE_GATE();
        run(base + 3, base + 4);
        STAGE_GATE();
        hipLaunchKernelGGL(k_sgu_naive, dim3((l == 0 ? 288 : 256) * 8), dim3(512), 128 * 128 * 4 + 1024, stream, a, l);
        const int nmix = (l == 0 ? 144 : 128) * 4 * 4;
        STAGE_GATE();
        hipLaunchKernelGGL(k_gemm_simple<ProbMix<0>>, dim3(nmix), dim3(256), 0, stream, a, l);
        STAGE_GATE();
        hipLaunchKernelGGL(k_gemm_simple<ProbMix<1>>, dim3(nmix), dim3(256), 0, stream, a, l);
        STAGE_GATE();
        hipLaunchKernelGGL(k_gemm_simple<ProbMix<2>>, dim3(nmix), dim3(256), 0, stream, a, l);
        STAGE_GATE();
        run(base + 6, base + 7);
        STAGE_GATE();
        run(base + 7, base + 8);
        const int nt = 256 + (l == 0 ? 32 : 0);
        STAGE_GATE();
        hipLaunchKernelGGL(k_gemm_simple<ProbMoe<0>>, dim3(nt * 8 * 4), dim3(256), 0, stream, a, l);
        STAGE_GATE();
        hipLaunchKernelGGL(k_gemm_simple<ProbMoe<1>>, dim3(nt * 4 * 4), dim3(256), 0, stream, a, l);
    }
    STAGE_GATE();
    run(21, 22);
}
```

```cpp
#include <hip/hip_runtime.h>
#include <cstdio>
#include <cstdint>

#define GAS __attribute__((address_space(1)))
#define LAS __attribute__((address_space(3)))
typedef unsigned short bf16;
typedef unsigned v4u __attribute__((ext_vector_type(4)));
typedef unsigned v2u __attribute__((ext_vector_type(2)));
typedef float f32x4 __attribute__((ext_vector_type(4)));
typedef float f32x2 __attribute__((ext_vector_type(2)));
typedef short bf16x8 __attribute__((ext_vector_type(8)));

constexpr int D = 1024, NB = 16, SEQ = 2048, CTXL = 256, NLAT = NB * SEQ, NCTX = NB * CTXL, NROW = NLAT + NCTX;
constexpr int HEADS = 16, HD = 64, NST = 128, NIN = 7200;
constexpr int NEXP = 16, CAP_L = 256, CAP_C = 32;
constexpr float EPS = 1e-6f;
constexpr int PW = 7168, PX = 0, PB = 1024, PC = 1536, PZ = 2048, PU = 3072, PV = 4096, PGA = 5120, PGB = 6144;
constexpr int WIN_ROWS = 7424;
constexpr int NLIST = NB * NEXP * CAP_L + NEXP * NB * CAP_C;
constexpr int LIST_C0 = NB * NEXP * CAP_L;

constexpr size_t MiB = 1u << 20;
constexpr size_t WS_CTL = 0, CTL_ZERO_BYTES = 1 * MiB;
constexpr size_t WS_MOD = 1 * MiB;
constexpr size_t WS_WST = 2 * MiB;
constexpr size_t WS_DT = 3 * MiB;
constexpr size_t WS_AFF = 8 * MiB;
constexpr size_t WS_INV = 11 * MiB;
constexpr size_t WS_IDX = 14 * MiB;
constexpr size_t WS_GATE = 14 * MiB + 512 * 1024;
constexpr size_t WS_WIN = 16 * MiB;
constexpr size_t WS_WMIX = 45 * MiB;
constexpr size_t WS_HC = 57 * MiB;
constexpr size_t WS_XM = 73 * MiB;
constexpr size_t WS_P = 145 * MiB;
constexpr size_t WS_END = 649 * MiB;
constexpr size_t PO_WGU = 0, PO_WD = 64 * MiB, PO_HID = 96 * MiB, PO_YM = 240 * MiB;

__device__ __forceinline__ unsigned f2bf(float f) { unsigned u = __builtin_bit_cast(unsigned, f); return (u + 0x7fffu + ((u >> 16) & 1u)) >> 16; }
__device__ __forceinline__ unsigned pk2(float lo, float hi) { return f2bf(lo) | (f2bf(hi) << 16); }
__device__ __forceinline__ float bflo(unsigned w) { return __builtin_bit_cast(float, w << 16); }
__device__ __forceinline__ float bfhi(unsigned w) { return __builtin_bit_cast(float, w & 0xffff0000u); }
__device__ __forceinline__ float bf2f(bf16 b) { return __builtin_bit_cast(float, ((unsigned)b) << 16); }
__device__ __forceinline__ float sigmoidf_(float x) { return 1.0f / (1.0f + __expf(-x)); }
__device__ __forceinline__ float siluf_(float x) { return x / (1.0f + __expf(-x)); }
__device__ __forceinline__ float gelu_tanh(float x) { const float u = 1.5957691216057308f * (x + 0.044715f * x * x * x); return x / (1.0f + __expf(-u)); }
__device__ __forceinline__ float softplusf_(float x) { return fmaxf(x, 0.f) + log1pf(__expf(-fabsf(x))); }
__device__ __forceinline__ float wave_sum(float v) {
#pragma unroll
    for (int o = 1; o < 64; o <<= 1) v += __shfl_xor(v, o);
    return v;
}
__device__ __forceinline__ v2u pack4(f32x4 v) { v2u r; r.x = pk2(v.x, v.y); r.y = pk2(v.z, v.w); return r; }
__device__ __forceinline__ f32x4 unpack4(v2u w) { return (f32x4){bflo(w.x), bfhi(w.x), bflo(w.y), bfhi(w.y)}; }

struct Args { const float* in[27]; float* out; unsigned char* ws; int ph_lo, ph_hi; };
enum { I_X = 0, I_C, I_CTX, I_CCTX, I_ADAW, I_ADAB, I_N1W, I_N2W, I_WIN, I_CONVW, I_CONVB, I_DTB, I_ALOG, I_DSKIP, I_SSDNW, I_LNW, I_LNB, I_WS, I_BS, I_WPA, I_WPB, I_WO, I_RW, I_WG, I_WU, I_WD, I_FNW };

struct Frame {
    LAS unsigned char* lds; int tid, lane, wave, nw, G, bid;
    const Args* a;
};
__device__ __forceinline__ const float* modp(const Args& a, int l, int br) { return (const float*)(a.ws + WS_MOD) + (size_t)(l * 17 + br) * 6144; }
__device__ __forceinline__ int batch_row(int r) { return r < NLAT ? (r >> 11) : 16; }

struct Unit { const bf16* A; const bf16* B; const int* gidx; int lda, a_row0, pm, pn, aux; };

struct ProbIn {      static constexpr bool GATHER = false;
    const Args* a; int l;
    __device__ int nunits() const { return l == 0 ? 144 * 29 : 128 * 29 + 16 * 9; }
    __device__ void unit(int L, Unit& u) const {
        int pm, pn;
        const int nfull = (l == 0 ? 144 : 128);
        if (L < nfull * 29) { const int grp = L / (8 * 29), w = L % (8 * 29); pm = grp * 8 + (w & 7); pn = w >> 3; }
        else { const int w = L - nfull * 29; pm = 128 + (w & 15); const int q = w >> 4; pn = q < 8 ? q : 28; }
        u.A = (const bf16*)(a->ws + WS_XM); u.lda = D; u.a_row0 = pm * 256; u.gidx = nullptr; u.pm = pm; u.pn = pn; u.aux = 0;
        u.B = (const bf16*)(a->ws + WS_WIN) + ((size_t)l * WIN_ROWS + (size_t)pn * 256) * D;
    }
    __device__ __forceinline__ void epi(const Unit& u, int r, int c, f32x4 lo0, f32x4 lo1, f32x4 hi0, f32x4 hi1) const {
        const int row = u.pm * 256 + r, pn = u.pn;
        if (pn == 28) {
            if (c < 32) { float* dt = (float*)(a->ws + WS_DT) + (size_t)row * 32 + c; const float* db = a->in[I_DTB] + l * 32 + c;
                f32x4 o0, o1;
#pragma unroll
                for (int i = 0; i < 4; ++i) { o0[i] = softplusf_(lo0[i] + db[i]); o1[i] = softplusf_(lo1[i] + db[4 + i]); }
                *(f32x4*)dt = o0; *(f32x4*)(dt + 4) = o1; }
            return;
        }
        if (pn >= 8 && pn < 12) {
#pragma unroll
            for (int i = 0; i < 4; ++i) { lo0[i] = siluf_(lo0[i]); lo1[i] = siluf_(lo1[i]); hi0[i] = siluf_(hi0[i]); hi1[i] = siluf_(hi1[i]); } }
        else if (pn >= 12 && pn < 20) {
#pragma unroll
            for (int i = 0; i < 4; ++i) { lo0[i] = gelu_tanh(lo0[i]); lo1[i] = gelu_tanh(lo1[i]); hi0[i] = gelu_tanh(hi0[i]); hi1[i] = gelu_tanh(hi1[i]); } }
        else if (pn >= 20) {
#pragma unroll
            for (int i = 0; i < 4; ++i) { lo0[i] = sigmoidf_(lo0[i]); lo1[i] = sigmoidf_(lo1[i]); hi0[i] = sigmoidf_(hi0[i]); hi1[i] = sigmoidf_(hi1[i]); } }
        bf16* o = (bf16*)(a->ws + WS_P) + (size_t)row * PW + pn * 256 + c;
        v4u w; w.x = pk2(lo0[0], lo0[1]); w.y = pk2(lo0[2], lo0[3]); w.z = pk2(lo1[0], lo1[1]); w.w = pk2(lo1[2], lo1[3]); *(v4u*)o = w;
        w.x = pk2(hi0[0], hi0[1]); w.y = pk2(hi0[2], hi0[3]); w.z = pk2(hi1[0], hi1[1]); w.w = pk2(hi1[2], hi1[3]); *(v4u*)(o + 128) = w;
    }
};

template <int MODE> struct ProbMix {
    static constexpr bool GATHER = false;
    const Args* a; int l;
    __device__ int nunits() const { return (l == 0 ? 144 : 128) * 4; }
    __device__ void unit(int L, Unit& u) const {
        const int grp = L / 32, w = L % 32; const int pm = grp * 8 + (w & 7), pn = w >> 3;
        u.pm = pm; u.pn = pn; u.aux = 0; u.gidx = nullptr; u.a_row0 = pm * 256;
        if (MODE == 0) { u.A = (const bf16*)(a->ws + WS_P) + PZ; u.lda = PW; }
        else if (MODE == 1) { u.A = (const bf16*)(a->ws + WS_P) + PU; u.lda = PW; }
        else { u.A = (const bf16*)(a->ws + WS_XM); u.lda = D; }
        u.B = (const bf16*)(a->ws + WS_WMIX) + ((size_t)(l * 3 + MODE) * D + (size_t)pn * 256) * D;
    }
    __device__ __forceinline__ void epi(const Unit& u, int r, int c, f32x4 lo0, f32x4 lo1, f32x4 hi0, f32x4 hi1) const {
        const int row = u.pm * 256 + r, col = u.pn * 256 + c;
        if (MODE == 0) {
            bf16* g = (bf16*)(a->ws + WS_P) + (size_t)row * PW + PGA + col;
            v4u gl = *(const v4u*)g, gh = *(const v4u*)(g + 128), w;
            w.x = pk2(bflo(gl.x) * lo0[0], bfhi(gl.x) * lo0[1]); w.y = pk2(bflo(gl.y) * lo0[2], bfhi(gl.y) * lo0[3]); w.z = pk2(bflo(gl.z) * lo1[0], bfhi(gl.z) * lo1[1]); w.w = pk2(bflo(gl.w) * lo1[2], bfhi(gl.w) * lo1[3]); *(v4u*)g = w;
            w.x = pk2(bflo(gh.x) * hi0[0], bfhi(gh.x) * hi0[1]); w.y = pk2(bflo(gh.y) * hi0[2], bfhi(gh.y) * hi0[3]); w.z = pk2(bflo(gh.z) * hi1[0], bfhi(gh.z) * hi1[1]); w.w = pk2(bflo(gh.w) * hi1[2], bfhi(gh.w) * hi1[3]); *(v4u*)(g + 128) = w;
        } else if (MODE == 1) {
            const bf16* t = (const bf16*)(a->ws + WS_P) + (size_t)row * PW + PGA + col; const bf16* g = t + (PGB - PGA);
            bf16* o = (bf16*)(a->ws + WS_XM) + (size_t)row * D + col;
            v4u tl = *(const v4u*)t, th = *(const v4u*)(t + 128), gl = *(const v4u*)g, gh = *(const v4u*)(g + 128), w;
            w.x = pk2(bflo(tl.x) + bflo(gl.x) * lo0[0], bfhi(tl.x) + bfhi(gl.x) * lo0[1]); w.y = pk2(bflo(tl.y) + bflo(gl.y) * lo0[2], bfhi(tl.y) + bfhi(gl.y) * lo0[3]);
            w.z = pk2(bflo(tl.z) + bflo(gl.z) * lo1[0], bfhi(tl.z) + bfhi(gl.z) * lo1[1]); w.w = pk2(bflo(tl.w) + bflo(gl.w) * lo1[2], bfhi(tl.w) + bfhi(gl.w) * lo1[3]); *(v4u*)o = w;
            w.x = pk2(bflo(th.x) + bflo(gh.x) * hi0[0], bfhi(th.x) + bfhi(gh.x) * hi0[1]); w.y = pk2(bflo(th.y) + bflo(gh.y) * hi0[2], bfhi(th.y) + bfhi(gh.y) * hi0[3]);
            w.z = pk2(bflo(th.z) + bflo(gh.z) * hi1[0], bfhi(th.z) + bfhi(gh.z) * hi1[1]); w.w = pk2(bflo(th.w) + bflo(gh.w) * hi1[2], bfhi(th.w) + bfhi(gh.w) * hi1[3]); *(v4u*)(o + 128) = w;
        } else {
            const bool lat = row < NLAT;
            const float* hin = (l == 0) ? (lat ? a->in[I_X] + (size_t)row * D : a->in[I_CTX] + (size_t)(row - NLAT) * D) : (lat ? a->out + (size_t)row * D : (const float*)(a->ws + WS_HC) + (size_t)(row - NLAT) * D);
            float* hout = lat ? a->out + (size_t)row * D : (float*)(a->ws + WS_HC) + (size_t)(row - NLAT) * D;
            const float* g1 = modp(*a, l, batch_row(row)) + 2048 + col;
            hin += col; hout += col;
            *(f32x4*)hout = *(const f32x4*)hin + *(const f32x4*)g1 * lo0; *(f32x4*)(hout + 4) = *(const f32x4*)(hin + 4) + *(const f32x4*)(g1 + 4) * lo1;
            *(f32x4*)(hout + 128) = *(const f32x4*)(hin + 128) + *(const f32x4*)(g1 + 128) * hi0; *(f32x4*)(hout + 132) = *(const f32x4*)(hin + 132) + *(const f32x4*)(g1 + 132) * hi1;
        }
    }
};

template <int MODE> struct ProbMoe {
    static constexpr bool GATHER = (MODE == 0);
    const Args* a; int l;
    __device__ int nunits() const { const int per = MODE == 0 ? 8 : 4; return (256 + (l == 0 ? 32 : 0)) * per; }
    __device__ void unit(int L, Unit& u) const {
        constexpr int per = MODE == 0 ? 8 : 4;
        const int pn = L % per, t = L / per;
        const int e = t < 256 ? (t & 15) : ((t - 256) >> 1);
        const int list0 = t < 256 ? t * 256 : LIST_C0 + (t - 256) * 256;
        u.pm = t; u.pn = pn; u.aux = list0;
        if (MODE == 0) { u.A = (const bf16*)(a->ws + WS_XM); u.lda = D; u.a_row0 = 0; u.gidx = (const int*)(a->ws + WS_IDX) + list0;
            u.B = (const bf16*)(a->ws + WS_P + PO_WGU) + ((size_t)e * 2048 + (size_t)pn * 256) * D; }
        else { u.A = (const bf16*)(a->ws + WS_P + PO_HID); u.lda = D; u.a_row0 = list0; u.gidx = nullptr;
            u.B = (const bf16*)(a->ws + WS_P + PO_WD) + ((size_t)e * 1024 + (size_t)pn * 256) * D; }
    }
    __device__ __forceinline__ void epi(const Unit& u, int r, int c, f32x4 lo0, f32x4 lo1, f32x4 hi0, f32x4 hi1) const {
        const size_t hrow = (size_t)u.aux + r;
        if (MODE == 0) {
            bf16* o = (bf16*)(a->ws + WS_P + PO_HID) + hrow * D + u.pn * 128 + c;
            v4u w; w.x = pk2(siluf_(lo0[0]) * hi0[0], siluf_(lo0[1]) * hi0[1]); w.y = pk2(siluf_(lo0[2]) * hi0[2], siluf_(lo0[3]) * hi0[3]);
            w.z = pk2(siluf_(lo1[0]) * hi1[0], siluf_(lo1[1]) * hi1[1]); w.w = pk2(siluf_(lo1[2]) * hi1[2], siluf_(lo1[3]) * hi1[3]); *(v4u*)o = w;
        } else {
            const float gt = ((const float*)(a->ws + WS_GATE))[hrow];
            bf16* o = (bf16*)(a->ws + WS_P + PO_YM) + hrow * D + u.pn * 256 + c;
            v4u w; w.x = pk2(gt * lo0[0], gt * lo0[1]); w.y = pk2(gt * lo0[2], gt * lo0[3]); w.z = pk2(gt * lo1[0], gt * lo1[1]); w.w = pk2(gt * lo1[2], gt * lo1[3]); *(v4u*)o = w;
            w.x = pk2(gt * hi0[0], gt * hi0[1]); w.y = pk2(gt * hi0[2], gt * hi0[3]); w.z = pk2(gt * hi1[0], gt * hi1[1]); w.w = pk2(gt * hi1[2], gt * hi1[3]); *(v4u*)(o + 128) = w;
        }
    }
};


namespace pg8 {
constexpr int BM = 256, BK = 64, HALF = 128, HTB = HALF * BK * 2, STAGE_BYTES = 8 * HTB;
__device__ __forceinline__ int lds_byte(int r, int c) { const int st = (r >> 4) * 2 + (c >> 5), rr = r & 15, cc = c & 31, ob = rr * 64 + cc * 2; return st * 1024 + (ob ^ (((ob >> 9) & 1) << 5)); }
__device__ __forceinline__ void stage_rc(int b, int& R, int& C) { const int st = b / 1024, sb = b % 1024, swz = sb ^ (((sb >> 9) & 1) << 5); R = (st >> 1) * 16 + swz / 64; C = (st & 1) * 32 + (swz % 64) / 2; }
__device__ __forceinline__ int perm32(int rho) { const int n = rho >> 4, i = rho & 15; return 8 * (i >> 2) + 4 * n + (i & 3); }

template <bool GATHER> __device__ __forceinline__ void unit_voffA(const Unit& u, int tid, unsigned (&vo)[4]) {
#pragma unroll
    for (int h = 0; h < 2; ++h)
#pragma unroll
        for (int i = 0; i < 2; ++i) { int R, C; stage_rc(tid * 16 + i * 8192, R, C); const int r = h * HALF + R;
            if (GATHER) { int row = u.gidx[r]; row = (unsigned)row < (unsigned)NROW ? row : 0; vo[h * 2 + i] = ((unsigned)row * (unsigned)u.lda + (unsigned)C) * 2u; }
            else vo[h * 2 + i] = ((unsigned)r * (unsigned)u.lda + (unsigned)C) * 2u; }
}

__device__ __forceinline__ __amdgpu_buffer_rsrc_t mk_rsrc(const char* p) {
    const unsigned long long v = (unsigned long long)p;
    const unsigned lo = __builtin_amdgcn_readfirstlane((unsigned)v), hi = __builtin_amdgcn_readfirstlane((unsigned)(v >> 32));
    return __builtin_amdgcn_make_buffer_rsrc((void*)(((unsigned long long)hi << 32) | lo), 0, 0x7fffffff, 0x00020000);
}

template <class Prob>
__device__ __forceinline__ void gemm_phase(LAS unsigned char* lds, const Prob& prob, int G, int bid) {
    constexpr bool GATHER = Prob::GATHER;
    int tid_ = threadIdx.x; asm volatile("" : "+v"(tid_));
    const int tid = tid_, wid = __builtin_amdgcn_readfirstlane(tid >> 6), lane = tid & 63, wr = wid >> 2, wc = wid & 3, fr = lane & 15, fq = lane >> 4;
    constexpr int K = 1024, nt = K / BK;
    unsigned voffB[2];
#pragma unroll
    for (int i = 0; i < 2; ++i) { int R, C; stage_rc(tid * 16 + i * 8192, R, C); const int Rb = (R & ~31) + perm32(R & 31); voffB[i] = (unsigned)(Rb * K + C) * 2u; }
    constexpr int kstep = BK * 2;
    constexpr int hstep = HALF * K * 2;
    const unsigned ldsw = (unsigned)wid * 1024u;
    const int aoff = lds_byte(wr * 64 + fr, fq * 8), boff = lds_byte(wc * 32 + fr, fq * 8);
#define PG8_SA(b, h) (((b) * 2 + (h)) * HTB)
#define PG8_SB(b, h) ((4 + (b) * 2 + (h)) * HTB)
#define PG8_STAGE2(bufoff, rsrc, v0, v1, soff) do { \
        __builtin_amdgcn_raw_ptr_buffer_load_lds(rsrc, (LAS unsigned*)(lds + (bufoff) + ldsw), 16, (int)(v0), (int)(soff), 0, 0); \
        __builtin_amdgcn_raw_ptr_buffer_load_lds(rsrc, (LAS unsigned*)(lds + (bufoff) + ldsw + 8192), 16, (int)(v1), (int)(soff), 0, 0); } while (0)
#define PG8_STAGEB(bufoff, rsrc, soff) PG8_STAGE2(bufoff, rsrc, voffB[0], voffB[1], soff)
#define PG8_LDA(dst, b, h) do { _Pragma("unroll") for (int m = 0; m < 4; ++m) _Pragma("unroll") for (int k = 0; k < 2; ++k) dst[m][k] = *(const LAS bf16x8*)(lds + PG8_SA(b, h) + aoff + m * 2048 + k * 1024); } while (0)
#define PG8_LDB(dst, b, h) do { _Pragma("unroll") for (int n = 0; n < 2; ++n) _Pragma("unroll") for (int k = 0; k < 2; ++k) dst[n][k] = *(const LAS bf16x8*)(lds + PG8_SB(b, h) + boff + n * 2048 + k * 1024); } while (0)
#define PG8_MMA(ai, bj, At, Bt) do { __builtin_amdgcn_s_setprio(1); _Pragma("unroll") for (int m = 0; m < 4; ++m) _Pragma("unroll") for (int n = 0; n < 2; ++n) _Pragma("unroll") for (int k = 0; k < 2; ++k) \
        acc[ai][bj][m][n] = __builtin_amdgcn_mfma_f32_16x16x32_bf16(Bt[n][k], At[m][k], acc[ai][bj][m][n], 0, 0, 0); __builtin_amdgcn_s_setprio(0); } while (0)
#define PG8_WAIT_V(n) asm volatile("s_waitcnt vmcnt(" #n ")" ::: "memory")
#define PG8_WAIT_L(n) asm volatile("s_waitcnt lgkmcnt(" #n ")" ::: "memory")
#define PG8_BAR __builtin_amdgcn_s_barrier()
#define PG8_SCHED __builtin_amdgcn_sched_barrier(0)
    const int nun = prob.nunits();
    int L = bid;
    if (L >= nun) return;
    Unit cur, nxt; prob.unit(L, cur);
    unsigned voA[4], nvoA[4];
    unit_voffA<GATHER>(cur, tid, voA);
    const char* cA = (const char*)cur.A + (GATHER ? (size_t)0 : (size_t)cur.a_row0 * cur.lda * 2); const char* cB = (const char*)cur.B;
    {
        const __amdgpu_buffer_rsrc_t rA = mk_rsrc(cA), rB = mk_rsrc(cB);
        PG8_STAGEB(PG8_SB(0, 0), rB, 0); PG8_STAGEB(PG8_SB(0, 1), rB, hstep); PG8_STAGE2(PG8_SA(0, 0), rA, voA[0], voA[1], 0); PG8_STAGE2(PG8_SA(0, 1), rA, voA[2], voA[3], 0);
        if (wr == 1) PG8_BAR;
        PG8_WAIT_V(2); PG8_BAR;
        PG8_STAGEB(PG8_SB(1, 0), rB, kstep); PG8_STAGE2(PG8_SA(1, 0), rA, voA[0], voA[1], kstep); PG8_STAGEB(PG8_SB(1, 1), rB, hstep + kstep);
        PG8_WAIT_V(6); PG8_BAR; PG8_SCHED;
    }
    f32x4 acc[2][2][4][2];
#pragma unroll
    for (int a = 0; a < 2; ++a)
#pragma unroll
        for (int b = 0; b < 2; ++b)
#pragma unroll
            for (int m = 0; m < 4; ++m)
#pragma unroll
                for (int n = 0; n < 2; ++n) acc[a][b][m][n] = (f32x4){0.f, 0.f, 0.f, 0.f};
    bf16x8 At[4][2], B0[2][2], B1[2][2];
    for (;;) {
        const bool has_next = (L + G < nun);
        const char* nA = cA; const char* nB = cB;
#pragma unroll
        for (int i = 0; i < 4; ++i) nvoA[i] = voA[i];
        if (has_next) { prob.unit(L + G, nxt); if (GATHER) unit_voffA<GATHER>(nxt, tid, nvoA); nA = (const char*)nxt.A + (GATHER ? (size_t)0 : (size_t)nxt.a_row0 * nxt.lda * 2); nB = (const char*)nxt.B; }
        const __amdgpu_buffer_rsrc_t rA1 = mk_rsrc(cA);
        for (int t = 0; t < nt; t += 2) {
            const bool last = (t == nt - 2);
            const __amdgpu_buffer_rsrc_t rA2 = mk_rsrc(last ? nA : cA), rB2 = mk_rsrc(last ? nB : cB);
            const int o1 = (t + 1) * kstep, o2 = last ? 0 : (t + 2) * kstep, o3 = o2 + kstep;
            const unsigned s0 = (GATHER && last) ? nvoA[0] : voA[0], s1 = (GATHER && last) ? nvoA[1] : voA[1], s2 = (GATHER && last) ? nvoA[2] : voA[2], s3 = (GATHER && last) ? nvoA[3] : voA[3];
            PG8_LDB(B0, 0, 0); PG8_LDB(B1, 0, 1); PG8_SCHED; PG8_LDA(At, 0, 0); PG8_STAGE2(PG8_SA(1, 1), rA1, voA[2], voA[3], o1);
            PG8_WAIT_V(8); PG8_WAIT_L(0); PG8_BAR; PG8_MMA(0, 0, At, B0); PG8_MMA(0, 1, At, B1); PG8_BAR; PG8_SCHED;
            PG8_LDA(At, 0, 1); PG8_STAGEB(PG8_SB(0, 0), rB2, o2); PG8_STAGEB(PG8_SB(0, 1), rB2, o2 + hstep); PG8_STAGE2(PG8_SA(0, 0), rA2, s0, s1, o2);
            PG8_WAIT_V(8); PG8_WAIT_L(0); PG8_BAR; PG8_MMA(1, 0, At, B0); PG8_MMA(1, 1, At, B1); PG8_BAR; PG8_SCHED;
            PG8_LDB(B0, 1, 0); PG8_LDB(B1, 1, 1); PG8_SCHED; PG8_LDA(At, 1, 0); PG8_STAGE2(PG8_SA(0, 1), rA2, s2, s3, o2);
            PG8_WAIT_V(8); PG8_WAIT_L(0); PG8_BAR; PG8_MMA(0, 0, At, B0); PG8_MMA(0, 1, At, B1); PG8_BAR; PG8_SCHED;
            PG8_LDA(At, 1, 1); PG8_STAGEB(PG8_SB(1, 0), rB2, o3); PG8_STAGEB(PG8_SB(1, 1), rB2, o3 + hstep); PG8_STAGE2(PG8_SA(1, 0), rA2, s0, s1, o3);
            PG8_WAIT_V(8); PG8_WAIT_L(0); PG8_BAR; PG8_MMA(1, 0, At, B0); PG8_MMA(1, 1, At, B1); PG8_BAR; PG8_SCHED;
        }
        if (wr == 0) PG8_BAR;
#pragma unroll
        for (int ai = 0; ai < 2; ++ai)
#pragma unroll
            for (int m = 0; m < 4; ++m) { prob.epi(cur, ai * HALF + wr * 64 + m * 16 + fr, wc * 32 + fq * 8, acc[ai][0][m][0], acc[ai][0][m][1], acc[ai][1][m][0], acc[ai][1][m][1]); PG8_SCHED; }
        if (!has_next) break;
#pragma unroll
        for (int a = 0; a < 2; ++a)
#pragma unroll
            for (int b = 0; b < 2; ++b)
#pragma unroll
                for (int m = 0; m < 4; ++m)
#pragma unroll
                    for (int n = 0; n < 2; ++n) acc[a][b][m][n] = (f32x4){0.f, 0.f, 0.f, 0.f};
        cur = nxt; cA = nA; cB = nB; L += G;
#pragma unroll
        for (int i = 0; i < 4; ++i) voA[i] = nvoA[i];
        if (wr == 1) PG8_BAR;
    }
    PG8_WAIT_V(0);
    PG8_BAR;
#undef PG8_SA
#undef PG8_SB
#undef PG8_STAGE2
#undef PG8_STAGEB
#undef PG8_LDA
#undef PG8_LDB
#undef PG8_MMA
#undef PG8_WAIT_V
#undef PG8_WAIT_L
#undef PG8_BAR
#undef PG8_SCHED
}
}

template <class P> __global__ void __launch_bounds__(256) k_gemm_simple(Args args, int layer) {
    __shared__ float As[32][68]; __shared__ float Bs[32][260];
    P prob{&args, layer};
    const int L = blockIdx.x >> 2, rb = blockIdx.x & 3, tid = threadIdx.x, ty = tid >> 4, tx = tid & 15;
    if (L >= prob.nunits()) return;
    Unit u; prob.unit(L, u);
    const int ar = tid >> 2, aq = tid & 3;
    int arow = u.gidx ? u.gidx[rb * 64 + ar] : (u.a_row0 + rb * 64 + ar);
    arow = arow < 0 ? 0 : (arow >= NROW + NLIST ? 0 : arow);
    const bf16* ap = u.A + (size_t)arow * u.lda + aq * 8;
    float acc[2][4][8];
#pragma unroll
    for (int h = 0; h < 2; ++h)
#pragma unroll
        for (int i = 0; i < 4; ++i)
#pragma unroll
            for (int j = 0; j < 8; ++j) acc[h][i][j] = 0.f;
    for (int k0 = 0; k0 < D; k0 += 32) {
        v4u av = *(const v4u*)(ap + k0); v4u bv[4];
#pragma unroll
        for (int j = 0; j < 4; ++j) { const int p = tid + 256 * j; bv[j] = *(const v4u*)(u.B + (size_t)(p >> 2) * D + k0 + (p & 3) * 8); }
        __syncthreads();
        { const int kk = aq * 8; As[kk + 0][ar] = bflo(av.x); As[kk + 1][ar] = bfhi(av.x); As[kk + 2][ar] = bflo(av.y); As[kk + 3][ar] = bfhi(av.y); As[kk + 4][ar] = bflo(av.z); As[kk + 5][ar] = bfhi(av.z); As[kk + 6][ar] = bflo(av.w); As[kk + 7][ar] = bfhi(av.w); }
#pragma unroll
        for (int j = 0; j < 4; ++j) { const int p = tid + 256 * j, br = p >> 2, kk = (p & 3) * 8; Bs[kk + 0][br] = bflo(bv[j].x); Bs[kk + 1][br] = bfhi(bv[j].x); Bs[kk + 2][br] = bflo(bv[j].y); Bs[kk + 3][br] = bfhi(bv[j].y);
            Bs[kk + 4][br] = bflo(bv[j].z); Bs[kk + 5][br] = bfhi(bv[j].z); Bs[kk + 6][br] = bflo(bv[j].w); Bs[kk + 7][br] = bfhi(bv[j].w); }
        __syncthreads();
#pragma unroll 4
        for (int k = 0; k < 32; ++k) {
            const f32x4 a4 = *(const f32x4*)&As[k][ty * 4];
            const f32x4 b0 = *(const f32x4*)&Bs[k][tx * 8], b1 = *(const f32x4*)&Bs[k][tx * 8 + 4], b2 = *(const f32x4*)&Bs[k][128 + tx * 8], b3 = *(const f32x4*)&Bs[k][128 + tx * 8 + 4];
#pragma unroll
            for (int i = 0; i < 4; ++i)
#pragma unroll
                for (int j = 0; j < 4; ++j) { acc[0][i][j] += a4[i] * b0[j]; acc[0][i][4 + j] += a4[i] * b1[j]; acc[1][i][j] += a4[i] * b2[j]; acc[1][i][4 + j] += a4[i] * b3[j]; }
        }
    }
#pragma unroll
    for (int i = 0; i < 4; ++i)
        prob.epi(u, rb * 64 + ty * 4 + i, tx * 8, (f32x4){acc[0][i][0], acc[0][i][1], acc[0][i][2], acc[0][i][3]}, (f32x4){acc[0][i][4], acc[0][i][5], acc[0][i][6], acc[0][i][7]},
                 (f32x4){acc[1][i][0], acc[1][i][1], acc[1][i][2], acc[1][i][3]}, (f32x4){acc[1][i][4], acc[1][i][5], acc[1][i][6], acc[1][i][7]});
}

__global__ void __launch_bounds__(256) k_ssd_naive(Args args, int l) {
    __shared__ float xs[32][64]; __shared__ float Bsm[32][128]; __shared__ float Csm[32][128]; __shared__ float dts[32];
    const int b = blockIdx.x >> 4, h = blockIdx.x & 15, g = h >> 2, tid = threadIdx.x, p = tid >> 2, nq = tid & 3;
    const bf16* P = (const bf16*)(args.ws + WS_P); bf16* Y = (bf16*)(args.ws + WS_XM); const float* DT = (const float*)(args.ws + WS_DT);
    const float* cw = args.in[I_CONVW] + (size_t)l * 3 * 2048; const float* cb = args.in[I_CONVB] + (size_t)l * 2048;
    const float dskip = args.in[I_DSKIP][l * 16 + h];
    for (int dir = 0; dir < 2; ++dir) {
        float st[32];
#pragma unroll
        for (int i = 0; i < 32; ++i) st[i] = 0.f;
        const float Ah = -__expf(args.in[I_ALOG][(l * 2 + dir) * 16 + h]);
        for (int seg = 0; seg < 2; ++seg) {
            const int base = seg == 0 ? NLAT + b * CTXL : b * SEQ, len = seg == 0 ? CTXL : SEQ;
            const bool wy = !(l == 1 && seg == 0);
            for (int blk = 0; blk < len / 32; ++blk) {
                for (int idx = tid; idx < 32 * 320; idx += 256) {
                    const int tt = idx / 320, ch = idx % 320;
                    const int tok = dir == 0 ? blk * 32 + tt : len - 1 - (blk * 32 + tt);
                    const int col = ch < 64 ? PX + h * 64 + ch : (ch < 192 ? PB + g * 128 + (ch - 64) : PC + g * 128 + (ch - 192));
                    const bf16* pp = P + (size_t)(base + tok) * PW + col;
                    const float cur = bf2f(pp[0]), prv = tok > 0 ? bf2f(pp[-PW]) : 0.f, nxt = tok < len - 1 ? bf2f(pp[PW]) : 0.f;
                    const float v = siluf_(cw[col] * prv + cw[2048 + col] * cur + cw[4096 + col] * nxt + cb[col]);
                    if (ch < 64) xs[tt][ch] = v; else if (ch < 192) Bsm[tt][ch - 64] = v; else Csm[tt][ch - 192] = v;
                }
                if (tid < 32) { const int tok = dir == 0 ? blk * 32 + tid : len - 1 - (blk * 32 + tid); dts[tid] = DT[(size_t)(base + tok) * 32 + dir * 16 + h]; }
                __syncthreads();
                for (int tt = 0; tt < 32; ++tt) {
                    const float dt = dts[tt], dA = __expf(dt * Ah), xr = xs[tt][p], xv = xr * dt;
                    float ys = 0.f;
#pragma unroll
                    for (int i = 0; i < 32; ++i) { const int n = nq * 32 + i; st[i] = st[i] * dA + xv * Bsm[tt][n]; ys += st[i] * Csm[tt][n]; }
                    ys += __shfl_xor(ys, 1); ys += __shfl_xor(ys, 2);
                    if (nq == 0 && wy) { const int tok = dir == 0 ? blk * 32 + tt : len - 1 - (blk * 32 + tt); bf16* yp = Y + (size_t)(base + tok) * D + h * 64 + p;
                        if (dir == 0) *yp = (bf16)f2bf(ys + dskip * xr); else *yp = (bf16)f2bf(bf2f(*yp) + ys); }
                }
                __syncthreads();
            }
        }
    }
}

__global__ void __launch_bounds__(512) k_sgu_naive(Args args, int l) {
    extern __shared__ __attribute__((aligned(16))) unsigned char smem[];
    float* Vn = (float*)smem; float* mu = Vn + 128 * 128; float* rs = mu + 128;
    const int chunk = blockIdx.x >> 3, g = blockIdx.x & 7, tid = threadIdx.x, lane = tid & 63, wave = tid >> 6;
    const int row0 = chunk < 256 ? chunk * 128 : NLAT + (chunk - 256) * 128;
    bf16* P = (bf16*)(args.ws + WS_P);
    for (int rr = 0; rr < 16; ++rr) { const int j = wave * 16 + rr; const bf16* vp = P + (size_t)(row0 + j) * PW + PV;
        float v[16]; float s = 0.f;
#pragma unroll
        for (int q = 0; q < 2; ++q) { const v4u w = *(const v4u*)(vp + lane * 8 + 512 * q); v[q * 8 + 0] = bflo(w.x); v[q * 8 + 1] = bfhi(w.x); v[q * 8 + 2] = bflo(w.y); v[q * 8 + 3] = bfhi(w.y); v[q * 8 + 4] = bflo(w.z); v[q * 8 + 5] = bfhi(w.z); v[q * 8 + 6] = bflo(w.w); v[q * 8 + 7] = bfhi(w.w); }
#pragma unroll
        for (int i = 0; i < 16; ++i) s += v[i];
        const float m = wave_sum(s) * (1.f / D); float s2 = 0.f;
#pragma unroll
        for (int i = 0; i < 16; ++i) { const float d = v[i] - m; s2 += d * d; }
        const float var = wave_sum(s2) * (1.f / D);
        if (lane == 0) { mu[j] = m; rs[j] = rsqrtf(var + EPS); } }
    __syncthreads();
    const float* lnw = args.in[I_LNW] + l * D + g * 128; const float* lnb = args.in[I_LNB] + l * D + g * 128;
    for (int idx = tid; idx < 128 * 128; idx += 512) { const int j = idx >> 7, d = idx & 127; Vn[idx] = (bf2f(P[(size_t)(row0 + j) * PW + PV + g * 128 + d]) - mu[j]) * rs[j] * lnw[d] + lnb[d]; }
    __syncthreads();
    const float* Wsg = args.in[I_WS] + ((size_t)(l * 8 + g) * 128) * 128; const float* bsg = args.in[I_BS] + (l * 8 + g) * 128;
    for (int idx = tid; idx < 128 * 128; idx += 512) { const int i = idx >> 7, d = idx & 127; float s = 0.f;
        for (int j = 0; j < 128; ++j) s += Wsg[i * 128 + j] * Vn[j * 128 + d];
        bf16* up = P + (size_t)(row0 + i) * PW + PU + g * 128 + d; *up = (bf16)f2bf(bf2f(*up) * (s + bsg[i])); }
}

__device__ __forceinline__ void tr_item(const float* W, int ldw, bf16* WT, int K, int k0, int n0, int drow0, LAS float* scr, int lane) {
#pragma unroll 8
    for (int i = 0; i < 32; ++i) { const int kk = 2 * i + (lane >> 5); scr[kk * 33 + (lane & 31)] = W[(size_t)(k0 + kk) * ldw + n0 + (lane & 31)]; }
    asm volatile("s_waitcnt lgkmcnt(0)" ::: "memory");
    const int c = lane & 7;
#pragma unroll
    for (int j = 0; j < 4; ++j) { const int n = (lane >> 3) + 8 * j; const LAS float* s = scr + (8 * c) * 33 + n;
        v4u o; o.x = pk2(s[0 * 33], s[1 * 33]); o.y = pk2(s[2 * 33], s[3 * 33]); o.z = pk2(s[4 * 33], s[5 * 33]); o.w = pk2(s[6 * 33], s[7 * 33]);
        *(v4u*)(WT + (size_t)(drow0 + n) * K + k0 + 8 * c) = o; }
    asm volatile("s_waitcnt lgkmcnt(0)" ::: "memory");
}

__device__ __forceinline__ void phase_prologue(const Frame& F) {
    const Args& a = *F.a;
    LAS float* sc = (LAS float*)F.lds; LAS float* red = sc + 17 * 1024;
    if (F.bid < 192) {
        for (int i = F.tid; i < 17 * 1024; i += 512) { const int r = i >> 10, k = i & 1023; const float v = r < 16 ? a.in[I_C][r * 1024 + k] : a.in[I_CCTX][k]; sc[i] = siluf_(v); }
        __syncthreads();
        for (int it = F.bid; it < 192; it += F.G) {
            const int l = it / 96, nb = it % 96, n = nb * 64 + F.lane;
            float acc[17];
#pragma unroll
            for (int r = 0; r < 17; ++r) acc[r] = 0.f;
            const float* W = a.in[I_ADAW] + (size_t)l * 1024 * 6144 + n;
#pragma unroll 4
            for (int kk = 0; kk < 128; ++kk) { const int k = F.wave * 128 + kk; const float wv = W[(size_t)k * 6144];
#pragma unroll
                for (int r = 0; r < 17; ++r) acc[r] += sc[r * 1024 + k] * wv; }
#pragma unroll
            for (int r = 0; r < 17; ++r) red[(F.wave * 17 + r) * 64 + F.lane] = acc[r];
            __syncthreads();
            for (int i = F.tid; i < 17 * 64; i += 512) { const int r = i >> 6, ln = i & 63; float s = 0.f;
#pragma unroll
                for (int w = 0; w < 8; ++w) s += red[(w * 17 + r) * 64 + ln];
                ((float*)(a.ws + WS_MOD))[(size_t)(l * 17 + r) * 6144 + nb * 64 + ln] = s + a.in[I_ADAB][l * 6144 + nb * 64 + ln]; }
            __syncthreads();
        }
    }
    __syncthreads();
    LAS float* scr = (LAS float*)(F.lds + F.wave * 8448);
    const int gw = F.bid * F.nw + F.wave, NGW = F.G * F.nw;
    constexpr int IT_IN = 16 * 225, IT_MX = 16 * 32, IT_L = IT_IN + 3 * IT_MX;
    for (int it = gw; it < 2 * IT_L; it += NGW) {
        const int l = it / IT_L; int r = it % IT_L;
        if (r < IT_IN) { const int kb = r / 225, nb = r % 225, n0 = nb * 32; const int d0 = n0 < 2048 ? n0 : (n0 < 2080 ? 7168 + (n0 - 2048) : n0 - 32);
            tr_item(a.in[I_WIN] + (size_t)l * D * NIN, NIN, (bf16*)(a.ws + WS_WIN) + (size_t)l * WIN_ROWS * D, D, kb * 64, n0, d0, scr, F.lane); }
        else { r -= IT_IN; const int m = r / IT_MX, q = r % IT_MX, kb = q / 32, nb = q % 32;
            const float* W = (m == 0 ? a.in[I_WPA] : (m == 1 ? a.in[I_WPB] : a.in[I_WO])) + (size_t)l * D * D;
            tr_item(W, D, (bf16*)(a.ws + WS_WMIX) + (size_t)(l * 3 + m) * D * D, D, kb * 64, nb * 32, nb * 32, scr, F.lane); }
    }
    for (int i = F.bid * 512 + F.tid; i < 2 * 224 * 128; i += F.G * 512) { const int l = i / (224 * 128), q = i % (224 * 128);
        *(v4u*)((bf16*)(a.ws + WS_WIN) + ((size_t)l * WIN_ROWS + 7200) * D + (size_t)q * 8) = (v4u){0u, 0u, 0u, 0u}; }
    for (int i = F.bid * 512 + F.tid; i < 2 * 8 * 128 * 128 / 4; i += F.G * 512) { const f32x4 v = *(const f32x4*)(a.in[I_WS] + (size_t)i * 4); *(v2u*)((bf16*)(a.ws + WS_WST) + (size_t)i * 4) = pack4(v); }
}

__device__ __forceinline__ void convert_experts(const Frame& F, int l) {
    const Args& a = *F.a;
    LAS float* scr = (LAS float*)(F.lds + 65536 + F.wave * 8448);
    const int gw = F.bid * F.nw + F.wave, NGW = F.G * F.nw;
    for (int it = gw; it < 16 * 3 * 512; it += NGW) {
        const int e = it / 1536, r = it % 1536, m = r / 512, q = r % 512, kb = q / 32, nb = q % 32, n0 = nb * 32;
        const float* W = (m == 0 ? a.in[I_WG] : (m == 1 ? a.in[I_WU] : a.in[I_WD])) + ((size_t)l * 16 + e) * D * D;
        if (m < 2) tr_item(W, D, (bf16*)(a.ws + WS_P + PO_WGU) + (size_t)e * 2048 * D, D, kb * 64, n0, (n0 >> 7) * 256 + m * 128 + (n0 & 127), scr, F.lane);
        else tr_item(W, D, (bf16*)(a.ws + WS_P + PO_WD) + (size_t)e * 1024 * D, D, kb * 64, n0, n0, scr, F.lane);
    }
}

__device__ __forceinline__ void moe_combine(const Frame& F, int lprev, int r, f32x4 (&v)[4]) {
    const Args& a = *F.a;
    const int* inv = (const int*)(a.ws + WS_INV) + (size_t)r * 16;
    const int myslot = F.lane < 16 ? inv[F.lane] : -1;
    const bool lat = r < NLAT; const int b = lat ? (r >> 11) : ((r - NLAT) >> 8);
    f32x4 s[4];
#pragma unroll
    for (int j = 0; j < 4; ++j) s[j] = (f32x4){0.f, 0.f, 0.f, 0.f};
    const bf16* YM = (const bf16*)(a.ws + WS_P + PO_YM);
    for (int e = 0; e < 16; ++e) {
        const int slot = __builtin_amdgcn_readlane(myslot, e);
        if (slot >= 0) { const size_t hrow = lat ? (size_t)((b * 16 + e) * 256 + slot) : (size_t)(LIST_C0 + e * 512 + b * 32 + slot);
            const bf16* yp = YM + hrow * D + 4 * F.lane;
#pragma unroll
            for (int j = 0; j < 4; ++j) s[j] += unpack4(*(const v2u*)(yp + 256 * j)); }
    }
    const float* g2 = modp(a, lprev, batch_row(r)) + 5120 + 4 * F.lane;
#pragma unroll
    for (int j = 0; j < 4; ++j) v[j] += *(const f32x4*)(g2 + 256 * j) * s[j];
}

__device__ __forceinline__ void phase_norm1(const Frame& F, int l) {
    const Args& a = *F.a;
    const int gw = F.bid * F.nw + F.wave, NGW = F.G * F.nw;
    for (int r = gw; r < NROW; r += NGW) {
        const bool lat = r < NLAT;
        const float* hin = (l == 0) ? (lat ? a.in[I_X] + (size_t)r * D : a.in[I_CTX] + (size_t)(r - NLAT) * D) : (lat ? a.out + (size_t)r * D : (const float*)(a.ws + WS_HC) + (size_t)(r - NLAT) * D);
        f32x4 v[4];
#pragma unroll
        for (int j = 0; j < 4; ++j) v[j] = *(const f32x4*)(hin + 4 * F.lane + 256 * j);
        if (l > 0) { moe_combine(F, l - 1, r, v); float* ho = lat ? a.out + (size_t)r * D : (float*)(a.ws + WS_HC) + (size_t)(r - NLAT) * D;
#pragma unroll
            for (int j = 0; j < 4; ++j) *(f32x4*)(ho + 4 * F.lane + 256 * j) = v[j]; }
        float ss = 0.f;
#pragma unroll
        for (int j = 0; j < 4; ++j) ss += v[j].x * v[j].x + v[j].y * v[j].y + v[j].z * v[j].z + v[j].w * v[j].w;
        const float rstd = rsqrtf(wave_sum(ss) * (1.f / D) + EPS);
        const float* md = modp(a, l, batch_row(r)) + 4 * F.lane; const float* nw = a.in[I_N1W] + l * D + 4 * F.lane;
        bf16* o = (bf16*)(a.ws + WS_XM) + (size_t)r * D + 4 * F.lane;
#pragma unroll
        for (int j = 0; j < 4; ++j) { const f32x4 w = *(const f32x4*)(nw + 256 * j), sh = *(const f32x4*)(md + 256 * j), scl = *(const f32x4*)(md + 1024 + 256 * j);
            *(v2u*)(o + 256 * j) = pack4(v[j] * rstd * w * (scl + 1.0f) + sh); }
    }
}

__device__ __forceinline__ void phase_ssdin(const Frame& F, int l) {
    const Args& a = *F.a;
    const int gw = F.bid * F.nw + F.wave, NGW = F.G * F.nw, nrows = l == 0 ? NROW : NLAT;
    const float* nw = a.in[I_SSDNW] + l * D + 4 * F.lane;
    for (int r = gw; r < nrows; r += NGW) {
        const bf16* y = (const bf16*)(a.ws + WS_XM) + (size_t)r * D + 4 * F.lane; bf16* z = (bf16*)(a.ws + WS_P) + (size_t)r * PW + PZ + 4 * F.lane;
#pragma unroll
        for (int j = 0; j < 4; ++j) { const f32x4 g = unpack4(*(const v2u*)(y + 256 * j)) * unpack4(*(const v2u*)(z + 256 * j));
            const float ms = wave_sum(g.x * g.x + g.y * g.y + g.z * g.z + g.w * g.w) * (1.f / 256.f);
            *(v2u*)(z + 256 * j) = pack4(g * rsqrtf(ms + EPS) * *(const f32x4*)(nw + 256 * j)); }
    }
}

__device__ __forceinline__ void phase_norm2(const Frame& F, int l) {
    const Args& a = *F.a;
    LAS float* rwT = (LAS float*)F.lds;
    for (int i = F.tid; i < 16 * 1024; i += 512) { const int k = i >> 4, e = i & 15; rwT[e * 1024 + k] = a.in[I_RW][(size_t)l * D * 16 + i]; }
    __syncthreads();
    const int gw = F.bid * F.nw + F.wave, NGW = F.G * F.nw, nrows = l == 0 ? NROW : NLAT;
    for (int r = gw; r < nrows; r += NGW) {
        const bool lat = r < NLAT;
        const float* hin = lat ? a.out + (size_t)r * D : (const float*)(a.ws + WS_HC) + (size_t)(r - NLAT) * D;
        f32x4 v[4]; float ss = 0.f;
#pragma unroll
        for (int j = 0; j < 4; ++j) { v[j] = *(const f32x4*)(hin + 4 * F.lane + 256 * j); ss += v[j].x * v[j].x + v[j].y * v[j].y + v[j].z * v[j].z + v[j].w * v[j].w; }
        const float rstd = rsqrtf(wave_sum(ss) * (1.f / D) + EPS);
        const float* md = modp(a, l, batch_row(r)) + 3072 + 4 * F.lane; const float* nw = a.in[I_N2W] + l * D + 4 * F.lane;
        bf16* o = (bf16*)(a.ws + WS_XM) + (size_t)r * D + 4 * F.lane;
#pragma unroll
        for (int j = 0; j < 4; ++j) { const f32x4 w = *(const f32x4*)(nw + 256 * j), sh = *(const f32x4*)(md + 256 * j), scl = *(const f32x4*)(md + 1024 + 256 * j);
            v[j] = v[j] * rstd * w * (scl + 1.0f) + sh; *(v2u*)(o + 256 * j) = pack4(v[j]); }
        float mine = 0.f;
#pragma unroll 1
        for (int e = 0; e < 16; ++e) { float s = 0.f;
#pragma unroll
            for (int j = 0; j < 4; ++j) { const f32x4 w = *(const LAS f32x4*)(rwT + e * 1024 + 4 * F.lane + 256 * j); s += v[j].x * w.x + v[j].y * w.y + v[j].z * w.z + v[j].w * w.w; }
            s = wave_sum(s); mine = (F.lane == e) ? s : mine; }
        float mx = mine;
#pragma unroll
        for (int o = 1; o < 16; o <<= 1) mx = fmaxf(mx, __shfl_xor(mx, o));
        const float ex = __expf(mine - mx); float den = ex;
#pragma unroll
        for (int o = 1; o < 16; o <<= 1) den += __shfl_xor(den, o);
        if (F.lane < 16) ((float*)(a.ws + WS_AFF))[(size_t)r * 16 + F.lane] = ex / den;
    }
    __syncthreads();
    convert_experts(F, l);
}

__device__ __forceinline__ void phase_topk(const Frame& F, int l) {
    const Args& a = *F.a;
    LAS float* vals = (LAS float*)F.lds;
    const int ntask = l == 0 ? 512 : 256;
    const float* AFF = (const float*)(a.ws + WS_AFF); int* INV = (int*)(a.ws + WS_INV); int* IDX = (int*)(a.ws + WS_IDX); float* GATE = (float*)(a.ws + WS_GATE);
    for (int task = F.bid; task < ntask; task += F.G) {
        const bool lat = task < 256; const int t = lat ? task : task - 256, b = t >> 4, e = t & 15;
        const int r0 = lat ? b * SEQ : NLAT + b * CTXL, n = lat ? SEQ : CTXL, cap = lat ? CAP_L : CAP_C;
        const int list0 = lat ? (b * 16 + e) * 256 : LIST_C0 + e * 512 + b * 32;
        for (int i = F.tid; i < n; i += 512) vals[i] = AFF[(size_t)(r0 + i) * 16 + e];
        __syncthreads();
        float av[4]; int rk[4];
#pragma unroll
        for (int q = 0; q < 4; ++q) { const int i = F.tid + 512 * q; av[q] = i < n ? vals[i] : 0.f; rk[q] = 0; }
        for (int j = 0; j < n; j += 4) { const f32x4 w = *(const LAS f32x4*)(vals + j);
#pragma unroll
            for (int q = 0; q < 4; ++q) { const int i = F.tid + 512 * q; const float x = av[q];
                rk[q] += (w.x > x || (w.x == x && j < i)) + (w.y > x || (w.y == x && j + 1 < i)) + (w.z > x || (w.z == x && j + 2 < i)) + (w.w > x || (w.w == x && j + 3 < i)); } }
#pragma unroll
        for (int q = 0; q < 4; ++q) { const int i = F.tid + 512 * q; if (i < n) { const int slot = rk[q] < cap ? rk[q] : -1; INV[(size_t)(r0 + i) * 16 + e] = slot;
            if (slot >= 0) { IDX[list0 + slot] = r0 + i; GATE[list0 + slot] = av[q]; } } }
        __syncthreads();
    }
}

__device__ __forceinline__ void phase_final(const Frame& F) {
    const Args& a = *F.a;
    const int gw = F.bid * F.nw + F.wave, NGW = F.G * F.nw;
    for (int r = gw; r < NLAT; r += NGW) {
        float* h = a.out + (size_t)r * D + 4 * F.lane; f32x4 v[4];
#pragma unroll
        for (int j = 0; j < 4; ++j) v[j] = *(const f32x4*)(h + 256 * j);
        moe_combine(F, 1, r, v);
        float ss = 0.f;
#pragma unroll
        for (int j = 0; j < 4; ++j) ss += v[j].x * v[j].x + v[j].y * v[j].y + v[j].z * v[j].z + v[j].w * v[j].w;
        const float rstd = rsqrtf(wave_sum(ss) * (1.f / D) + EPS);
#pragma unroll
        for (int j = 0; j < 4; ++j) *(f32x4*)(h + 256 * j) = v[j] * rstd * *(const f32x4*)(a.in[I_FNW] + 4 * F.lane + 256 * j);
    }
}


__device__ __forceinline__ void phase_ssd_seq(const Frame& F, int l) {
    const Args& a = *F.a;
    LAS float* xs = (LAS float*)F.lds; LAS float* Bsm = xs + 32 * 64; LAS float* Csm = Bsm + 32 * 128; LAS float* dts = Csm + 32 * 128;
    const bf16* P = (const bf16*)(a.ws + WS_P); bf16* Y = (bf16*)(a.ws + WS_XM); const float* DT = (const float*)(a.ws + WS_DT);
    const float* cw = a.in[I_CONVW] + (size_t)l * 3 * 2048; const float* cb = a.in[I_CONVB] + (size_t)l * 2048;
    const int tid = F.tid, p = tid >> 3, nq = tid & 7;
    for (int task = F.bid; task < 256; task += F.G) {
        const int b = task >> 4, h = task & 15, g = h >> 2;
        const float dskip = a.in[I_DSKIP][l * 16 + h];
        for (int dir = 0; dir < 2; ++dir) {
            float st[16];
#pragma unroll
            for (int i = 0; i < 16; ++i) st[i] = 0.f;
            const float Ah = -__expf(a.in[I_ALOG][(l * 2 + dir) * 16 + h]);
            for (int seg = 0; seg < 2; ++seg) {
                const int base = seg == 0 ? NLAT + b * CTXL : b * SEQ, len = seg == 0 ? CTXL : SEQ;
                const bool wy = !(l == 1 && seg == 0);
                for (int blk = 0; blk < len / 32; ++blk) {
                    for (int idx = tid; idx < 32 * 320; idx += 512) {
                        const int tt = idx / 320, ch = idx % 320;
                        const int tok = dir == 0 ? blk * 32 + tt : len - 1 - (blk * 32 + tt);
                        const int col = ch < 64 ? PX + h * 64 + ch : (ch < 192 ? PB + g * 128 + (ch - 64) : PC + g * 128 + (ch - 192));
                        const bf16* pp = P + (size_t)(base + tok) * PW + col;
                        const float cur = bf2f(pp[0]), prv = tok > 0 ? bf2f(pp[-PW]) : 0.f, nxt = tok < len - 1 ? bf2f(pp[PW]) : 0.f;
                        const float v = siluf_(cw[col] * prv + cw[2048 + col] * cur + cw[4096 + col] * nxt + cb[col]);
                        if (ch < 64) xs[tt * 64 + ch] = v; else if (ch < 192) Bsm[tt * 128 + ch - 64] = v; else Csm[tt * 128 + ch - 192] = v;
                    }
                    if (tid < 32) { const int tok = dir == 0 ? blk * 32 + tid : len - 1 - (blk * 32 + tid); dts[tid] = DT[(size_t)(base + tok) * 32 + dir * 16 + h]; }
                    __syncthreads();
                    for (int tt = 0; tt < 32; ++tt) {
                        const float dt = dts[tt], dA = __expf(dt * Ah), xr = xs[tt * 64 + p], xv = xr * dt;
                        float ys = 0.f;
#pragma unroll
                        for (int i = 0; i < 16; ++i) { const int n = nq * 16 + i; st[i] = st[i] * dA + xv * Bsm[tt * 128 + n]; ys += st[i] * Csm[tt * 128 + n]; }
                        ys += __shfl_xor(ys, 1); ys += __shfl_xor(ys, 2); ys += __shfl_xor(ys, 4);
                        if (nq == 0 && wy) { const int tok = dir == 0 ? blk * 32 + tt : len - 1 - (blk * 32 + tt); bf16* yp = Y + (size_t)(base + tok) * D + h * 64 + p;
                            if (dir == 0) *yp = (bf16)f2bf(ys + dskip * xr); else *yp = (bf16)f2bf(bf2f(*yp) + ys); }
                    }
                    __syncthreads();
                }
            }
        }
    }
}

__device__ __forceinline__ void phase_sgu_simple(const Frame& F, int l) {
    const Args& a = *F.a;
    LAS float* Vn = (LAS float*)F.lds; LAS float* mu = Vn + 128 * 128; LAS float* rs = mu + 128;
    bf16* P = (bf16*)(a.ws + WS_P);
    const int ntask = (l == 0 ? 288 : 256) * 8, tid = F.tid, lane = F.lane, wave = F.wave;
    for (int task = F.bid; task < ntask; task += F.G) {
        const int chunk = task >> 3, g = task & 7;
        const int row0 = chunk < 256 ? chunk * 128 : NLAT + (chunk - 256) * 128;
        for (int rr = 0; rr < 16; ++rr) { const int j = wave * 16 + rr; const bf16* vp = P + (size_t)(row0 + j) * PW + PV;
            float v[16]; float sm = 0.f;
#pragma unroll
            for (int q = 0; q < 2; ++q) { const v4u w = *(const v4u*)(vp + lane * 8 + 512 * q); v[q * 8 + 0] = bflo(w.x); v[q * 8 + 1] = bfhi(w.x); v[q * 8 + 2] = bflo(w.y); v[q * 8 + 3] = bfhi(w.y); v[q * 8 + 4] = bflo(w.z); v[q * 8 + 5] = bfhi(w.z); v[q * 8 + 6] = bflo(w.w); v[q * 8 + 7] = bfhi(w.w); }
#pragma unroll
            for (int i = 0; i < 16; ++i) sm += v[i];
            const float m = wave_sum(sm) * (1.f / D); float s2 = 0.f;
#pragma unroll
            for (int i = 0; i < 16; ++i) { const float d = v[i] - m; s2 += d * d; }
            const float var = wave_sum(s2) * (1.f / D);
            if (lane == 0) { mu[j] = m; rs[j] = rsqrtf(var + EPS); } }
        __syncthreads();
        const float* lnw = a.in[I_LNW] + l * D + g * 128; const float* lnb = a.in[I_LNB] + l * D + g * 128;
        for (int idx = tid; idx < 128 * 128; idx += 512) { const int j = idx >> 7, d = idx & 127; Vn[idx] = (bf2f(P[(size_t)(row0 + j) * PW + PV + g * 128 + d]) - mu[j]) * rs[j] * lnw[d] + lnb[d]; }
        __syncthreads();
        const float* Wsg = a.in[I_WS] + ((size_t)(l * 8 + g) * 128) * 128; const float* bsg = a.in[I_BS] + (l * 8 + g) * 128;
        for (int idx = tid; idx < 128 * 128; idx += 512) { const int i = idx >> 7, d = idx & 127; float sm = 0.f;
#pragma unroll 8
            for (int j = 0; j < 128; ++j) sm += Wsg[i * 128 + j] * Vn[j * 128 + d];
            bf16* up = P + (size_t)(row0 + i) * PW + PU + g * 128 + d; *up = (bf16)f2bf(bf2f(*up) * (sm + bsg[i])); }
        __syncthreads();
    }
}

#define XB_TMO      128
#define XB_XCNT(j)  (256  + 64 * (j))
#define XB_XSUB(j)  (1280 + 64 * (j))
#define XB_XGEN(j)  (2304 + 64 * (j))
#define XB_TOP      3328
#define XB_TOPGEN   3392
#define XCD_BAR_WORDS 3456
#define XB_SPIN_CAP (1u << 22)
__device__ __forceinline__ unsigned xb_ld(unsigned* p)              { return __hip_atomic_load(p, __ATOMIC_RELAXED, __HIP_MEMORY_SCOPE_AGENT); }
__device__ __forceinline__ unsigned xb_add(unsigned* p, unsigned v) { return __hip_atomic_fetch_add(p, v, __ATOMIC_RELAXED, __HIP_MEMORY_SCOPE_AGENT); }
__device__ __forceinline__ unsigned xb_xcc_id() { return (unsigned)__builtin_amdgcn_s_getreg((3 << 11) | 20) & 0xFu; }
#define XB_SPIN(cond, bar) do { unsigned _sp = 0; while (cond) { __builtin_amdgcn_s_sleep(1); \
    if ((++_sp & 255u) == 0u) { if (xb_ld(&(bar)[XB_TMO])) break; if (_sp > XB_SPIN_CAP) { atomicAdd(&(bar)[XB_TMO], 1u); break; } } } } while (0)
struct XcdBarrier { unsigned* bar; unsigned x; volatile LAS unsigned* st; };
__device__ __forceinline__ XcdBarrier xcd_barrier_post(unsigned* bar, volatile LAS unsigned* st) {
    XcdBarrier b; b.bar = bar; b.x = xb_xcc_id(); b.st = st;
    if (threadIdx.x == 0) (void)xb_add(&bar[XB_XCNT(b.x)], 1u);
    return b;
}
__device__ __forceinline__ void xcd_barrier_complete(unsigned* bar, unsigned x, unsigned& nloc, unsigned& nx) {
    const unsigned G = gridDim.x * gridDim.y * gridDim.z;
    unsigned sum, cnt, mine, sp = 0u;
    for (;;) {
        sum = 0u; cnt = 0u; mine = 0u;
#pragma unroll
        for (unsigned j = 0; j < 16; ++j) { const unsigned c = xb_ld(&bar[XB_XCNT(j)]); sum += c; cnt += (c > 0u) ? 1u : 0u; mine = (j == x) ? c : mine; }
        if (sum == G) break;
        __builtin_amdgcn_s_sleep(1);
        if ((++sp & 255u) == 0u) { if (xb_ld(&bar[XB_TMO])) break; if (sp > XB_SPIN_CAP) { atomicAdd(&bar[XB_TMO], 1u); break; } }
    }
    nloc = mine > 0u ? mine : 1u; nx = cnt > 0u ? cnt : 1u;
}
__device__ __forceinline__ void xcd_barrier(const XcdBarrier& b) {
    asm volatile("s_waitcnt vmcnt(0)" ::: "memory");
    __syncthreads();
    if (threadIdx.x == 0) {
        unsigned* bar = b.bar;
        __builtin_amdgcn_s_waitcnt(0);
        unsigned nloc = b.st[0], nx = b.st[1];
        if (nloc == 0u) { xcd_barrier_complete(bar, b.x, nloc, nx); b.st[0] = nloc; b.st[1] = nx; }
        const unsigned old = xb_add(&bar[XB_XSUB(b.x)], 1u);
        const unsigned gen = old / nloc;
        if (old + 1u == (gen + 1u) * nloc) {
            __builtin_amdgcn_fence(__ATOMIC_RELEASE, "agent");
            asm volatile("s_waitcnt vmcnt(0)" ::: "memory");
            const unsigned og = xb_add(&bar[XB_TOP], 1u);
            const unsigned tg = og / nx;
            if (og + 1u == (tg + 1u) * nx) xb_add(&bar[XB_TOPGEN], 1u);
            else XB_SPIN(xb_ld(&bar[XB_TOPGEN]) == tg, bar);
            __builtin_amdgcn_fence(__ATOMIC_ACQUIRE, "agent");
            xb_add(&bar[XB_XGEN(b.x)], 1u);
            asm volatile("s_waitcnt vmcnt(0)" ::: "memory");
        } else {
            XB_SPIN(xb_ld(&bar[XB_XGEN(b.x)]) == gen, bar);
            __builtin_amdgcn_fence(__ATOMIC_ACQUIRE, "agent");
            asm volatile("s_waitcnt vmcnt(0)" ::: "memory");
        }
    }
    __syncthreads();
}

constexpr int LDS_BYTES = 147456, LDS_MISC = 139264;
constexpr int CW_BAR = 4096;
constexpr int NPHASE = 22;
__global__ void __launch_bounds__(512, 2) mk_fwd(Args args) {
    extern __shared__ __attribute__((aligned(16))) unsigned char lds[];
    Frame F; F.lds = (LAS unsigned char*)lds; F.tid = threadIdx.x; F.lane = F.tid & 63; F.wave = __builtin_amdgcn_readfirstlane(F.tid >> 6); F.nw = 8; F.G = gridDim.x; F.bid = blockIdx.x; F.a = &args;
    const int lo = args.ph_lo, hi = args.ph_hi;
    volatile LAS unsigned* MISC = (volatile LAS unsigned*)(F.lds + LDS_MISC);
    if (F.tid < 64) MISC[F.tid] = 0u;
    __syncthreads();
    XcdBarrier bar; bar.bar = (unsigned*)(args.ws + WS_CTL) + CW_BAR; bar.x = 0; bar.st = MISC + 8;
    if (hi - lo > 1) bar = xcd_barrier_post((unsigned*)(args.ws + WS_CTL) + CW_BAR, MISC + 8);
#define IN(k) (lo <= (k) && (k) < hi)
#define SEAM(k) do { if (IN(k) && IN((k) + 1)) { XcdBarrier b2_ = bar; asm volatile("" : "+s"(b2_.bar)); xcd_barrier(b2_); } } while (0)
#define FRESH(Fp) Frame Fp = F; { int t_ = threadIdx.x; asm volatile("" : "+v"(t_)); Fp.tid = t_; Fp.lane = t_ & 63; Fp.wave = __builtin_amdgcn_readfirstlane(t_ >> 6); }
    if (IN(0)) { FRESH(Fp); phase_prologue(Fp); } SEAM(0);
#pragma unroll 1
    for (int l = 0; l < 2; ++l) {
        const int base = 1 + 10 * l;
        if (IN(base + 0)) { FRESH(Fp); phase_norm1(Fp, l); } SEAM(base + 0);
        if (IN(base + 1)) { ProbIn p{&args, l}; pg8::gemm_phase(F.lds, p, F.G, F.bid); } SEAM(base + 1);
        if (IN(base + 2)) { FRESH(Fp); phase_ssd_seq(Fp, l); } SEAM(base + 2);
        if (IN(base + 3)) { { FRESH(Fp); phase_ssdin(Fp, l); } { FRESH(Fp); phase_sgu_simple(Fp, l); } } SEAM(base + 3);
        if (IN(base + 4)) { { ProbMix<0> p{&args, l}; pg8::gemm_phase(F.lds, p, F.G, F.bid); } { ProbMix<1> p{&args, l}; pg8::gemm_phase(F.lds, p, F.G, F.bid); } } SEAM(base + 4);
        if (IN(base + 5)) { ProbMix<2> p{&args, l}; pg8::gemm_phase(F.lds, p, F.G, F.bid); } SEAM(base + 5);
        if (IN(base + 6)) { FRESH(Fp); phase_norm2(Fp, l); } SEAM(base + 6);
        if (IN(base + 7)) { FRESH(Fp); phase_topk(Fp, l); } SEAM(base + 7);
        if (IN(base + 8)) { ProbMoe<0> p{&args, l}; pg8::gemm_phase(F.lds, p, F.G, F.bid); } SEAM(base + 8);
        if (IN(base + 9)) { ProbMoe<1> p{&args, l}; pg8::gemm_phase(F.lds, p, F.G, F.bid); } SEAM(base + 9);
    }
    if (IN(21)) { FRESH(Fp); phase_final(Fp); }
#undef IN
#undef SEAM
#undef FRESH
}

#ifndef MK_ONE_LAUNCH
#define MK_ONE_LAUNCH 1
#endif
#ifndef STOP_AT
#define STOP_AT 99
#endif
__global__ void k_dump(float* o, size_t base, const unsigned char* src, int mode, size_t n) { for (size_t i = (size_t)blockIdx.x * blockDim.x + threadIdx.x; i < n; i += (size_t)gridDim.x * blockDim.x) {
    float v = mode == 0 ? bf2f(((const bf16*)src)[i]) : (mode == 1 ? ((const float*)src)[i] : (float)((const int*)src)[i]); o[base + i] = v; } }
#ifndef DUMP_SET
#define DUMP_SET 0
#endif
__global__ void k_fill(float* o, size_t n) { for (size_t i = (size_t)blockIdx.x * blockDim.x + threadIdx.x; i < n; i += (size_t)gridDim.x * blockDim.x) o[i] = 0.f; }
extern "C" void kernel_launch(void* const* d_in, const int* in_sizes, int n_in, void* d_out, int out_size, void* d_ws, size_t ws_size, hipStream_t stream) {
    static int grid = 0;
    if (grid == 0) {
        if (n_in != 27 || out_size != NLAT * D || ws_size < WS_END) { fprintf(stderr, "kernel_launch: unexpected shapes (n_in %d, out %d, ws %zu < %zu)\n", n_in, out_size, ws_size, (size_t)WS_END); grid = -1; return; }
        int dev = 0, cus = 0;
        if (hipGetDevice(&dev) != hipSuccess || hipDeviceGetAttribute(&cus, hipDeviceAttributeMultiprocessorCount, dev) != hipSuccess) { grid = -1; return; }
        if (hipFuncSetAttribute((const void*)mk_fwd, hipFuncAttributeMaxDynamicSharedMemorySize, LDS_BYTES) != hipSuccess) { grid = -1; return; }
        if (hipFuncSetAttribute((const void*)k_sgu_naive, hipFuncAttributeMaxDynamicSharedMemorySize, 128 * 128 * 4 + 1024) != hipSuccess) { grid = -1; return; }
        (void)hipGetLastError();
        grid = cus;
    }
    if (grid < 0) return;
    (void)hipMemsetAsync((char*)d_ws + WS_CTL, 0, CTL_ZERO_BYTES, stream);
    Args a{};
    for (int i = 0; i < 27; ++i) a.in[i] = (const float*)d_in[i];
    a.out = (float*)d_out; a.ws = (unsigned char*)d_ws;
    auto run = [&](int lo, int hi) { a.ph_lo = lo; a.ph_hi = hi; hipLaunchKernelGGL(mk_fwd, dim3(grid), dim3(512), LDS_BYTES, stream, a); };
#if MK_ONE_LAUNCH
    run(0, NPHASE);
#else
    for (int ph = 0; ph < NPHASE; ++ph) run(ph, ph + 1);
#endif
}
```

```cpp
#include <hip/hip_runtime.h>
#include <cstdio>
#include <cstdint>

#ifndef USE_SSD_SEQ
#define USE_SSD_SEQ 0
#endif
#ifndef REPEAT_PH
#define REPEAT_PH -1
#endif
#define GAS __attribute__((address_space(1)))
#define LAS __attribute__((address_space(3)))
typedef unsigned short bf16;
typedef unsigned v4u __attribute__((ext_vector_type(4)));
typedef unsigned v2u __attribute__((ext_vector_type(2)));
typedef float f32x4 __attribute__((ext_vector_type(4)));
typedef float f32x2 __attribute__((ext_vector_type(2)));
typedef short bf16x8 __attribute__((ext_vector_type(8)));

constexpr int D = 1024, NB = 16, SEQ = 2048, CTXL = 256, NLAT = NB * SEQ, NCTX = NB * CTXL, NROW = NLAT + NCTX;
constexpr int HEADS = 16, HD = 64, NST = 128, NIN = 7200;
constexpr int NEXP = 16, CAP_L = 256, CAP_C = 32;
constexpr float EPS = 1e-6f;
constexpr int PW = 7168, PX = 0, PB = 1024, PC = 1536, PZ = 2048, PU = 3072, PV = 4096, PGA = 5120, PGB = 6144;
constexpr int WIN_ROWS = 7424;
constexpr int NLIST = NB * NEXP * CAP_L + NEXP * NB * CAP_C;
constexpr int LIST_C0 = NB * NEXP * CAP_L;

constexpr size_t MiB = 1u << 20;
constexpr size_t WS_CTL = 0, CTL_ZERO_BYTES = 1 * MiB;
constexpr size_t WS_MOD = 1 * MiB;
constexpr size_t WS_WST = 2 * MiB;
constexpr size_t WS_VSTAT = 2 * MiB + 512 * 1024;
constexpr size_t WS_DT = 3 * MiB;
constexpr size_t WS_AFF = 8 * MiB;
constexpr size_t WS_INV = 11 * MiB;
constexpr size_t WS_IDX = 14 * MiB;
constexpr size_t WS_GATE = 14 * MiB + 512 * 1024;
constexpr size_t WS_WIN = 16 * MiB;
constexpr size_t WS_WMIX = 45 * MiB;
constexpr size_t WS_HC = 57 * MiB;
constexpr size_t WS_XM = 73 * MiB;
constexpr size_t WS_P = 145 * MiB;
constexpr size_t WS_END = 649 * MiB;
constexpr size_t PO_WGU = 0, PO_WD = 64 * MiB, PO_HID = 96 * MiB, PO_YM = 240 * MiB;

typedef __bf16 bf16x2_t __attribute__((ext_vector_type(2)));
__device__ __forceinline__ unsigned pk2(float lo, float hi) { const f32x2 v = {lo, hi}; return __builtin_bit_cast(unsigned, __builtin_convertvector(v, bf16x2_t)); }
__device__ __forceinline__ unsigned f2bf(float f) { return pk2(f, 0.f) & 0xffffu; }
__device__ __forceinline__ float bflo(unsigned w) { return __builtin_bit_cast(float, w << 16); }
__device__ __forceinline__ float bfhi(unsigned w) { return __builtin_bit_cast(float, w & 0xffff0000u); }
__device__ __forceinline__ float bf2f(bf16 b) { return __builtin_bit_cast(float, ((unsigned)b) << 16); }
__device__ __forceinline__ float rcpf_(float x) { return __builtin_amdgcn_rcpf(x); }
__device__ __forceinline__ float sigmoidf_(float x) { return rcpf_(1.0f + __expf(-x)); }
__device__ __forceinline__ float siluf_(float x) { return x * rcpf_(1.0f + __expf(-x)); }
__device__ __forceinline__ float gelu_tanh(float x) { const float u = 1.5957691216057308f * (x + 0.044715f * x * x * x); return x * rcpf_(1.0f + __expf(-u)); }
__device__ __forceinline__ float softplusf_(float x) { return fmaxf(x, 0.f) + log1pf(__expf(-fabsf(x))); }
__device__ __forceinline__ float wave_sum(float v) {
#pragma unroll
    for (int o = 1; o < 64; o <<= 1) v += __shfl_xor(v, o);
    return v;
}
__device__ __forceinline__ v2u pack4(f32x4 v) { v2u r; r.x = pk2(v.x, v.y); r.y = pk2(v.z, v.w); return r; }
__device__ __forceinline__ f32x4 unpack4(v2u w) { return (f32x4){bflo(w.x), bfhi(w.x), bflo(w.y), bfhi(w.y)}; }

struct Args { const float* in[27]; float* out; unsigned char* ws; int ph_lo, ph_hi; };
enum { I_X = 0, I_C, I_CTX, I_CCTX, I_ADAW, I_ADAB, I_N1W, I_N2W, I_WIN, I_CONVW, I_CONVB, I_DTB, I_ALOG, I_DSKIP, I_SSDNW, I_LNW, I_LNB, I_WS, I_BS, I_WPA, I_WPB, I_WO, I_RW, I_WG, I_WU, I_WD, I_FNW };

struct Frame {
    LAS unsigned char* lds; int tid, lane, wave, nw, G, bid;
    const Args* a;
};
__device__ __forceinline__ const float* modp(const Args& a, int l, int br) { return (const float*)(a.ws + WS_MOD) + (size_t)(l * 17 + br) * 6144; }
__device__ __forceinline__ int batch_row(int r) { return r < NLAT ? (r >> 11) : 16; }

struct Unit { const bf16* A; const bf16* B; const int* gidx; int lda, a_row0, pm, pn, aux; };

struct ProbIn {      static constexpr bool GATHER = false;
    const Args* a; int l;
    __device__ int nunits() const { return l == 0 ? 144 * 29 : 128 * 29 + 16 * 9; }
    __device__ void unit(int L, Unit& u) const {
        int pm, pn;
        const int nfull = (l == 0 ? 144 : 128), nun = nunits();
        const int wg = (L & 7) * (nun >> 3) + (L >> 3);
        if (wg < nfull * 29) { const int grp = wg / (8 * 29), w = wg % (8 * 29); pm = grp * 8 + (w & 7); pn = w >> 3; }
        else { const int w = wg - nfull * 29, g2 = w / 72, w2 = w % 72; pm = 128 + g2 * 8 + (w2 & 7); const int q = w2 >> 3; pn = q < 8 ? q : 28; }
        u.A = (const bf16*)(a->ws + WS_XM); u.lda = D; u.a_row0 = pm * 256; u.gidx = nullptr; u.pm = pm; u.pn = pn; u.aux = 0;
        u.B = (const bf16*)(a->ws + WS_WIN) + ((size_t)l * WIN_ROWS + (size_t)pn * 256) * D;
    }
    __device__ __forceinline__ void epi(const Unit& u, int r, int c, f32x4 lo0, f32x4 lo1, f32x4 hi0, f32x4 hi1) const {
        const int row = u.pm * 256 + r, pn = u.pn;
        if (pn == 28) {
            if (c < 32) { float* dt = (float*)(a->ws + WS_DT) + (size_t)row * 32 + c; const float* db = a->in[I_DTB] + l * 32 + c;
                f32x4 o0, o1;
#pragma unroll
                for (int i = 0; i < 4; ++i) { o0[i] = softplusf_(lo0[i] + db[i]); o1[i] = softplusf_(lo1[i] + db[4 + i]); }
                *(f32x4*)dt = o0; *(f32x4*)(dt + 4) = o1; }
            return;
        }
        if (pn >= 8 && pn < 12) {
#pragma unroll
            for (int i = 0; i < 4; ++i) { lo0[i] = siluf_(lo0[i]); lo1[i] = siluf_(lo1[i]); hi0[i] = siluf_(hi0[i]); hi1[i] = siluf_(hi1[i]); } }
        else if (pn >= 12 && pn < 20) {
#pragma unroll
            for (int i = 0; i < 4; ++i) { lo0[i] = gelu_tanh(lo0[i]); lo1[i] = gelu_tanh(lo1[i]); hi0[i] = gelu_tanh(hi0[i]); hi1[i] = gelu_tanh(hi1[i]); } }
        else if (pn >= 20) {
#pragma unroll
            for (int i = 0; i < 4; ++i) { lo0[i] = sigmoidf_(lo0[i]); lo1[i] = sigmoidf_(lo1[i]); hi0[i] = sigmoidf_(hi0[i]); hi1[i] = sigmoidf_(hi1[i]); } }
        bf16* o = (bf16*)(a->ws + WS_P) + (size_t)row * PW + pn * 256 + c;
        v4u w; w.x = pk2(lo0[0], lo0[1]); w.y = pk2(lo0[2], lo0[3]); w.z = pk2(lo1[0], lo1[1]); w.w = pk2(lo1[2], lo1[3]); *(v4u*)o = w;
        w.x = pk2(hi0[0], hi0[1]); w.y = pk2(hi0[2], hi0[3]); w.z = pk2(hi1[0], hi1[1]); w.w = pk2(hi1[2], hi1[3]); *(v4u*)(o + 128) = w;
    }
};

template <int MODE> struct ProbMix {
    static constexpr bool GATHER = false;
    const Args* a; int l;
    __device__ int nunits() const { return (l == 0 ? 144 : 128) * 4; }
    __device__ void unit(int L, Unit& u) const {
        const int wg = (L & 7) * (nunits() >> 3) + (L >> 3);
        const int grp = wg / 32, w = wg % 32; const int pm = grp * 8 + (w & 7), pn = w >> 3;
        u.pm = pm; u.pn = pn; u.aux = 0; u.gidx = nullptr; u.a_row0 = pm * 256;
        if (MODE == 0) { u.A = (const bf16*)(a->ws + WS_P) + PZ; u.lda = PW; }
        else if (MODE == 1) { u.A = (const bf16*)(a->ws + WS_P) + PU; u.lda = PW; }
        else { u.A = (const bf16*)(a->ws + WS_XM); u.lda = D; }
        u.B = (const bf16*)(a->ws + WS_WMIX) + ((size_t)(l * 3 + MODE) * D + (size_t)pn * 256) * D;
    }
    __device__ __forceinline__ void epi(const Unit& u, int r, int c, f32x4 lo0, f32x4 lo1, f32x4 hi0, f32x4 hi1) const {
        const int row = u.pm * 256 + r, col = u.pn * 256 + c;
        if (MODE == 0) {
            bf16* g = (bf16*)(a->ws + WS_P) + (size_t)row * PW + PGA + col;
            v4u gl = *(const v4u*)g, gh = *(const v4u*)(g + 128), w;
            w.x = pk2(bflo(gl.x) * lo0[0], bfhi(gl.x) * lo0[1]); w.y = pk2(bflo(gl.y) * lo0[2], bfhi(gl.y) * lo0[3]); w.z = pk2(bflo(gl.z) * lo1[0], bfhi(gl.z) * lo1[1]); w.w = pk2(bflo(gl.w) * lo1[2], bfhi(gl.w) * lo1[3]); *(v4u*)g = w;
            w.x = pk2(bflo(gh.x) * hi0[0], bfhi(gh.x) * hi0[1]); w.y = pk2(bflo(gh.y) * hi0[2], bfhi(gh.y) * hi0[3]); w.z = pk2(bflo(gh.z) * hi1[0], bfhi(gh.z) * hi1[1]); w.w = pk2(bflo(gh.w) * hi1[2], bfhi(gh.w) * hi1[3]); *(v4u*)(g + 128) = w;
        } else if (MODE == 1) {
            const bf16* t = (const bf16*)(a->ws + WS_P) + (size_t)row * PW + PGA + col; const bf16* g = t + (PGB - PGA);
            bf16* o = (bf16*)(a->ws + WS_XM) + (size_t)row * D + col;
            v4u tl = *(const v4u*)t, th = *(const v4u*)(t + 128), gl = *(const v4u*)g, gh = *(const v4u*)(g + 128), w;
            w.x = pk2(bflo(tl.x) + bflo(gl.x) * lo0[0], bfhi(tl.x) + bfhi(gl.x) * lo0[1]); w.y = pk2(bflo(tl.y) + bflo(gl.y) * lo0[2], bfhi(tl.y) + bfhi(gl.y) * lo0[3]);
            w.z = pk2(bflo(tl.z) + bflo(gl.z) * lo1[0], bfhi(tl.z) + bfhi(gl.z) * lo1[1]); w.w = pk2(bflo(tl.w) + bflo(gl.w) * lo1[2], bfhi(tl.w) + bfhi(gl.w) * lo1[3]); *(v4u*)o = w;
            w.x = pk2(bflo(th.x) + bflo(gh.x) * hi0[0], bfhi(th.x) + bfhi(gh.x) * hi0[1]); w.y = pk2(bflo(th.y) + bflo(gh.y) * hi0[2], bfhi(th.y) + bfhi(gh.y) * hi0[3]);
            w.z = pk2(bflo(th.z) + bflo(gh.z) * hi1[0], bfhi(th.z) + bfhi(gh.z) * hi1[1]); w.w = pk2(bflo(th.w) + bflo(gh.w) * hi1[2], bfhi(th.w) + bfhi(gh.w) * hi1[3]); *(v4u*)(o + 128) = w;
        } else {
            const bool lat = row < NLAT;
            const float* hin = (l == 0) ? (lat ? a->in[I_X] + (size_t)row * D : a->in[I_CTX] + (size_t)(row - NLAT) * D) : (lat ? a->out + (size_t)row * D : (const float*)(a->ws + WS_HC) + (size_t)(row - NLAT) * D);
            float* hout = lat ? a->out + (size_t)row * D : (float*)(a->ws + WS_HC) + (size_t)(row - NLAT) * D;
            const float* g1 = modp(*a, l, batch_row(row)) + 2048 + col;
            hin += col; hout += col;
            *(f32x4*)hout = *(const f32x4*)hin + *(const f32x4*)g1 * lo0; *(f32x4*)(hout + 4) = *(const f32x4*)(hin + 4) + *(const f32x4*)(g1 + 4) * lo1;
            *(f32x4*)(hout + 128) = *(const f32x4*)(hin + 128) + *(const f32x4*)(g1 + 128) * hi0; *(f32x4*)(hout + 132) = *(const f32x4*)(hin + 132) + *(const f32x4*)(g1 + 132) * hi1;
        }
    }
};

template <int MODE> struct ProbMoe {
    static constexpr bool GATHER = (MODE == 0);
    const Args* a; int l;
    __device__ int nunits() const { const int per = MODE == 0 ? 8 : 4; return (256 + (l == 0 ? 32 : 0)) * per; }
    __device__ void unit(int L, Unit& u) const {
        constexpr int per = MODE == 0 ? 8 : 4;
        const int x = L & 7, off = L >> 3;
        int pn, t;
        if (off < 32 * per) { const int e = 2 * x + off / (16 * per), r = off % (16 * per); t = (r / per) * 16 + e; pn = r % per; }
        else { const int o = off - 32 * per; t = 256 + 4 * x + o / per; pn = o % per; }
        const int e = t < 256 ? (t & 15) : ((t - 256) >> 1);
        const int list0 = t < 256 ? t * 256 : LIST_C0 + (t - 256) * 256;
        u.pm = t; u.pn = pn; u.aux = list0;
        if (MODE == 0) { u.A = (const bf16*)(a->ws + WS_XM); u.lda = D; u.a_row0 = 0; u.gidx = (const int*)(a->ws + WS_IDX) + list0;
            u.B = (const bf16*)(a->ws + WS_P + PO_WGU) + ((size_t)e * 2048 + (size_t)pn * 256) * D; }
        else { u.A = (const bf16*)(a->ws + WS_P + PO_HID); u.lda = D; u.a_row0 = list0; u.gidx = nullptr;
            u.B = (const bf16*)(a->ws + WS_P + PO_WD) + ((size_t)e * 1024 + (size_t)pn * 256) * D; }
    }
    __device__ __forceinline__ void epi(const Unit& u, int r, int c, f32x4 lo0, f32x4 lo1, f32x4 hi0, f32x4 hi1) const {
        const size_t hrow = (size_t)u.aux + r;
        if (MODE == 0) {
            bf16* o = (bf16*)(a->ws + WS_P + PO_HID) + hrow * D + u.pn * 128 + c;
            v4u w; w.x = pk2(siluf_(lo0[0]) * hi0[0], siluf_(lo0[1]) * hi0[1]); w.y = pk2(siluf_(lo0[2]) * hi0[2], siluf_(lo0[3]) * hi0[3]);
            w.z = pk2(siluf_(lo1[0]) * hi1[0], siluf_(lo1[1]) * hi1[1]); w.w = pk2(siluf_(lo1[2]) * hi1[2], siluf_(lo1[3]) * hi1[3]); *(v4u*)o = w;
        } else {
            const float gt = ((const float*)(a->ws + WS_GATE))[hrow];
            bf16* o = (bf16*)(a->ws + WS_P + PO_YM) + hrow * D + u.pn * 256 + c;
            v4u w; w.x = pk2(gt * lo0[0], gt * lo0[1]); w.y = pk2(gt * lo0[2], gt * lo0[3]); w.z = pk2(gt * lo1[0], gt * lo1[1]); w.w = pk2(gt * lo1[2], gt * lo1[3]); *(v4u*)o = w;
            w.x = pk2(gt * hi0[0], gt * hi0[1]); w.y = pk2(gt * hi0[2], gt * hi0[3]); w.z = pk2(gt * hi1[0], gt * hi1[1]); w.w = pk2(gt * hi1[2], gt * hi1[3]); *(v4u*)(o + 128) = w;
        }
    }
};


namespace pg8 {
constexpr int BM = 256, BK = 64, HALF = 128, HTB = HALF * BK * 2, STAGE_BYTES = 8 * HTB;
__device__ __forceinline__ int lds_byte(int r, int c) { const int st = (r >> 4) * 2 + (c >> 5), rr = r & 15, cc = c & 31, ob = rr * 64 + cc * 2; return st * 1024 + (ob ^ (((ob >> 9) & 1) << 5)); }
__device__ __forceinline__ void stage_rc(int b, int& R, int& C) { const int st = b / 1024, sb = b % 1024, swz = sb ^ (((sb >> 9) & 1) << 5); R = (st >> 1) * 16 + swz / 64; C = (st & 1) * 32 + (swz % 64) / 2; }
__device__ __forceinline__ int perm32(int rho) { const int n = rho >> 4, i = rho & 15; return 8 * (i >> 2) + 4 * n + (i & 3); }

template <bool GATHER> __device__ __forceinline__ void unit_voffA(const Unit& u, int tid, unsigned (&vo)[4]) {
#pragma unroll
    for (int h = 0; h < 2; ++h)
#pragma unroll
        for (int i = 0; i < 2; ++i) { int R, C; stage_rc(tid * 16 + i * 8192, R, C); const int r = h * HALF + R;
            if (GATHER) { int row = u.gidx[r]; row = (unsigned)row < (unsigned)NROW ? row : 0; vo[h * 2 + i] = ((unsigned)row * (unsigned)u.lda + (unsigned)C) * 2u; }
            else vo[h * 2 + i] = ((unsigned)r * (unsigned)u.lda + (unsigned)C) * 2u; }
}

__device__ __forceinline__ __amdgpu_buffer_rsrc_t mk_rsrc(const char* p) {
    const unsigned long long v = (unsigned long long)p;
    const unsigned lo = __builtin_amdgcn_readfirstlane((unsigned)v), hi = __builtin_amdgcn_readfirstlane((unsigned)(v >> 32));
    return __builtin_amdgcn_make_buffer_rsrc((void*)(((unsigned long long)hi << 32) | lo), 0, 0x7fffffff, 0x00020000);
}

template <class Prob>
__device__ __forceinline__ void gemm_phase(LAS unsigned char* lds, const Prob& prob, int G, int bid) {
    constexpr bool GATHER = Prob::GATHER;
    int tid_ = threadIdx.x; asm volatile("" : "+v"(tid_));
    const int tid = tid_, wid = __builtin_amdgcn_readfirstlane(tid >> 6), lane = tid & 63, wr = wid >> 2, wc = wid & 3, fr = lane & 15, fq = lane >> 4;
    constexpr int K = 1024, nt = K / BK;
    unsigned voffB[2];
#pragma unroll
    for (int i = 0; i < 2; ++i) { int R, C; stage_rc(tid * 16 + i * 8192, R, C); const int Rb = (R & ~31) + perm32(R & 31); voffB[i] = (unsigned)(Rb * K + C) * 2u; }
    constexpr int kstep = BK * 2;
    constexpr int hstep = HALF * K * 2;
    const unsigned ldsw = (unsigned)wid * 1024u;
    const int aoff = lds_byte(wr * 64 + fr, fq * 8), boff = lds_byte(wc * 32 + fr, fq * 8);
#define PG8_SA(b, h) (((b) * 2 + (h)) * HTB)
#define PG8_SB(b, h) ((4 + (b) * 2 + (h)) * HTB)
#define PG8_STAGE2(bufoff, rsrc, v0, v1, soff) do { \
        __builtin_amdgcn_raw_ptr_buffer_load_lds(rsrc, (LAS unsigned*)(lds + (bufoff) + ldsw), 16, (int)(v0), (int)(soff), 0, 0); \
        __builtin_amdgcn_raw_ptr_buffer_load_lds(rsrc, (LAS unsigned*)(lds + (bufoff) + ldsw + 8192), 16, (int)(v1), (int)(soff), 0, 0); } while (0)
#define PG8_STAGEB(bufoff, rsrc, soff) PG8_STAGE2(bufoff, rsrc, voffB[0], voffB[1], soff)
#define PG8_LDA(dst, b, h) do { _Pragma("unroll") for (int m = 0; m < 4; ++m) _Pragma("unroll") for (int k = 0; k < 2; ++k) dst[m][k] = *(const LAS bf16x8*)(lds + PG8_SA(b, h) + aoff + m * 2048 + k * 1024); } while (0)
#define PG8_LDB(dst, b, h) do { _Pragma("unroll") for (int n = 0; n < 2; ++n) _Pragma("unroll") for (int k = 0; k < 2; ++k) dst[n][k] = *(const LAS bf16x8*)(lds + PG8_SB(b, h) + boff + n * 2048 + k * 1024); } while (0)
#define PG8_MMA(ai, bj, At, Bt) do { __builtin_amdgcn_s_setprio(1); _Pragma("unroll") for (int m = 0; m < 4; ++m) _Pragma("unroll") for (int n = 0; n < 2; ++n) _Pragma("unroll") for (int k = 0; k < 2; ++k) \
        acc[ai][bj][m][n] = __builtin_amdgcn_mfma_f32_16x16x32_bf16(Bt[n][k], At[m][k], acc[ai][bj][m][n], 0, 0, 0); __builtin_amdgcn_s_setprio(0); } while (0)
#define PG8_WAIT_V(n) asm volatile("s_waitcnt vmcnt(" #n ")" ::: "memory")
#define PG8_WAIT_L(n) asm volatile("s_waitcnt lgkmcnt(" #n ")" ::: "memory")
#define PG8_BAR __builtin_amdgcn_s_barrier()
#define PG8_SCHED __builtin_amdgcn_sched_barrier(0)
    const int nun = prob.nunits();
    int L = bid;
    if (L >= nun) return;
    Unit cur, nxt; prob.unit(L, cur);
    unsigned voA[4], nvoA[4];
    unit_voffA<GATHER>(cur, tid, voA);
    const char* cA = (const char*)cur.A + (GATHER ? (size_t)0 : (size_t)cur.a_row0 * cur.lda * 2); const char* cB = (const char*)cur.B;
    {
        const __amdgpu_buffer_rsrc_t rA = mk_rsrc(cA), rB = mk_rsrc(cB);
        PG8_STAGEB(PG8_SB(0, 0), rB, 0); PG8_STAGEB(PG8_SB(0, 1), rB, hstep); PG8_STAGE2(PG8_SA(0, 0), rA, voA[0], voA[1], 0); PG8_STAGE2(PG8_SA(0, 1), rA, voA[2], voA[3], 0);
        if (wr == 1) PG8_BAR;
        PG8_WAIT_V(2); PG8_BAR;
        PG8_STAGEB(PG8_SB(1, 0), rB, kstep); PG8_STAGE2(PG8_SA(1, 0), rA, voA[0], voA[1], kstep); PG8_STAGEB(PG8_SB(1, 1), rB, hstep + kstep);
        PG8_WAIT_V(6); PG8_BAR; PG8_SCHED;
    }
    f32x4 acc[2][2][4][2];
#pragma unroll
    for (int a = 0; a < 2; ++a)
#pragma unroll
        for (int b = 0; b < 2; ++b)
#pragma unroll
            for (int m = 0; m < 4; ++m)
#pragma unroll
                for (int n = 0; n < 2; ++n) acc[a][b][m][n] = (f32x4){0.f, 0.f, 0.f, 0.f};
    bf16x8 At[4][2], B0[2][2], B1[2][2];
    for (;;) {
        const bool has_next = (L + G < nun);
        const char* nA = cA; const char* nB = cB;
#pragma unroll
        for (int i = 0; i < 4; ++i) nvoA[i] = voA[i];
        if (has_next) { prob.unit(L + G, nxt); if (GATHER) unit_voffA<GATHER>(nxt, tid, nvoA); nA = (const char*)nxt.A + (GATHER ? (size_t)0 : (size_t)nxt.a_row0 * nxt.lda * 2); nB = (const char*)nxt.B; }
        const __amdgpu_buffer_rsrc_t rA1 = mk_rsrc(cA);
        for (int t = 0; t < nt; t += 2) {
            const bool last = (t == nt - 2);
            const __amdgpu_buffer_rsrc_t rA2 = mk_rsrc(last ? nA : cA), rB2 = mk_rsrc(last ? nB : cB);
            const int o1 = (t + 1) * kstep, o2 = last ? 0 : (t + 2) * kstep, o3 = o2 + kstep;
            const unsigned s0 = (GATHER && last) ? nvoA[0] : voA[0], s1 = (GATHER && last) ? nvoA[1] : voA[1], s2 = (GATHER && last) ? nvoA[2] : voA[2], s3 = (GATHER && last) ? nvoA[3] : voA[3];
            PG8_LDB(B0, 0, 0); PG8_LDB(B1, 0, 1); PG8_SCHED; PG8_LDA(At, 0, 0); PG8_STAGE2(PG8_SA(1, 1), rA1, voA[2], voA[3], o1);
            PG8_WAIT_V(8); PG8_WAIT_L(0); PG8_BAR; PG8_MMA(0, 0, At, B0); PG8_MMA(0, 1, At, B1); PG8_BAR; PG8_SCHED;
            PG8_LDA(At, 0, 1); PG8_STAGEB(PG8_SB(0, 0), rB2, o2); PG8_STAGEB(PG8_SB(0, 1), rB2, o2 + hstep); PG8_STAGE2(PG8_SA(0, 0), rA2, s0, s1, o2);
            PG8_WAIT_V(8); PG8_WAIT_L(0); PG8_BAR; PG8_MMA(1, 0, At, B0); PG8_MMA(1, 1, At, B1); PG8_BAR; PG8_SCHED;
            PG8_LDB(B0, 1, 0); PG8_LDB(B1, 1, 1); PG8_SCHED; PG8_LDA(At, 1, 0); PG8_STAGE2(PG8_SA(0, 1), rA2, s2, s3, o2);
            PG8_WAIT_V(8); PG8_WAIT_L(0); PG8_BAR; PG8_MMA(0, 0, At, B0); PG8_MMA(0, 1, At, B1); PG8_BAR; PG8_SCHED;
            PG8_LDA(At, 1, 1); PG8_STAGEB(PG8_SB(1, 0), rB2, o3); PG8_STAGEB(PG8_SB(1, 1), rB2, o3 + hstep); PG8_STAGE2(PG8_SA(1, 0), rA2, s0, s1, o3);
            PG8_WAIT_V(8); PG8_WAIT_L(0); PG8_BAR; PG8_MMA(1, 0, At, B0); PG8_MMA(1, 1, At, B1); PG8_BAR; PG8_SCHED;
        }
        if (wr == 0) PG8_BAR;
#pragma unroll
        for (int ai = 0; ai < 2; ++ai)
#pragma unroll
            for (int m = 0; m < 4; ++m) { prob.epi(cur, ai * HALF + wr * 64 + m * 16 + fr, wc * 32 + fq * 8, acc[ai][0][m][0], acc[ai][0][m][1], acc[ai][1][m][0], acc[ai][1][m][1]); PG8_SCHED; }
        if (!has_next) break;
#pragma unroll
        for (int a = 0; a < 2; ++a)
#pragma unroll
            for (int b = 0; b < 2; ++b)
#pragma unroll
                for (int m = 0; m < 4; ++m)
#pragma unroll
                    for (int n = 0; n < 2; ++n) acc[a][b][m][n] = (f32x4){0.f, 0.f, 0.f, 0.f};
        cur = nxt; cA = nA; cB = nB; L += G;
#pragma unroll
        for (int i = 0; i < 4; ++i) voA[i] = nvoA[i];
        if (wr == 1) PG8_BAR;
    }
    PG8_WAIT_V(0);
    PG8_BAR;
#undef PG8_SA
#undef PG8_SB
#undef PG8_STAGE2
#undef PG8_STAGEB
#undef PG8_LDA
#undef PG8_LDB
#undef PG8_MMA
#undef PG8_WAIT_V
#undef PG8_WAIT_L
#undef PG8_BAR
#undef PG8_SCHED
}
}

template <class P> __global__ void __launch_bounds__(256) k_gemm_simple(Args args, int layer) {
    __shared__ float As[32][68]; __shared__ float Bs[32][260];
    P prob{&args, layer};
    const int L = blockIdx.x >> 2, rb = blockIdx.x & 3, tid = threadIdx.x, ty = tid >> 4, tx = tid & 15;
    if (L >= prob.nunits()) return;
    Unit u; prob.unit(L, u);
    const int ar = tid >> 2, aq = tid & 3;
    int arow = u.gidx ? u.gidx[rb * 64 + ar] : (u.a_row0 + rb * 64 + ar);
    arow = arow < 0 ? 0 : (arow >= NROW + NLIST ? 0 : arow);
    const bf16* ap = u.A + (size_t)arow * u.lda + aq * 8;
    float acc[2][4][8];
#pragma unroll
    for (int h = 0; h < 2; ++h)
#pragma unroll
        for (int i = 0; i < 4; ++i)
#pragma unroll
            for (int j = 0; j < 8; ++j) acc[h][i][j] = 0.f;
    for (int k0 = 0; k0 < D; k0 += 32) {
        v4u av = *(const v4u*)(ap + k0); v4u bv[4];
#pragma unroll
        for (int j = 0; j < 4; ++j) { const int p = tid + 256 * j; bv[j] = *(const v4u*)(u.B + (size_t)(p >> 2) * D + k0 + (p & 3) * 8); }
        __syncthreads();
        { const int kk = aq * 8; As[kk + 0][ar] = bflo(av.x); As[kk + 1][ar] = bfhi(av.x); As[kk + 2][ar] = bflo(av.y); As[kk + 3][ar] = bfhi(av.y); As[kk + 4][ar] = bflo(av.z); As[kk + 5][ar] = bfhi(av.z); As[kk + 6][ar] = bflo(av.w); As[kk + 7][ar] = bfhi(av.w); }
#pragma unroll
        for (int j = 0; j < 4; ++j) { const int p = tid + 256 * j, br = p >> 2, kk = (p & 3) * 8; Bs[kk + 0][br] = bflo(bv[j].x); Bs[kk + 1][br] = bfhi(bv[j].x); Bs[kk + 2][br] = bflo(bv[j].y); Bs[kk + 3][br] = bfhi(bv[j].y);
            Bs[kk + 4][br] = bflo(bv[j].z); Bs[kk + 5][br] = bfhi(bv[j].z); Bs[kk + 6][br] = bflo(bv[j].w); Bs[kk + 7][br] = bfhi(bv[j].w); }
        __syncthreads();
#pragma unroll 4
        for (int k = 0; k < 32; ++k) {
            const f32x4 a4 = *(const f32x4*)&As[k][ty * 4];
            const f32x4 b0 = *(const f32x4*)&Bs[k][tx * 8], b1 = *(const f32x4*)&Bs[k][tx * 8 + 4], b2 = *(const f32x4*)&Bs[k][128 + tx * 8], b3 = *(const f32x4*)&Bs[k][128 + tx * 8 + 4];
#pragma unroll
            for (int i = 0; i < 4; ++i)
#pragma unroll
                for (int j = 0; j < 4; ++j) { acc[0][i][j] += a4[i] * b0[j]; acc[0][i][4 + j] += a4[i] * b1[j]; acc[1][i][j] += a4[i] * b2[j]; acc[1][i][4 + j] += a4[i] * b3[j]; }
        }
    }
#pragma unroll
    for (int i = 0; i < 4; ++i)
        prob.epi(u, rb * 64 + ty * 4 + i, tx * 8, (f32x4){acc[0][i][0], acc[0][i][1], acc[0][i][2], acc[0][i][3]}, (f32x4){acc[0][i][4], acc[0][i][5], acc[0][i][6], acc[0][i][7]},
                 (f32x4){acc[1][i][0], acc[1][i][1], acc[1][i][2], acc[1][i][3]}, (f32x4){acc[1][i][4], acc[1][i][5], acc[1][i][6], acc[1][i][7]});
}

__global__ void __launch_bounds__(256) k_ssd_naive(Args args, int l) {
    __shared__ float xs[32][64]; __shared__ float Bsm[32][128]; __shared__ float Csm[32][128]; __shared__ float dts[32];
    const int b = blockIdx.x >> 4, h = blockIdx.x & 15, g = h >> 2, tid = threadIdx.x, p = tid >> 2, nq = tid & 3;
    const bf16* P = (const bf16*)(args.ws + WS_P); bf16* Y = (bf16*)(args.ws + WS_XM); const float* DT = (const float*)(args.ws + WS_DT);
    const float* cw = args.in[I_CONVW] + (size_t)l * 3 * 2048; const float* cb = args.in[I_CONVB] + (size_t)l * 2048;
    const float dskip = args.in[I_DSKIP][l * 16 + h];
    for (int dir = 0; dir < 2; ++dir) {
        float st[32];
#pragma unroll
        for (int i = 0; i < 32; ++i) st[i] = 0.f;
        const float Ah = -__expf(args.in[I_ALOG][(l * 2 + dir) * 16 + h]);
        for (int seg = 0; seg < 2; ++seg) {
            const int base = seg == 0 ? NLAT + b * CTXL : b * SEQ, len = seg == 0 ? CTXL : SEQ;
            const bool wy = !(l == 1 && seg == 0);
            for (int blk = 0; blk < len / 32; ++blk) {
                for (int idx = tid; idx < 32 * 320; idx += 256) {
                    const int tt = idx / 320, ch = idx % 320;
                    const int tok = dir == 0 ? blk * 32 + tt : len - 1 - (blk * 32 + tt);
                    const int col = ch < 64 ? PX + h * 64 + ch : (ch < 192 ? PB + g * 128 + (ch - 64) : PC + g * 128 + (ch - 192));
                    const bf16* pp = P + (size_t)(base + tok) * PW + col;
                    const float cur = bf2f(pp[0]), prv = tok > 0 ? bf2f(pp[-PW]) : 0.f, nxt = tok < len - 1 ? bf2f(pp[PW]) : 0.f;
                    const float v = siluf_(cw[col] * prv + cw[2048 + col] * cur + cw[4096 + col] * nxt + cb[col]);
                    if (ch < 64) xs[tt][ch] = v; else if (ch < 192) Bsm[tt][ch - 64] = v; else Csm[tt][ch - 192] = v;
                }
                if (tid < 32) { const int tok = dir == 0 ? blk * 32 + tid : len - 1 - (blk * 32 + tid); dts[tid] = DT[(size_t)(base + tok) * 32 + dir * 16 + h]; }
                __syncthreads();
                for (int tt = 0; tt < 32; ++tt) {
                    const float dt = dts[tt], dA = __expf(dt * Ah), xr = xs[tt][p], xv = xr * dt;
                    float ys = 0.f;
#pragma unroll
                    for (int i = 0; i < 32; ++i) { const int n = nq * 32 + i; st[i] = st[i] * dA + xv * Bsm[tt][n]; ys += st[i] * Csm[tt][n]; }
                    ys += __shfl_xor(ys, 1); ys += __shfl_xor(ys, 2);
                    if (nq == 0 && wy) { const int tok = dir == 0 ? blk * 32 + tt : len - 1 - (blk * 32 + tt); bf16* yp = Y + (size_t)(base + tok) * D + h * 64 + p;
                        if (dir == 0) *yp = (bf16)f2bf(ys + dskip * xr); else *yp = (bf16)f2bf(bf2f(*yp) + ys); }
                }
                __syncthreads();
            }
        }
    }
}

__global__ void __launch_bounds__(512) k_sgu_naive(Args args, int l) {
    extern __shared__ __attribute__((aligned(16))) unsigned char smem[];
    float* Vn = (float*)smem; float* mu = Vn + 128 * 128; float* rs = mu + 128;
    const int chunk = blockIdx.x >> 3, g = blockIdx.x & 7, tid = threadIdx.x, lane = tid & 63, wave = tid >> 6;
    const int row0 = chunk < 256 ? chunk * 128 : NLAT + (chunk - 256) * 128;
    bf16* P = (bf16*)(args.ws + WS_P);
    for (int rr = 0; rr < 16; ++rr) { const int j = wave * 16 + rr; const bf16* vp = P + (size_t)(row0 + j) * PW + PV;
        float v[16]; float s = 0.f;
#pragma unroll
        for (int q = 0; q < 2; ++q) { const v4u w = *(const v4u*)(vp + lane * 8 + 512 * q); v[q * 8 + 0] = bflo(w.x); v[q * 8 + 1] = bfhi(w.x); v[q * 8 + 2] = bflo(w.y); v[q * 8 + 3] = bfhi(w.y); v[q * 8 + 4] = bflo(w.z); v[q * 8 + 5] = bfhi(w.z); v[q * 8 + 6] = bflo(w.w); v[q * 8 + 7] = bfhi(w.w); }
#pragma unroll
        for (int i = 0; i < 16; ++i) s += v[i];
        const float m = wave_sum(s) * (1.f / D); float s2 = 0.f;
#pragma unroll
        for (int i = 0; i < 16; ++i) { const float d = v[i] - m; s2 += d * d; }
        const float var = wave_sum(s2) * (1.f / D);
        if (lane == 0) { mu[j] = m; rs[j] = rsqrtf(var + EPS); } }
    __syncthreads();
    const float* lnw = args.in[I_LNW] + l * D + g * 128; const float* lnb = args.in[I_LNB] + l * D + g * 128;
    for (int idx = tid; idx < 128 * 128; idx += 512) { const int j = idx >> 7, d = idx & 127; Vn[idx] = (bf2f(P[(size_t)(row0 + j) * PW + PV + g * 128 + d]) - mu[j]) * rs[j] * lnw[d] + lnb[d]; }
    __syncthreads();
    const float* Wsg = args.in[I_WS] + ((size_t)(l * 8 + g) * 128) * 128; const float* bsg = args.in[I_BS] + (l * 8 + g) * 128;
    for (int idx = tid; idx < 128 * 128; idx += 512) { const int i = idx >> 7, d = idx & 127; float s = 0.f;
        for (int j = 0; j < 128; ++j) s += Wsg[i * 128 + j] * Vn[j * 128 + d];
        bf16* up = P + (size_t)(row0 + i) * PW + PU + g * 128 + d; *up = (bf16)f2bf(bf2f(*up) * (s + bsg[i])); }
}

__device__ __forceinline__ void tr_item(const float* W, int ldw, bf16* WT, int K, int k0, int n0, int drow0, LAS float* scr, int lane) {
#pragma unroll 8
    for (int i = 0; i < 32; ++i) { const int kk = 2 * i + (lane >> 5); scr[kk * 33 + (lane & 31)] = W[(size_t)(k0 + kk) * ldw + n0 + (lane & 31)]; }
    asm volatile("s_waitcnt lgkmcnt(0)" ::: "memory");
    const int c = lane & 7;
#pragma unroll
    for (int j = 0; j < 4; ++j) { const int n = (lane >> 3) + 8 * j; const LAS float* s = scr + (8 * c) * 33 + n;
        v4u o; o.x = pk2(s[0 * 33], s[1 * 33]); o.y = pk2(s[2 * 33], s[3 * 33]); o.z = pk2(s[4 * 33], s[5 * 33]); o.w = pk2(s[6 * 33], s[7 * 33]);
        *(v4u*)(WT + (size_t)(drow0 + n) * K + k0 + 8 * c) = o; }
    asm volatile("s_waitcnt lgkmcnt(0)" ::: "memory");
}

__device__ __forceinline__ void phase_prologue(const Frame& F) {
    const Args& a = *F.a;
    LAS float* sc = (LAS float*)F.lds; LAS float* red = sc + 17 * 1024;
    if (F.bid < 192) {
        for (int i = F.tid; i < 17 * 1024; i += 512) { const int r = i >> 10, k = i & 1023; const float v = r < 16 ? a.in[I_C][r * 1024 + k] : a.in[I_CCTX][k]; sc[i] = siluf_(v); }
        __syncthreads();
        for (int it = F.bid; it < 192; it += F.G) {
            const int l = it / 96, nb = it % 96, n = nb * 64 + F.lane;
            float acc[17];
#pragma unroll
            for (int r = 0; r < 17; ++r) acc[r] = 0.f;
            const float* W = a.in[I_ADAW] + (size_t)l * 1024 * 6144 + n;
#pragma unroll 4
            for (int kk = 0; kk < 128; ++kk) { const int k = F.wave * 128 + kk; const float wv = W[(size_t)k * 6144];
#pragma unroll
                for (int r = 0; r < 17; ++r) acc[r] += sc[r * 1024 + k] * wv; }
#pragma unroll
            for (int r = 0; r < 17; ++r) red[(F.wave * 17 + r) * 64 + F.lane] = acc[r];
            __syncthreads();
            for (int i = F.tid; i < 17 * 64; i += 512) { const int r = i >> 6, ln = i & 63; float s = 0.f;
#pragma unroll
                for (int w = 0; w < 8; ++w) s += red[(w * 17 + r) * 64 + ln];
                ((float*)(a.ws + WS_MOD))[(size_t)(l * 17 + r) * 6144 + nb * 64 + ln] = s + a.in[I_ADAB][l * 6144 + nb * 64 + ln]; }
            __syncthreads();
        }
    }
    __syncthreads();
    LAS float* scr = (LAS float*)(F.lds + F.wave * 8448);
    const int gw = F.bid * F.nw + F.wave, NGW = F.G * F.nw;
    constexpr int IT_IN = 16 * 225, IT_MX = 16 * 32, IT_L = IT_IN + 3 * IT_MX;
    for (int it = gw; it < 2 * IT_L; it += NGW) {
        const int l = it / IT_L; int r = it % IT_L;
        if (r < IT_IN) { const int kb = r / 225, nb = r % 225, n0 = nb * 32; const int d0 = n0 < 2048 ? n0 : (n0 < 2080 ? 7168 + (n0 - 2048) : n0 - 32);
            tr_item(a.in[I_WIN] + (size_t)l * D * NIN, NIN, (bf16*)(a.ws + WS_WIN) + (size_t)l * WIN_ROWS * D, D, kb * 64, n0, d0, scr, F.lane); }
        else { r -= IT_IN; const int m = r / IT_MX, q = r % IT_MX, kb = q / 32, nb = q % 32;
            const float* W = (m == 0 ? a.in[I_WPA] : (m == 1 ? a.in[I_WPB] : a.in[I_WO])) + (size_t)l * D * D;
            tr_item(W, D, (bf16*)(a.ws + WS_WMIX) + (size_t)(l * 3 + m) * D * D, D, kb * 64, nb * 32, nb * 32, scr, F.lane); }
    }
    for (int i = F.bid * 512 + F.tid; i < 2 * 224 * 128; i += F.G * 512) { const int l = i / (224 * 128), q = i % (224 * 128);
        *(v4u*)((bf16*)(a.ws + WS_WIN) + ((size_t)l * WIN_ROWS + 7200) * D + (size_t)q * 8) = (v4u){0u, 0u, 0u, 0u}; }
    for (int i = F.bid * 512 + F.tid; i < 2 * 8 * 128 * 128 / 4; i += F.G * 512) { const f32x4 v = *(const f32x4*)(a.in[I_WS] + (size_t)i * 4); *(v2u*)((bf16*)(a.ws + WS_WST) + (size_t)i * 4) = pack4(v); }
}

__device__ __forceinline__ void convert_experts(const Frame& F, int l) {
    const Args& a = *F.a;
    LAS float* scr = (LAS float*)(F.lds + 65536 + F.wave * 8448);
    const int gw = F.bid * F.nw + F.wave, NGW = F.G * F.nw;
    for (int it = gw; it < 16 * 3 * 512; it += NGW) {
        const int e = it / 1536, r = it % 1536, m = r / 512, q = r % 512, kb = q / 32, nb = q % 32, n0 = nb * 32;
        const float* W = (m == 0 ? a.in[I_WG] : (m == 1 ? a.in[I_WU] : a.in[I_WD])) + ((size_t)l * 16 + e) * D * D;
        if (m < 2) tr_item(W, D, (bf16*)(a.ws + WS_P + PO_WGU) + (size_t)e * 2048 * D, D, kb * 64, n0, (n0 >> 7) * 256 + m * 128 + (n0 & 127), scr, F.lane);
        else tr_item(W, D, (bf16*)(a.ws + WS_P + PO_WD) + (size_t)e * 1024 * D, D, kb * 64, n0, n0, scr, F.lane);
    }
}

__device__ __forceinline__ void moe_combine(const Frame& F, int lprev, int r, f32x4 (&v)[4]) {
    const Args& a = *F.a;
    const int* inv = (const int*)(a.ws + WS_INV) + (size_t)r * 16;
    const int myslot = F.lane < 16 ? inv[F.lane] : -1;
    const bool lat = r < NLAT; const int b = lat ? (r >> 11) : ((r - NLAT) >> 8);
    f32x4 s[4];
#pragma unroll
    for (int j = 0; j < 4; ++j) s[j] = (f32x4){0.f, 0.f, 0.f, 0.f};
    const bf16* YM = (const bf16*)(a.ws + WS_P + PO_YM);
    for (int e = 0; e < 16; ++e) {
        const int slot = __builtin_amdgcn_readlane(myslot, e);
        if (slot >= 0) { const size_t hrow = lat ? (size_t)((b * 16 + e) * 256 + slot) : (size_t)(LIST_C0 + e * 512 + b * 32 + slot);
            const bf16* yp = YM + hrow * D + 4 * F.lane;
#pragma unroll
            for (int j = 0; j < 4; ++j) s[j] += unpack4(*(const v2u*)(yp + 256 * j)); }
    }
    const float* g2 = modp(a, lprev, batch_row(r)) + 5120 + 4 * F.lane;
#pragma unroll
    for (int j = 0; j < 4; ++j) v[j] += *(const f32x4*)(g2 + 256 * j) * s[j];
}

__device__ __forceinline__ void phase_norm1(const Frame& F, int l) {
    const Args& a = *F.a;
    const int gw = F.bid * F.nw + F.wave, NGW = F.G * F.nw;
    for (int r = gw; r < NROW; r += NGW) {
        const bool lat = r < NLAT;
        const float* hin = (l == 0) ? (lat ? a.in[I_X] + (size_t)r * D : a.in[I_CTX] + (size_t)(r - NLAT) * D) : (lat ? a.out + (size_t)r * D : (const float*)(a.ws + WS_HC) + (size_t)(r - NLAT) * D);
        f32x4 v[4];
#pragma unroll
        for (int j = 0; j < 4; ++j) v[j] = *(const f32x4*)(hin + 4 * F.lane + 256 * j);
        if (l > 0) { moe_combine(F, l - 1, r, v); float* ho = lat ? a.out + (size_t)r * D : (float*)(a.ws + WS_HC) + (size_t)(r - NLAT) * D;
#pragma unroll
            for (int j = 0; j < 4; ++j) *(f32x4*)(ho + 4 * F.lane + 256 * j) = v[j]; }
        float ss = 0.f;
#pragma unroll
        for (int j = 0; j < 4; ++j) ss += v[j].x * v[j].x + v[j].y * v[j].y + v[j].z * v[j].z + v[j].w * v[j].w;
        const float rstd = rsqrtf(wave_sum(ss) * (1.f / D) + EPS);
        const float* md = modp(a, l, batch_row(r)) + 4 * F.lane; const float* nw = a.in[I_N1W] + l * D + 4 * F.lane;
        bf16* o = (bf16*)(a.ws + WS_XM) + (size_t)r * D + 4 * F.lane;
#pragma unroll
        for (int j = 0; j < 4; ++j) { const f32x4 w = *(const f32x4*)(nw + 256 * j), sh = *(const f32x4*)(md + 256 * j), scl = *(const f32x4*)(md + 1024 + 256 * j);
            *(v2u*)(o + 256 * j) = pack4(v[j] * rstd * w * (scl + 1.0f) + sh); }
    }
}

__device__ __forceinline__ void phase_ssdin(const Frame& F, int l) {
    const Args& a = *F.a;
    const int gw = F.bid * F.nw + F.wave, NGW = F.G * F.nw, nrows = l == 0 ? NROW : NLAT;
    const float* nw = a.in[I_SSDNW] + l * D + 4 * F.lane;
    for (int r = gw; r < nrows; r += NGW) {
        const bf16* y = (const bf16*)(a.ws + WS_XM) + (size_t)r * D + 4 * F.lane; bf16* z = (bf16*)(a.ws + WS_P) + (size_t)r * PW + PZ + 4 * F.lane;
#pragma unroll
        for (int j = 0; j < 4; ++j) { const f32x4 g = unpack4(*(const v2u*)(y + 256 * j)) * unpack4(*(const v2u*)(z + 256 * j));
            const float ms = wave_sum(g.x * g.x + g.y * g.y + g.z * g.z + g.w * g.w) * (1.f / 256.f);
            *(v2u*)(z + 256 * j) = pack4(g * rsqrtf(ms + EPS) * *(const f32x4*)(nw + 256 * j)); }
    }
}

__device__ __forceinline__ void phase_norm2(const Frame& F, int l) {
    const Args& a = *F.a;
    LAS float* rwT = (LAS float*)F.lds;
    for (int i = F.tid; i < 16 * 1024; i += 512) { const int k = i >> 4, e = i & 15; rwT[e * 1024 + k] = a.in[I_RW][(size_t)l * D * 16 + i]; }
    __syncthreads();
    const int gw = F.bid * F.nw + F.wave, NGW = F.G * F.nw, nrows = l == 0 ? NROW : NLAT;
    for (int r = gw; r < nrows; r += NGW) {
        const bool lat = r < NLAT;
        const float* hin = lat ? a.out + (size_t)r * D : (const float*)(a.ws + WS_HC) + (size_t)(r - NLAT) * D;
        f32x4 v[4]; float ss = 0.f;
#pragma unroll
        for (int j = 0; j < 4; ++j) { v[j] = *(const f32x4*)(hin + 4 * F.lane + 256 * j); ss += v[j].x * v[j].x + v[j].y * v[j].y + v[j].z * v[j].z + v[j].w * v[j].w; }
        const float rstd = rsqrtf(wave_sum(ss) * (1.f / D) + EPS);
        const float* md = modp(a, l, batch_row(r)) + 3072 + 4 * F.lane; const float* nw = a.in[I_N2W] + l * D + 4 * F.lane;
        bf16* o = (bf16*)(a.ws + WS_XM) + (size_t)r * D + 4 * F.lane;
#pragma unroll
        for (int j = 0; j < 4; ++j) { const f32x4 w = *(const f32x4*)(nw + 256 * j), sh = *(const f32x4*)(md + 256 * j), scl = *(const f32x4*)(md + 1024 + 256 * j);
            v[j] = v[j] * rstd * w * (scl + 1.0f) + sh; *(v2u*)(o + 256 * j) = pack4(v[j]); }
        float mine = 0.f;
#pragma unroll 1
        for (int e = 0; e < 16; ++e) { float s = 0.f;
#pragma unroll
            for (int j = 0; j < 4; ++j) { const f32x4 w = *(const LAS f32x4*)(rwT + e * 1024 + 4 * F.lane + 256 * j); s += v[j].x * w.x + v[j].y * w.y + v[j].z * w.z + v[j].w * w.w; }
            s = wave_sum(s); mine = (F.lane == e) ? s : mine; }
        float mx = mine;
#pragma unroll
        for (int o = 1; o < 16; o <<= 1) mx = fmaxf(mx, __shfl_xor(mx, o));
        const float ex = __expf(mine - mx); float den = ex;
#pragma unroll
        for (int o = 1; o < 16; o <<= 1) den += __shfl_xor(den, o);
        if (F.lane < 16) ((float*)(a.ws + WS_AFF))[(size_t)r * 16 + F.lane] = ex / den;
    }
    __syncthreads();
    convert_experts(F, l);
}

__device__ __forceinline__ void phase_topk(const Frame& F, int l) {
    const Args& a = *F.a;
    LAS float* vals = (LAS float*)F.lds;
    const int ntask = l == 0 ? 512 : 256;
    const float* AFF = (const float*)(a.ws + WS_AFF); int* INV = (int*)(a.ws + WS_INV); int* IDX = (int*)(a.ws + WS_IDX); float* GATE = (float*)(a.ws + WS_GATE);
    for (int task = F.bid; task < ntask; task += F.G) {
        const bool lat = task < 256; const int t = lat ? task : task - 256, b = t >> 4, e = t & 15;
        const int r0 = lat ? b * SEQ : NLAT + b * CTXL, n = lat ? SEQ : CTXL, cap = lat ? CAP_L : CAP_C;
        const int list0 = lat ? (b * 16 + e) * 256 : LIST_C0 + e * 512 + b * 32;
        for (int i = F.tid; i < n; i += 512) vals[i] = AFF[(size_t)(r0 + i) * 16 + e];
        __syncthreads();
        float av[4]; int rk[4];
#pragma unroll
        for (int q = 0; q < 4; ++q) { const int i = F.tid + 512 * q; av[q] = i < n ? vals[i] : 0.f; rk[q] = 0; }
        for (int j = 0; j < n; j += 4) { const f32x4 w = *(const LAS f32x4*)(vals + j);
#pragma unroll
            for (int q = 0; q < 4; ++q) { const int i = F.tid + 512 * q; const float x = av[q];
                rk[q] += (w.x > x || (w.x == x && j < i)) + (w.y > x || (w.y == x && j + 1 < i)) + (w.z > x || (w.z == x && j + 2 < i)) + (w.w > x || (w.w == x && j + 3 < i)); } }
#pragma unroll
        for (int q = 0; q < 4; ++q) { const int i = F.tid + 512 * q; if (i < n) { const int slot = rk[q] < cap ? rk[q] : -1; INV[(size_t)(r0 + i) * 16 + e] = slot;
            if (slot >= 0) { IDX[list0 + slot] = r0 + i; GATE[list0 + slot] = av[q]; } } }
        __syncthreads();
    }
}

__device__ __forceinline__ void phase_final(const Frame& F) {
    const Args& a = *F.a;
    const int gw = F.bid * F.nw + F.wave, NGW = F.G * F.nw;
    for (int r = gw; r < NLAT; r += NGW) {
        float* h = a.out + (size_t)r * D + 4 * F.lane; f32x4 v[4];
#pragma unroll
        for (int j = 0; j < 4; ++j) v[j] = *(const f32x4*)(h + 256 * j);
        moe_combine(F, 1, r, v);
        float ss = 0.f;
#pragma unroll
        for (int j = 0; j < 4; ++j) ss += v[j].x * v[j].x + v[j].y * v[j].y + v[j].z * v[j].z + v[j].w * v[j].w;
        const float rstd = rsqrtf(wave_sum(ss) * (1.f / D) + EPS);
#pragma unroll
        for (int j = 0; j < 4; ++j) *(f32x4*)(h + 256 * j) = v[j] * rstd * *(const f32x4*)(a.in[I_FNW] + 4 * F.lane + 256 * j);
    }
}


__device__ __forceinline__ void phase_ssd_seq(const Frame& F, int l) {
    const Args& a = *F.a;
    LAS float* xs = (LAS float*)F.lds; LAS float* Bsm = xs + 32 * 64; LAS float* Csm = Bsm + 32 * 128; LAS float* dts = Csm + 32 * 128;
    const bf16* P = (const bf16*)(a.ws + WS_P); bf16* Y = (bf16*)(a.ws + WS_XM); const float* DT = (const float*)(a.ws + WS_DT);
    const float* cw = a.in[I_CONVW] + (size_t)l * 3 * 2048; const float* cb = a.in[I_CONVB] + (size_t)l * 2048;
    const int tid = F.tid, p = tid >> 3, nq = tid & 7;
    for (int task = F.bid; task < 256; task += F.G) {
        const int b = task >> 4, h = task & 15, g = h >> 2;
        const float dskip = a.in[I_DSKIP][l * 16 + h];
        for (int dir = 0; dir < 2; ++dir) {
            float st[16];
#pragma unroll
            for (int i = 0; i < 16; ++i) st[i] = 0.f;
            const float Ah = -__expf(a.in[I_ALOG][(l * 2 + dir) * 16 + h]);
            for (int seg = 0; seg < 2; ++seg) {
                const int base = seg == 0 ? NLAT + b * CTXL : b * SEQ, len = seg == 0 ? CTXL : SEQ;
                const bool wy = !(l == 1 && seg == 0);
                for (int blk = 0; blk < len / 32; ++blk) {
                    for (int idx = tid; idx < 32 * 320; idx += 512) {
                        const int tt = idx / 320, ch = idx % 320;
                        const int tok = dir == 0 ? blk * 32 + tt : len - 1 - (blk * 32 + tt);
                        const int col = ch < 64 ? PX + h * 64 + ch : (ch < 192 ? PB + g * 128 + (ch - 64) : PC + g * 128 + (ch - 192));
                        const bf16* pp = P + (size_t)(base + tok) * PW + col;
                        const float cur = bf2f(pp[0]), prv = tok > 0 ? bf2f(pp[-PW]) : 0.f, nxt = tok < len - 1 ? bf2f(pp[PW]) : 0.f;
                        const float v = siluf_(cw[col] * prv + cw[2048 + col] * cur + cw[4096 + col] * nxt + cb[col]);
                        if (ch < 64) xs[tt * 64 + ch] = v; else if (ch < 192) Bsm[tt * 128 + ch - 64] = v; else Csm[tt * 128 + ch - 192] = v;
                    }
                    if (tid < 32) { const int tok = dir == 0 ? blk * 32 + tid : len - 1 - (blk * 32 + tid); dts[tid] = DT[(size_t)(base + tok) * 32 + dir * 16 + h]; }
                    __syncthreads();
                    for (int tt = 0; tt < 32; ++tt) {
                        const float dt = dts[tt], dA = __expf(dt * Ah), xr = xs[tt * 64 + p], xv = xr * dt;
                        float ys = 0.f;
#pragma unroll
                        for (int i = 0; i < 16; ++i) { const int n = nq * 16 + i; st[i] = st[i] * dA + xv * Bsm[tt * 128 + n]; ys += st[i] * Csm[tt * 128 + n]; }
                        ys += __shfl_xor(ys, 1); ys += __shfl_xor(ys, 2); ys += __shfl_xor(ys, 4);
                        if (nq == 0 && wy) { const int tok = dir == 0 ? blk * 32 + tt : len - 1 - (blk * 32 + tt); bf16* yp = Y + (size_t)(base + tok) * D + h * 64 + p;
                            if (dir == 0) *yp = (bf16)f2bf(ys + dskip * xr); else *yp = (bf16)f2bf(bf2f(*yp) + ys); }
                    }
                    __syncthreads();
                }
            }
        }
    }
}


typedef short s16x4 __attribute__((ext_vector_type(4)));
__device__ __forceinline__ bf16x8 tr_frag(const LAS unsigned char* p, int stride4) {
    const s16x4 lo = __builtin_amdgcn_ds_read_tr16_b64_v4i16((LAS s16x4*)p), hi = __builtin_amdgcn_ds_read_tr16_b64_v4i16((LAS s16x4*)(p + stride4));
    return __builtin_shufflevector(lo, hi, 0, 1, 2, 3, 4, 5, 6, 7);
}
__device__ __forceinline__ void phase_ssd_chunked(const Frame& F, int l) {
    const Args& a = *F.a;
    constexpr int SB = 272, SX = 144;
    constexpr int O_BS = 0, O_CS = 34816, O_HS = 69632, O_XS = 87040, O_XW = 105472, O_DT = 123904, O_AC = 124416, O_SC = 124928, O_TOT = 125440;
    LAS unsigned char* Ls = F.lds;
    LAS float* dtl = (LAS float*)(Ls + O_DT); LAS float* acl = (LAS float*)(Ls + O_AC); LAS float* scl = (LAS float*)(Ls + O_SC); LAS float* totl = (LAS float*)(Ls + O_TOT);
    const bf16* P = (const bf16*)(a.ws + WS_P); bf16* Y = (bf16*)(a.ws + WS_XM); const float* DT = (const float*)(a.ws + WS_DT);
    const float* cw = a.in[I_CONVW] + (size_t)l * 3 * 2048; const float* cb = a.in[I_CONVB] + (size_t)l * 2048;
    const int tid = F.tid, lane = F.lane, w = F.wave, r16 = lane & 15, q4 = lane >> 4;
    for (int task = F.bid; task < 256; task += F.G) {
        const int b = task >> 4, h = task & 15, g = h >> 2;
        const float dskip = a.in[I_DSKIP][l * 16 + h];
        const int cg = tid % 40, rg = tid / 40;
        const int gcol = cg < 8 ? PX + h * 64 + cg * 8 : (cg < 24 ? PB + g * 128 + (cg - 8) * 8 : PC + g * 128 + (cg - 24) * 8);
        const int dstoff = cg < 8 ? O_XS + cg * 16 : (cg < 24 ? O_BS + (cg - 8) * 16 : O_CS + (cg - 24) * 16), dststr = cg < 8 ? SX : SB;
        for (int dir = 0; dir < 2; ++dir) {
            f32x4 acch[4];
#pragma unroll
            for (int i = 0; i < 4; ++i) acch[i] = (f32x4){0.f, 0.f, 0.f, 0.f};
            for (int i = tid; i < 64 * SB / 16; i += 512) *(LAS v4u*)(Ls + O_HS + i * 16) = (v4u){0u, 0u, 0u, 0u};
            const float Ah = -__expf(a.in[I_ALOG][(l * 2 + dir) * 16 + h]);
            for (int step = 0; step < 18; ++step) {
                const bool isctx = step < 2;
                const int chunk = dir == 0 ? (isctx ? step : step - 2) : (isctx ? 1 - step : 17 - step);
                const int len = isctx ? CTXL : SEQ, t0 = chunk * 128, base = (isctx ? NLAT + b * CTXL : b * SEQ) + t0;
                const bool wy = !(l == 1 && isctx);
                if (tid < 320) {
                    int gc = gcol; asm volatile("" : "+v"(gc));
                    float w0[8], w1[8], w2[8], bs[8];
#pragma unroll
                    for (int i = 0; i < 8; ++i) { w0[i] = cw[gc + i]; w1[i] = cw[2048 + gc + i]; w2[i] = cw[4096 + gc + i]; bs[i] = cb[gc + i]; }
#pragma unroll 1
                    for (int hh = 0; hh < 2; ++hh) {
                    const int i0 = rg * 16 + hh * 8;
                    const bf16* pp = P + (size_t)(base + i0) * PW + gc;
                    v4u rows[10];
#pragma unroll
                    for (int ii = 0; ii < 10; ++ii) { const int t = t0 + i0 + ii - 1; rows[ii] = (t >= 0 && t < len) ? *(const v4u*)(pp + (ptrdiff_t)(ii - 1) * PW) : (v4u){0u, 0u, 0u, 0u}; }
#pragma unroll
                    for (int ii = 0; ii < 8; ++ii) { const v4u p0 = rows[ii], p1 = rows[ii + 1], p2 = rows[ii + 2]; float o[8];
                        o[0] = w0[0] * bflo(p0.x) + w1[0] * bflo(p1.x) + w2[0] * bflo(p2.x) + bs[0]; o[1] = w0[1] * bfhi(p0.x) + w1[1] * bfhi(p1.x) + w2[1] * bfhi(p2.x) + bs[1];
                        o[2] = w0[2] * bflo(p0.y) + w1[2] * bflo(p1.y) + w2[2] * bflo(p2.y) + bs[2]; o[3] = w0[3] * bfhi(p0.y) + w1[3] * bfhi(p1.y) + w2[3] * bfhi(p2.y) + bs[3];
                        o[4] = w0[4] * bflo(p0.z) + w1[4] * bflo(p1.z) + w2[4] * bflo(p2.z) + bs[4]; o[5] = w0[5] * bfhi(p0.z) + w1[5] * bfhi(p1.z) + w2[5] * bfhi(p2.z) + bs[5];
                        o[6] = w0[6] * bflo(p0.w) + w1[6] * bflo(p1.w) + w2[6] * bflo(p2.w) + bs[6]; o[7] = w0[7] * bfhi(p0.w) + w1[7] * bfhi(p1.w) + w2[7] * bfhi(p2.w) + bs[7];
                        v4u ov; ov.x = pk2(siluf_(o[0]), siluf_(o[1])); ov.y = pk2(siluf_(o[2]), siluf_(o[3])); ov.z = pk2(siluf_(o[4]), siluf_(o[5])); ov.w = pk2(siluf_(o[6]), siluf_(o[7]));
                        *(LAS v4u*)(Ls + dstoff + (i0 + ii) * dststr) = ov; }
                    }
                } else if (w == 7) {
                    const int t = 2 * lane;
                    const float d0 = DT[(size_t)(base + t) * 32 + dir * 16 + h], d1 = DT[(size_t)(base + t + 1) * 32 + dir * 16 + h];
                    const float a0 = d0 * Ah, a1 = d1 * Ah;
                    float incl = a0 + a1;
#pragma unroll
                    for (int o = 1; o < 64; o <<= 1) { const float v = __shfl_up(incl, o); if (lane >= o) incl += v; }
                    const float tot = __shfl(incl, 63), excl = incl - (a0 + a1);
                    float c0, c1;
                    if (dir == 0) { c0 = excl + a0; c1 = incl; } else { c0 = tot - excl; c1 = tot - excl - a0; }
                    dtl[t] = d0; dtl[t + 1] = d1; acl[t] = c0; acl[t + 1] = c1; scl[t] = d0 * __expf(tot - c0); scl[t + 1] = d1 * __expf(tot - c1);
                    if (lane == 0) totl[0] = tot;
                }
                __syncthreads();
                { const int j = tid >> 2, c0 = (tid & 3) * 16; const float sc = scl[j];
                    const v4u x0 = *(const LAS v4u*)(Ls + O_XS + j * SX + c0 * 2), x1 = *(const LAS v4u*)(Ls + O_XS + j * SX + c0 * 2 + 16); v4u y0, y1;
                    y0.x = pk2(bflo(x0.x) * sc, bfhi(x0.x) * sc); y0.y = pk2(bflo(x0.y) * sc, bfhi(x0.y) * sc); y0.z = pk2(bflo(x0.z) * sc, bfhi(x0.z) * sc); y0.w = pk2(bflo(x0.w) * sc, bfhi(x0.w) * sc);
                    y1.x = pk2(bflo(x1.x) * sc, bfhi(x1.x) * sc); y1.y = pk2(bflo(x1.y) * sc, bfhi(x1.y) * sc); y1.z = pk2(bflo(x1.z) * sc, bfhi(x1.z) * sc); y1.w = pk2(bflo(x1.w) * sc, bfhi(x1.w) * sc);
                    *(LAS v4u*)(Ls + O_XW + j * SX + c0 * 2) = y0; *(LAS v4u*)(Ls + O_XW + j * SX + c0 * 2 + 16) = y1; }
                if (wy) {
                    bf16x8 cf[4];
#pragma unroll
                    for (int ks = 0; ks < 4; ++ks) cf[ks] = *(const LAS bf16x8*)(Ls + O_CS + (16 * w + r16) * SB + (32 * ks + 8 * q4) * 2);
                    f32x4 aoff[4];
#pragma unroll
                    for (int pt = 0; pt < 4; ++pt) { aoff[pt] = (f32x4){0.f, 0.f, 0.f, 0.f};
#pragma unroll
                        for (int ks = 0; ks < 4; ++ks) aoff[pt] = __builtin_amdgcn_mfma_f32_16x16x32_bf16(cf[ks], *(const LAS bf16x8*)(Ls + O_HS + (16 * pt + r16) * SB + (32 * ks + 8 * q4) * 2), aoff[pt], 0, 0, 0); }
                    float aci[4];
#pragma unroll
                    for (int rg4 = 0; rg4 < 4; ++rg4) aci[rg4] = acl[16 * w + 4 * q4 + rg4];
#pragma unroll
                    for (int jt = 0; jt < 8; ++jt) {
                        const bool live = dir == 0 ? (jt <= w) : (jt >= w);
                        f32x4 cbv = (f32x4){0.f, 0.f, 0.f, 0.f};
                        if (live) {
#pragma unroll
                            for (int ks = 0; ks < 4; ++ks) cbv = __builtin_amdgcn_mfma_f32_16x16x32_bf16(cf[ks], *(const LAS bf16x8*)(Ls + O_BS + (16 * jt + r16) * SB + (32 * ks + 8 * q4) * 2), cbv, 0, 0, 0);
                            const int j = 16 * jt + r16; const float acj = acl[j], dtj = dtl[j];
#pragma unroll
                            for (int rg4 = 0; rg4 < 4; ++rg4) { const int i = 16 * w + 4 * q4 + rg4; const bool ok = dir == 0 ? (j <= i) : (j >= i);
                                cbv[rg4] = ok ? cbv[rg4] * __expf(fminf(aci[rg4] - acj, 0.f)) * dtj : 0.f; }
                        }
#pragma unroll
                        for (int rg4 = 0; rg4 < 4; ++rg4) *(LAS bf16*)(Ls + O_CS + (16 * w + 4 * q4 + rg4) * SB + (16 * jt + r16) * 2) = (bf16)f2bf(cbv[rg4]);
                    }
                    f32x4 ad[4];
#pragma unroll
                    for (int pt = 0; pt < 4; ++pt) { ad[pt] = (f32x4){0.f, 0.f, 0.f, 0.f};
#pragma unroll
                        for (int ks = 0; ks < 4; ++ks) ad[pt] = __builtin_amdgcn_mfma_f32_16x16x32_bf16(*(const LAS bf16x8*)(Ls + O_CS + (16 * w + r16) * SB + (32 * ks + 8 * q4) * 2),
                            tr_frag(Ls + O_XS + (32 * ks + 8 * q4 + (r16 >> 2)) * SX + (16 * pt + 4 * (r16 & 3)) * 2, 4 * SX), ad[pt], 0, 0, 0); }
#pragma unroll
                    for (int pt = 0; pt < 4; ++pt)
#pragma unroll
                        for (int rg4 = 0; rg4 < 4; ++rg4) { const int i = 16 * w + 4 * q4 + rg4, p = 16 * pt + r16;
                            float v = ad[pt][rg4] + __expf(aci[rg4]) * aoff[pt][rg4];
                            bf16* yp = Y + (size_t)(base + i) * D + h * 64 + p;
                            if (dir == 0) v += dskip * bf2f(*(const LAS bf16*)(Ls + O_XS + i * SX + p * 2)); else v += bf2f(*yp);
                            *yp = (bf16)f2bf(v); }
                }
                __syncthreads();
                {
                    const float dec = __expf(totl[0]);
                    bf16x8 bfr[4];
#pragma unroll
                    for (int ks = 0; ks < 4; ++ks) bfr[ks] = tr_frag(Ls + O_BS + (32 * ks + 8 * q4 + (r16 >> 2)) * SB + (16 * w + 4 * (r16 & 3)) * 2, 4 * SB);
#pragma unroll
                    for (int pt = 0; pt < 4; ++pt) { acch[pt] *= dec;
#pragma unroll
                        for (int ks = 0; ks < 4; ++ks) acch[pt] = __builtin_amdgcn_mfma_f32_16x16x32_bf16(tr_frag(Ls + O_XW + (32 * ks + 8 * q4 + (r16 >> 2)) * SX + (16 * pt + 4 * (r16 & 3)) * 2, 4 * SX), bfr[ks], acch[pt], 0, 0, 0);
#pragma unroll
                        for (int rg4 = 0; rg4 < 4; ++rg4) *(LAS bf16*)(Ls + O_HS + (16 * pt + 4 * q4 + rg4) * SB + (16 * w + r16) * 2) = (bf16)f2bf(acch[pt][rg4]); }
                }
                __syncthreads();
            }
        }
    }
}


__device__ __forceinline__ void phase_vstats(const Frame& F, int l) {
    const Args& a = *F.a;
    const int gw = F.bid * F.nw + F.wave, NGW = F.G * F.nw, nrows = l == 0 ? NROW : NLAT;
    for (int r = gw; r < nrows; r += NGW) {
        const bf16* vp = (const bf16*)(a.ws + WS_P) + (size_t)r * PW + PV + F.lane * 8;
        const v4u w0 = *(const v4u*)vp, w1 = *(const v4u*)(vp + 512);
        float v[16] = {bflo(w0.x), bfhi(w0.x), bflo(w0.y), bfhi(w0.y), bflo(w0.z), bfhi(w0.z), bflo(w0.w), bfhi(w0.w), bflo(w1.x), bfhi(w1.x), bflo(w1.y), bfhi(w1.y), bflo(w1.z), bfhi(w1.z), bflo(w1.w), bfhi(w1.w)};
        float sm = 0.f;
#pragma unroll
        for (int i = 0; i < 16; ++i) sm += v[i];
        const float m = wave_sum(sm) * (1.f / D); float s2 = 0.f;
#pragma unroll
        for (int i = 0; i < 16; ++i) { const float d = v[i] - m; s2 += d * d; }
        const float var = wave_sum(s2) * (1.f / D);
        if (F.lane == 0) *(f32x2*)((float*)(a.ws + WS_VSTAT) + (size_t)r * 2) = (f32x2){m, rsqrtf(var + EPS)};
    }
}

__device__ __forceinline__ void phase_sgu_mfma(const Frame& F, int l) {
    const Args& a = *F.a;
    constexpr int SV = 272, SO = 528;
    constexpr int O_VN = 0, O_OUT = 34816;
    LAS unsigned char* Ls = F.lds;
    bf16* P = (bf16*)(a.ws + WS_P);
    const int ntask = (l == 0 ? 288 : 256) * 8, tid = F.tid, lane = F.lane, w = F.wave, r16 = lane & 15, q4 = lane >> 4;
    for (int task = F.bid; task < ntask; task += F.G) {
        const int chunk = task >> 3, g = task & 7;
        const int row0 = chunk < 256 ? chunk * 128 : NLAT + (chunk - 256) * 128;
        const float* lnw = a.in[I_LNW] + l * D + g * 128; const float* lnb = a.in[I_LNB] + l * D + g * 128;
#pragma unroll
        for (int q = 0; q < 4; ++q) { const int piece = tid + 512 * q, j = piece >> 4, d8 = (piece & 15) * 8;
            const v4u vv = *(const v4u*)(P + (size_t)(row0 + j) * PW + PV + g * 128 + d8);
            const f32x2 st = *(const f32x2*)((const float*)(a.ws + WS_VSTAT) + (size_t)(row0 + j) * 2);
            const f32x4 w0 = *(const f32x4*)(lnw + d8), w1 = *(const f32x4*)(lnw + d8 + 4), b0 = *(const f32x4*)(lnb + d8), b1 = *(const f32x4*)(lnb + d8 + 4);
            v4u o; o.x = pk2((bflo(vv.x) - st.x) * st.y * w0.x + b0.x, (bfhi(vv.x) - st.x) * st.y * w0.y + b0.y); o.y = pk2((bflo(vv.y) - st.x) * st.y * w0.z + b0.z, (bfhi(vv.y) - st.x) * st.y * w0.w + b0.w);
            o.z = pk2((bflo(vv.z) - st.x) * st.y * w1.x + b1.x, (bfhi(vv.z) - st.x) * st.y * w1.y + b1.y); o.w = pk2((bflo(vv.w) - st.x) * st.y * w1.z + b1.z, (bfhi(vv.w) - st.x) * st.y * w1.w + b1.w);
            *(LAS v4u*)(Ls + O_VN + j * SV + d8 * 2) = o; }
        bf16x8 af[4];
        const bf16* wsg = (const bf16*)(a.ws + WS_WST) + ((size_t)(l * 8 + g) * 128 + 16 * w + r16) * 128 + 8 * q4;
#pragma unroll
        for (int ks = 0; ks < 4; ++ks) af[ks] = *(const bf16x8*)(wsg + 32 * ks);
        float bi[4];
#pragma unroll
        for (int rg4 = 0; rg4 < 4; ++rg4) bi[rg4] = a.in[I_BS][(l * 8 + g) * 128 + 16 * w + 4 * q4 + rg4];
        __syncthreads();
#pragma unroll
        for (int dt = 0; dt < 8; ++dt) { f32x4 acc = (f32x4){0.f, 0.f, 0.f, 0.f};
#pragma unroll
            for (int ks = 0; ks < 4; ++ks) acc = __builtin_amdgcn_mfma_f32_16x16x32_bf16(af[ks], tr_frag(Ls + O_VN + (32 * ks + 8 * q4 + (r16 >> 2)) * SV + (16 * dt + 4 * (r16 & 3)) * 2, 4 * SV), acc, 0, 0, 0);
#pragma unroll
            for (int rg4 = 0; rg4 < 4; ++rg4) *(LAS float*)(Ls + O_OUT + (16 * w + 4 * q4 + rg4) * SO + (16 * dt + r16) * 4) = acc[rg4] + bi[rg4]; }
        __syncthreads();
#pragma unroll
        for (int q = 0; q < 4; ++q) { const int piece = tid + 512 * q, i = piece >> 4, d8 = (piece & 15) * 8;
            bf16* up = P + (size_t)(row0 + i) * PW + PU + g * 128 + d8; const v4u uv = *(const v4u*)up;
            const f32x4 m0 = *(const LAS f32x4*)(Ls + O_OUT + i * SO + d8 * 4), m1 = *(const LAS f32x4*)(Ls + O_OUT + i * SO + d8 * 4 + 16);
            v4u o; o.x = pk2(bflo(uv.x) * m0.x, bfhi(uv.x) * m0.y); o.y = pk2(bflo(uv.y) * m0.z, bfhi(uv.y) * m0.w); o.z = pk2(bflo(uv.z) * m1.x, bfhi(uv.z) * m1.y); o.w = pk2(bflo(uv.w) * m1.z, bfhi(uv.w) * m1.w);
            *(v4u*)up = o; }
        __syncthreads();
    }
}

__device__ __forceinline__ void phase_sgu_simple(const Frame& F, int l) {
    const Args& a = *F.a;
    LAS float* Vn = (LAS float*)F.lds; LAS float* mu = Vn + 128 * 128; LAS float* rs = mu + 128;
    bf16* P = (bf16*)(a.ws + WS_P);
    const int ntask = (l == 0 ? 288 : 256) * 8, tid = F.tid, lane = F.lane, wave = F.wave;
    for (int task = F.bid; task < ntask; task += F.G) {
        const int chunk = task >> 3, g = task & 7;
        const int row0 = chunk < 256 ? chunk * 128 : NLAT + (chunk - 256) * 128;
        for (int rr = 0; rr < 16; ++rr) { const int j = wave * 16 + rr; const bf16* vp = P + (size_t)(row0 + j) * PW + PV;
            float v[16]; float sm = 0.f;
#pragma unroll
            for (int q = 0; q < 2; ++q) { const v4u w = *(const v4u*)(vp + lane * 8 + 512 * q); v[q * 8 + 0] = bflo(w.x); v[q * 8 + 1] = bfhi(w.x); v[q * 8 + 2] = bflo(w.y); v[q * 8 + 3] = bfhi(w.y); v[q * 8 + 4] = bflo(w.z); v[q * 8 + 5] = bfhi(w.z); v[q * 8 + 6] = bflo(w.w); v[q * 8 + 7] = bfhi(w.w); }
#pragma unroll
            for (int i = 0; i < 16; ++i) sm += v[i];
            const float m = wave_sum(sm) * (1.f / D); float s2 = 0.f;
#pragma unroll
            for (int i = 0; i < 16; ++i) { const float d = v[i] - m; s2 += d * d; }
            const float var = wave_sum(s2) * (1.f / D);
            if (lane == 0) { mu[j] = m; rs[j] = rsqrtf(var + EPS); } }
        __syncthreads();
        const float* lnw = a.in[I_LNW] + l * D + g * 128; const float* lnb = a.in[I_LNB] + l * D + g * 128;
        for (int idx = tid; idx < 128 * 128; idx += 512) { const int j = idx >> 7, d = idx & 127; Vn[idx] = (bf2f(P[(size_t)(row0 + j) * PW + PV + g * 128 + d]) - mu[j]) * rs[j] * lnw[d] + lnb[d]; }
        __syncthreads();
        const float* Wsg = a.in[I_WS] + ((size_t)(l * 8 + g) * 128) * 128; const float* bsg = a.in[I_BS] + (l * 8 + g) * 128;
        for (int idx = tid; idx < 128 * 128; idx += 512) { const int i = idx >> 7, d = idx & 127; float sm = 0.f;
#pragma unroll 8
            for (int j = 0; j < 128; ++j) sm += Wsg[i * 128 + j] * Vn[j * 128 + d];
            bf16* up = P + (size_t)(row0 + i) * PW + PU + g * 128 + d; *up = (bf16)f2bf(bf2f(*up) * (sm + bsg[i])); }
        __syncthreads();
    }
}

#define XB_TMO      128
#define XB_XCNT(j)  (256  + 64 * (j))
#define XB_XSUB(j)  (1280 + 64 * (j))
#define XB_XGEN(j)  (2304 + 64 * (j))
#define XB_TOP      3328
#define XB_TOPGEN   3392
#define XCD_BAR_WORDS 3456
#define XB_SPIN_CAP (1u << 22)
__device__ __forceinline__ unsigned xb_ld(unsigned* p)              { return __hip_atomic_load(p, __ATOMIC_RELAXED, __HIP_MEMORY_SCOPE_AGENT); }
__device__ __forceinline__ unsigned xb_add(unsigned* p, unsigned v) { return __hip_atomic_fetch_add(p, v, __ATOMIC_RELAXED, __HIP_MEMORY_SCOPE_AGENT); }
__device__ __forceinline__ unsigned xb_xcc_id() { return (unsigned)__builtin_amdgcn_s_getreg((3 << 11) | 20) & 0xFu; }
#define XB_SPIN(cond, bar) do { unsigned _sp = 0; while (cond) { __builtin_amdgcn_s_sleep(1); \
    if ((++_sp & 255u) == 0u) { if (xb_ld(&(bar)[XB_TMO])) break; if (_sp > XB_SPIN_CAP) { atomicAdd(&(bar)[XB_TMO], 1u); break; } } } } while (0)
struct XcdBarrier { unsigned* bar; unsigned x; volatile LAS unsigned* st; };
__device__ __forceinline__ XcdBarrier xcd_barrier_post(unsigned* bar, volatile LAS unsigned* st) {
    XcdBarrier b; b.bar = bar; b.x = xb_xcc_id(); b.st = st;
    if (threadIdx.x == 0) (void)xb_add(&bar[XB_XCNT(b.x)], 1u);
    return b;
}
__device__ __forceinline__ void xcd_barrier_complete(unsigned* bar, unsigned x, unsigned& nloc, unsigned& nx) {
    const unsigned G = gridDim.x * gridDim.y * gridDim.z;
    unsigned sum, cnt, mine, sp = 0u;
    for (;;) {
        sum = 0u; cnt = 0u; mine = 0u;
#pragma unroll
        for (unsigned j = 0; j < 16; ++j) { const unsigned c = xb_ld(&bar[XB_XCNT(j)]); sum += c; cnt += (c > 0u) ? 1u : 0u; mine = (j == x) ? c : mine; }
        if (sum == G) break;
        __builtin_amdgcn_s_sleep(1);
        if ((++sp & 255u) == 0u) { if (xb_ld(&bar[XB_TMO])) break; if (sp > XB_SPIN_CAP) { atomicAdd(&bar[XB_TMO], 1u); break; } }
    }
    nloc = mine > 0u ? mine : 1u; nx = cnt > 0u ? cnt : 1u;
}
__device__ __forceinline__ void xcd_barrier(const XcdBarrier& b) {
    asm volatile("s_waitcnt vmcnt(0)" ::: "memory");
    __syncthreads();
    if (threadIdx.x == 0) {
        unsigned* bar = b.bar;
        __builtin_amdgcn_s_waitcnt(0);
        unsigned nloc = b.st[0], nx = b.st[1];
        if (nloc == 0u) { xcd_barrier_complete(bar, b.x, nloc, nx); b.st[0] = nloc; b.st[1] = nx; }
        const unsigned old = xb_add(&bar[XB_XSUB(b.x)], 1u);
        const unsigned gen = old / nloc;
        if (old + 1u == (gen + 1u) * nloc) {
            __builtin_amdgcn_fence(__ATOMIC_RELEASE, "agent");
            asm volatile("s_waitcnt vmcnt(0)" ::: "memory");
            const unsigned og = xb_add(&bar[XB_TOP], 1u);
            const unsigned tg = og / nx;
            if (og + 1u == (tg + 1u) * nx) xb_add(&bar[XB_TOPGEN], 1u);
            else XB_SPIN(xb_ld(&bar[XB_TOPGEN]) == tg, bar);
            __builtin_amdgcn_fence(__ATOMIC_ACQUIRE, "agent");
            xb_add(&bar[XB_XGEN(b.x)], 1u);
            asm volatile("s_waitcnt vmcnt(0)" ::: "memory");
        } else {
            XB_SPIN(xb_ld(&bar[XB_XGEN(b.x)]) == gen, bar);
            __builtin_amdgcn_fence(__ATOMIC_ACQUIRE, "agent");
            asm volatile("s_waitcnt vmcnt(0)" ::: "memory");
        }
    }
    __syncthreads();
}

constexpr int LDS_BYTES = 147456, LDS_MISC = 139264;
constexpr int CW_BAR = 4096;
constexpr int NPHASE = 22;
__global__ void __launch_bounds__(512, 2) mk_fwd(Args args) {
    extern __shared__ __attribute__((aligned(16))) unsigned char lds[];
    Frame F; F.lds = (LAS unsigned char*)lds; F.tid = threadIdx.x; F.lane = F.tid & 63; F.wave = __builtin_amdgcn_readfirstlane(F.tid >> 6); F.nw = 8; F.G = gridDim.x; F.bid = blockIdx.x; F.a = &args;
    const int lo = args.ph_lo, hi = args.ph_hi;
    volatile LAS unsigned* MISC = (volatile LAS unsigned*)(F.lds + LDS_MISC);
    if (F.tid < 64) MISC[F.tid] = 0u;
    __syncthreads();
    XcdBarrier bar; bar.bar = (unsigned*)(args.ws + WS_CTL) + CW_BAR; bar.x = 0; bar.st = MISC + 8;
    if (hi - lo > 1) bar = xcd_barrier_post((unsigned*)(args.ws + WS_CTL) + CW_BAR, MISC + 8);
#define IN(k) (lo <= (k) && (k) < hi)
#define SEAM(k) do { if (IN(k) && IN((k) + 1)) { XcdBarrier b2_ = bar; asm volatile("" : "+s"(b2_.bar)); xcd_barrier(b2_); } } while (0)
#define REP(k) for (int rep_ = 0; rep_ < ((k) == REPEAT_PH ? 2 : 1); ++rep_)
#define FRESH(Fp) Frame Fp = F; { int t_ = threadIdx.x; asm volatile("" : "+v"(t_)); Fp.tid = t_; Fp.lane = t_ & 63; Fp.wave = __builtin_amdgcn_readfirstlane(t_ >> 6); }
    if (IN(0)) REP(0) { FRESH(Fp); phase_prologue(Fp); __syncthreads(); } SEAM(0);
#pragma unroll 1
    for (int l = 0; l < 2; ++l) {
        const int base = 1 + 10 * l;
        if (IN(base + 0)) { FRESH(Fp); phase_norm1(Fp, l); } SEAM(base + 0);
        if (IN(base + 1)) REP(base + 1) { ProbIn p{&args, l}; pg8::gemm_phase(F.lds, p, F.G, F.bid); } SEAM(base + 1);
        if (IN(base + 2)) REP(base + 2) { FRESH(Fp); if (USE_SSD_SEQ) phase_ssd_seq(Fp, l); else phase_ssd_chunked(Fp, l); __syncthreads(); phase_vstats(Fp, l); } SEAM(base + 2);
        if (IN(base + 3)) { { FRESH(Fp); phase_ssdin(Fp, l); } { FRESH(Fp); phase_sgu_mfma(Fp, l); } } SEAM(base + 3);
        if (IN(base + 4)) { { ProbMix<0> p{&args, l}; pg8::gemm_phase(F.lds, p, F.G, F.bid); } { ProbMix<1> p{&args, l}; pg8::gemm_phase(F.lds, p, F.G, F.bid); } } SEAM(base + 4);
        if (IN(base + 5)) { ProbMix<2> p{&args, l}; pg8::gemm_phase(F.lds, p, F.G, F.bid); } SEAM(base + 5);
        if (IN(base + 6)) REP(base + 6) { FRESH(Fp); phase_norm2(Fp, l); } SEAM(base + 6);
        if (IN(base + 7)) REP(base + 7) { FRESH(Fp); phase_topk(Fp, l); } SEAM(base + 7);
        if (IN(base + 8)) REP(base + 8) { ProbMoe<0> p{&args, l}; pg8::gemm_phase(F.lds, p, F.G, F.bid); } SEAM(base + 8);
        if (IN(base + 9)) REP(base + 9) { ProbMoe<1> p{&args, l}; pg8::gemm_phase(F.lds, p, F.G, F.bid); } SEAM(base + 9);
    }
    if (IN(21)) { FRESH(Fp); phase_final(Fp); }
#undef IN
#undef SEAM
#undef FRESH
#undef REP
}

#ifndef USE_SSD_SEQ
#define USE_SSD_SEQ 0
#endif
#ifndef MK_ONE_LAUNCH
#define MK_ONE_LAUNCH 1
#endif
#ifndef STOP_AT
#define STOP_AT 99
#endif
__global__ void k_dump(float* o, size_t base, const unsigned char* src, int mode, size_t n) { for (size_t i = (size_t)blockIdx.x * blockDim.x + threadIdx.x; i < n; i += (size_t)gridDim.x * blockDim.x) {
    float v = mode == 0 ? bf2f(((const bf16*)src)[i]) : (mode == 1 ? ((const float*)src)[i] : (float)((const int*)src)[i]); o[base + i] = v; } }
#ifndef DUMP_SET
#define DUMP_SET 0
#endif
__global__ void k_fill(float* o, size_t n) { for (size_t i = (size_t)blockIdx.x * blockDim.x + threadIdx.x; i < n; i += (size_t)gridDim.x * blockDim.x) o[i] = 0.f; }
extern "C" void kernel_launch(void* const* d_in, const int* in_sizes, int n_in, void* d_out, int out_size, void* d_ws, size_t ws_size, hipStream_t stream) {
    static int grid = 0;
    if (grid == 0) {
        if (n_in != 27 || out_size != NLAT * D || ws_size < WS_END) { fprintf(stderr, "kernel_launch: unexpected shapes (n_in %d, out %d, ws %zu < %zu)\n", n_in, out_size, ws_size, (size_t)WS_END); grid = -1; return; }
        int dev = 0, cus = 0;
        if (hipGetDevice(&dev) != hipSuccess || hipDeviceGetAttribute(&cus, hipDeviceAttributeMultiprocessorCount, dev) != hipSuccess) { grid = -1; return; }
        if (hipFuncSetAttribute((const void*)mk_fwd, hipFuncAttributeMaxDynamicSharedMemorySize, LDS_BYTES) != hipSuccess) { grid = -1; return; }
        if (hipFuncSetAttribute((const void*)k_sgu_naive, hipFuncAttributeMaxDynamicSharedMemorySize, 128 * 128 * 4 + 1024) != hipSuccess) { grid = -1; return; }
        (void)hipGetLastError();
        grid = cus;
    }
    if (grid < 0) return;
    (void)hipMemsetAsync((char*)d_ws + WS_CTL, 0, CTL_ZERO_BYTES, stream);
    Args a{};
    for (int i = 0; i < 27; ++i) a.in[i] = (const float*)d_in[i];
    a.out = (float*)d_out; a.ws = (unsigned char*)d_ws;
    auto run = [&](int lo, int hi) { a.ph_lo = lo; a.ph_hi = hi; hipLaunchKernelGGL(mk_fwd, dim3(grid), dim3(512), LDS_BYTES, stream, a); };
#if MK_ONE_LAUNCH
    run(0, NPHASE);
#else
    for (int ph = 0; ph < NPHASE; ++ph) run(ph, ph + 1);
#endif
}
```

```cpp
#include <hip/hip_runtime.h>
#include <cstdio>
#include <cstdint>

#ifndef USE_SSD_SEQ
#define USE_SSD_SEQ 0
#endif
#ifndef REPEAT_PH
#define REPEAT_PH -1
#endif
#define GAS __attribute__((address_space(1)))
#define LAS __attribute__((address_space(3)))
typedef unsigned short bf16;
typedef unsigned v4u __attribute__((ext_vector_type(4)));
typedef unsigned v2u __attribute__((ext_vector_type(2)));
typedef float f32x4 __attribute__((ext_vector_type(4)));
typedef float f32x2 __attribute__((ext_vector_type(2)));
typedef short bf16x8 __attribute__((ext_vector_type(8)));

constexpr int D = 1024, NB = 16, SEQ = 2048, CTXL = 256, NLAT = NB * SEQ, NCTX = NB * CTXL, NROW = NLAT + NCTX;
constexpr int HEADS = 16, HD = 64, NST = 128, NIN = 7200;
constexpr int NEXP = 16, CAP_L = 256, CAP_C = 32;
constexpr float EPS = 1e-6f;
constexpr int PW = 7168, PX = 0, PB = 1024, PC = 1536, PZ = 2048, PU = 3072, PV = 4096, PGA = 5120, PGB = 6144;
constexpr int WIN_ROWS = 7424;
constexpr int NLIST = NB * NEXP * CAP_L + NEXP * NB * CAP_C;
constexpr int LIST_C0 = NB * NEXP * CAP_L;

constexpr size_t MiB = 1u << 20;
constexpr size_t WS_CTL = 0, CTL_ZERO_BYTES = 1 * MiB;
constexpr size_t WS_MOD = 1 * MiB;
constexpr size_t WS_WST = 2 * MiB;
constexpr size_t WS_VSTAT = 2 * MiB + 512 * 1024;
constexpr size_t WS_DT = 3 * MiB;
constexpr size_t WS_AFF = 8 * MiB;
constexpr size_t WS_INV = 11 * MiB;
constexpr size_t WS_IDX = 14 * MiB;
constexpr size_t WS_GATE = 14 * MiB + 512 * 1024;
constexpr size_t WS_WIN = 16 * MiB;
constexpr size_t WS_WMIX = 45 * MiB;
constexpr size_t WS_HC = 57 * MiB;
constexpr size_t WS_XM = 73 * MiB;
constexpr size_t WS_P = 145 * MiB;
constexpr size_t WS_END = 649 * MiB;
constexpr size_t PO_WGU = 0, PO_WD = 64 * MiB, PO_HID = 96 * MiB, PO_YM = 240 * MiB;

typedef __bf16 bf16x2_t __attribute__((ext_vector_type(2)));
__device__ __forceinline__ unsigned pk2(float lo, float hi) { const f32x2 v = {lo, hi}; return __builtin_bit_cast(unsigned, __builtin_convertvector(v, bf16x2_t)); }
__device__ __forceinline__ unsigned f2bf(float f) { return pk2(f, 0.f) & 0xffffu; }
__device__ __forceinline__ float bflo(unsigned w) { return __builtin_bit_cast(float, w << 16); }
__device__ __forceinline__ float bfhi(unsigned w) { return __builtin_bit_cast(float, w & 0xffff0000u); }
__device__ __forceinline__ float bf2f(bf16 b) { return __builtin_bit_cast(float, ((unsigned)b) << 16); }
__device__ __forceinline__ float rcpf_(float x) { return __builtin_amdgcn_rcpf(x); }
__device__ __forceinline__ float sigmoidf_(float x) { return rcpf_(1.0f + __expf(-x)); }
__device__ __forceinline__ float siluf_(float x) { return x * rcpf_(1.0f + __expf(-x)); }
__device__ __forceinline__ float gelu_tanh(float x) { const float u = 1.5957691216057308f * (x + 0.044715f * x * x * x); return x * rcpf_(1.0f + __expf(-u)); }
__device__ __forceinline__ float softplusf_(float x) { return fmaxf(x, 0.f) + log1pf(__expf(-fabsf(x))); }
__device__ __forceinline__ float wave_sum(float v) {
#pragma unroll
    for (int o = 1; o < 64; o <<= 1) v += __shfl_xor(v, o);
    return v;
}
__device__ __forceinline__ v2u pack4(f32x4 v) { v2u r; r.x = pk2(v.x, v.y); r.y = pk2(v.z, v.w); return r; }
__device__ __forceinline__ f32x4 unpack4(v2u w) { return (f32x4){bflo(w.x), bfhi(w.x), bflo(w.y), bfhi(w.y)}; }

struct Args { const float* in[27]; float* out; unsigned char* ws; int ph_lo, ph_hi; };
enum { I_X = 0, I_C, I_CTX, I_CCTX, I_ADAW, I_ADAB, I_N1W, I_N2W, I_WIN, I_CONVW, I_CONVB, I_DTB, I_ALOG, I_DSKIP, I_SSDNW, I_LNW, I_LNB, I_WS, I_BS, I_WPA, I_WPB, I_WO, I_RW, I_WG, I_WU, I_WD, I_FNW };

struct Frame {
    LAS unsigned char* lds; int tid, lane, wave, nw, G, bid;
    const Args* a;
};
__device__ __forceinline__ const float* modp(const Args& a, int l, int br) { return (const float*)(a.ws + WS_MOD) + (size_t)(l * 17 + br) * 6144; }
__device__ __forceinline__ int batch_row(int r) { return r < NLAT ? (r >> 11) : 16; }

struct Unit { const bf16* A; const bf16* B; const int* gidx; int lda, a_row0, pm, pn, aux; };

struct ProbIn {      static constexpr bool GATHER = false, NOSCHED = true;
    const Args* a; int l; int noepi = 0;
    __device__ int nunits() const { return l == 0 ? 144 * 29 : 128 * 29 + 16 * 9; }
    __device__ void unit(int L, Unit& u) const {
        int pm, pn;
        const int nfull = (l == 0 ? 144 : 128), nun = nunits();
        const int wg = (L & 7) * (nun >> 3) + (L >> 3);
        if (wg < nfull * 29) { const int grp = wg / (8 * 29), w = wg % (8 * 29); pm = grp * 8 + (w & 7); pn = w >> 3; }
        else { const int w = wg - nfull * 29, g2 = w / 72, w2 = w % 72; pm = 128 + g2 * 8 + (w2 & 7); const int q = w2 >> 3; pn = q < 8 ? q : 28; }
        u.A = (const bf16*)(a->ws + WS_XM); u.lda = D; u.a_row0 = pm * 256; u.gidx = nullptr; u.pm = pm; u.pn = pn; u.aux = 0;
        u.B = (const bf16*)(a->ws + WS_WIN) + ((size_t)l * WIN_ROWS + (size_t)pn * 256) * D;
    }
    struct Pre { int dummy; };
    __device__ __forceinline__ Pre pre(const Unit&, int, int) const { return Pre{0}; }
    __device__ __forceinline__ void epi(const Unit& u, int r, int c, f32x4 lo0, f32x4 lo1, f32x4 hi0, f32x4 hi1, const Pre&) const {
        if (noepi) return;
        const int row = u.pm * 256 + r, pn = u.pn;
        if (pn == 28) {
            if (c < 32) { float* dt = (float*)(a->ws + WS_DT) + (size_t)row * 32 + c; const float* db = a->in[I_DTB] + l * 32 + c;
                f32x4 o0, o1;
#pragma unroll
                for (int i = 0; i < 4; ++i) { o0[i] = softplusf_(lo0[i] + db[i]); o1[i] = softplusf_(lo1[i] + db[4 + i]); }
                *(f32x4*)dt = o0; *(f32x4*)(dt + 4) = o1; }
            return;
        }
        if (pn >= 8 && pn < 12) {
#pragma unroll
            for (int i = 0; i < 4; ++i) { lo0[i] = siluf_(lo0[i]); lo1[i] = siluf_(lo1[i]); hi0[i] = siluf_(hi0[i]); hi1[i] = siluf_(hi1[i]); } }
        else if (pn >= 12 && pn < 20) {
#pragma unroll
            for (int i = 0; i < 4; ++i) { lo0[i] = gelu_tanh(lo0[i]); lo1[i] = gelu_tanh(lo1[i]); hi0[i] = gelu_tanh(hi0[i]); hi1[i] = gelu_tanh(hi1[i]); } }
        else if (pn >= 20) {
#pragma unroll
            for (int i = 0; i < 4; ++i) { lo0[i] = sigmoidf_(lo0[i]); lo1[i] = sigmoidf_(lo1[i]); hi0[i] = sigmoidf_(hi0[i]); hi1[i] = sigmoidf_(hi1[i]); } }
        bf16* o = (bf16*)(a->ws + WS_P) + (size_t)row * PW + pn * 256 + c;
        v4u w; w.x = pk2(lo0[0], lo0[1]); w.y = pk2(lo0[2], lo0[3]); w.z = pk2(lo1[0], lo1[1]); w.w = pk2(lo1[2], lo1[3]); *(v4u*)o = w;
        w.x = pk2(hi0[0], hi0[1]); w.y = pk2(hi0[2], hi0[3]); w.z = pk2(hi1[0], hi1[1]); w.w = pk2(hi1[2], hi1[3]); *(v4u*)(o + 128) = w;
    }
};

template <int MODE> struct ProbMix {
    static constexpr bool GATHER = false, NOSCHED = false;
    const Args* a; int l;
    __device__ int nunits() const { return (l == 0 ? 144 : 128) * 4; }
    __device__ void unit(int L, Unit& u) const {
        const int wg = (L & 7) * (nunits() >> 3) + (L >> 3);
        const int grp = wg / 32, w = wg % 32; const int pm = grp * 8 + (w & 7), pn = w >> 3;
        u.pm = pm; u.pn = pn; u.aux = 0; u.gidx = nullptr; u.a_row0 = pm * 256;
        if (MODE == 0) { u.A = (const bf16*)(a->ws + WS_P) + PZ; u.lda = PW; }
        else if (MODE == 1) { u.A = (const bf16*)(a->ws + WS_P) + PU; u.lda = PW; }
        else { u.A = (const bf16*)(a->ws + WS_XM); u.lda = D; }
        u.B = (const bf16*)(a->ws + WS_WMIX) + ((size_t)(l * 3 + MODE) * D + (size_t)pn * 256) * D;
    }
    struct Pre { v4u q0, q1, q2, q3; f32x4 f0, f1, f2, f3, g0, g1, g2, g3; };
    __device__ __forceinline__ Pre pre(const Unit& u, int r, int c) const {
        const int row = u.pm * 256 + r, col = u.pn * 256 + c; Pre p;
        if (MODE == 0) { const bf16* g = (const bf16*)(a->ws + WS_P) + (size_t)row * PW + PGA + col; p.q0 = *(const v4u*)g; p.q1 = *(const v4u*)(g + 128); }
        else if (MODE == 1) { const bf16* t = (const bf16*)(a->ws + WS_P) + (size_t)row * PW + PGA + col; const bf16* g = t + (PGB - PGA);
            p.q0 = *(const v4u*)t; p.q1 = *(const v4u*)(t + 128); p.q2 = *(const v4u*)g; p.q3 = *(const v4u*)(g + 128); }
        else { const bool lat = row < NLAT;
            const float* hin = ((l == 0) ? (lat ? a->in[I_X] + (size_t)row * D : a->in[I_CTX] + (size_t)(row - NLAT) * D) : (lat ? a->out + (size_t)row * D : (const float*)(a->ws + WS_HC) + (size_t)(row - NLAT) * D)) + col;
            const float* g1 = modp(*a, l, batch_row(row)) + 2048 + col;
            p.f0 = *(const f32x4*)hin; p.f1 = *(const f32x4*)(hin + 4); p.f2 = *(const f32x4*)(hin + 128); p.f3 = *(const f32x4*)(hin + 132);
            p.g0 = *(const f32x4*)g1; p.g1 = *(const f32x4*)(g1 + 4); p.g2 = *(const f32x4*)(g1 + 128); p.g3 = *(const f32x4*)(g1 + 132); }
        return p;
    }
    __device__ __forceinline__ void epi(const Unit& u, int r, int c, f32x4 lo0, f32x4 lo1, f32x4 hi0, f32x4 hi1, const Pre& p) const {
        const int row = u.pm * 256 + r, col = u.pn * 256 + c;
        if (MODE == 0) {
            bf16* g = (bf16*)(a->ws + WS_P) + (size_t)row * PW + PGA + col;
            const v4u gl = p.q0, gh = p.q1; v4u w;
            w.x = pk2(bflo(gl.x) * lo0[0], bfhi(gl.x) * lo0[1]); w.y = pk2(bflo(gl.y) * lo0[2], bfhi(gl.y) * lo0[3]); w.z = pk2(bflo(gl.z) * lo1[0], bfhi(gl.z) * lo1[1]); w.w = pk2(bflo(gl.w) * lo1[2], bfhi(gl.w) * lo1[3]); *(v4u*)g = w;
            w.x = pk2(bflo(gh.x) * hi0[0], bfhi(gh.x) * hi0[1]); w.y = pk2(bflo(gh.y) * hi0[2], bfhi(gh.y) * hi0[3]); w.z = pk2(bflo(gh.z) * hi1[0], bfhi(gh.z) * hi1[1]); w.w = pk2(bflo(gh.w) * hi1[2], bfhi(gh.w) * hi1[3]); *(v4u*)(g + 128) = w;
        } else if (MODE == 1) {
            bf16* o = (bf16*)(a->ws + WS_XM) + (size_t)row * D + col;
            const v4u tl = p.q0, th = p.q1, gl = p.q2, gh = p.q3; v4u w;
            w.x = pk2(bflo(tl.x) + bflo(gl.x) * lo0[0], bfhi(tl.x) + bfhi(gl.x) * lo0[1]); w.y = pk2(bflo(tl.y) + bflo(gl.y) * lo0[2], bfhi(tl.y) + bfhi(gl.y) * lo0[3]);
            w.z = pk2(bflo(tl.z) + bflo(gl.z) * lo1[0], bfhi(tl.z) + bfhi(gl.z) * lo1[1]); w.w = pk2(bflo(tl.w) + bflo(gl.w) * lo1[2], bfhi(tl.w) + bfhi(gl.w) * lo1[3]); *(v4u*)o = w;
            w.x = pk2(bflo(th.x) + bflo(gh.x) * hi0[0], bfhi(th.x) + bfhi(gh.x) * hi0[1]); w.y = pk2(bflo(th.y) + bflo(gh.y) * hi0[2], bfhi(th.y) + bfhi(gh.y) * hi0[3]);
            w.z = pk2(bflo(th.z) + bflo(gh.z) * hi1[0], bfhi(th.z) + bfhi(gh.z) * hi1[1]); w.w = pk2(bflo(th.w) + bflo(gh.w) * hi1[2], bfhi(th.w) + bfhi(gh.w) * hi1[3]); *(v4u*)(o + 128) = w;
        } else {
            const bool lat = row < NLAT;
            float* hout = (lat ? a->out + (size_t)row * D : (float*)(a->ws + WS_HC) + (size_t)(row - NLAT) * D) + col;
            *(f32x4*)hout = p.f0 + p.g0 * lo0; *(f32x4*)(hout + 4) = p.f1 + p.g1 * lo1; *(f32x4*)(hout + 128) = p.f2 + p.g2 * hi0; *(f32x4*)(hout + 132) = p.f3 + p.g3 * hi1;
        }
    }
};

template <int MODE> struct ProbMoe {
    static constexpr bool GATHER = (MODE == 0), NOSCHED = false;
    const Args* a; int l;
    __device__ int nunits() const { const int per = MODE == 0 ? 8 : 4; return (256 + (l == 0 ? 32 : 0)) * per; }
    __device__ void unit(int L, Unit& u) const {
        constexpr int per = MODE == 0 ? 8 : 4;
        const int x = L & 7, off = L >> 3;
        int pn, t;
        if (off < 32 * per) { const int e = 2 * x + off / (16 * per), r = off % (16 * per); t = (r / per) * 16 + e; pn = r % per; }
        else { const int o = off - 32 * per; t = 256 + 4 * x + o / per; pn = o % per; }
        const int e = t < 256 ? (t & 15) : ((t - 256) >> 1);
        const int list0 = t < 256 ? t * 256 : LIST_C0 + (t - 256) * 256;
        u.pm = t; u.pn = pn; u.aux = list0;
        if (MODE == 0) { u.A = (const bf16*)(a->ws + WS_XM); u.lda = D; u.a_row0 = 0; u.gidx = (const int*)(a->ws + WS_IDX) + list0;
            u.B = (const bf16*)(a->ws + WS_P + PO_WGU) + ((size_t)e * 2048 + (size_t)pn * 256) * D; }
        else { u.A = (const bf16*)(a->ws + WS_P + PO_HID); u.lda = D; u.a_row0 = list0; u.gidx = nullptr;
            u.B = (const bf16*)(a->ws + WS_P + PO_WD) + ((size_t)e * 1024 + (size_t)pn * 256) * D; }
    }
    struct Pre { float gt; };
    __device__ __forceinline__ Pre pre(const Unit& u, int r, int) const { Pre p; p.gt = MODE == 1 ? ((const float*)(a->ws + WS_GATE))[(size_t)u.aux + r] : 0.f; return p; }
    __device__ __forceinline__ void epi(const Unit& u, int r, int c, f32x4 lo0, f32x4 lo1, f32x4 hi0, f32x4 hi1, const Pre& pr) const {
        const size_t hrow = (size_t)u.aux + r;
        if (MODE == 0) {
            bf16* o = (bf16*)(a->ws + WS_P + PO_HID) + hrow * D + u.pn * 128 + c;
            v4u w; w.x = pk2(siluf_(lo0[0]) * hi0[0], siluf_(lo0[1]) * hi0[1]); w.y = pk2(siluf_(lo0[2]) * hi0[2], siluf_(lo0[3]) * hi0[3]);
            w.z = pk2(siluf_(lo1[0]) * hi1[0], siluf_(lo1[1]) * hi1[1]); w.w = pk2(siluf_(lo1[2]) * hi1[2], siluf_(lo1[3]) * hi1[3]); *(v4u*)o = w;
        } else {
            const float gt = pr.gt;
            bf16* o = (bf16*)(a->ws + WS_P + PO_YM) + hrow * D + u.pn * 256 + c;
            v4u w; w.x = pk2(gt * lo0[0], gt * lo0[1]); w.y = pk2(gt * lo0[2], gt * lo0[3]); w.z = pk2(gt * lo1[0], gt * lo1[1]); w.w = pk2(gt * lo1[2], gt * lo1[3]); *(v4u*)o = w;
            w.x = pk2(gt * hi0[0], gt * hi0[1]); w.y = pk2(gt * hi0[2], gt * hi0[3]); w.z = pk2(gt * hi1[0], gt * hi1[1]); w.w = pk2(gt * hi1[2], gt * hi1[3]); *(v4u*)(o + 128) = w;
        }
    }
};


namespace pg8 {
constexpr int BM = 256, BK = 64, HALF = 128, HTB = HALF * BK * 2, STAGE_BYTES = 8 * HTB;
__device__ __forceinline__ int lds_byte(int r, int c) { const int st = (r >> 4) * 2 + (c >> 5), rr = r & 15, cc = c & 31, ob = rr * 64 + cc * 2; return st * 1024 + (ob ^ (((ob >> 9) & 1) << 5)); }
__device__ __forceinline__ void stage_rc(int b, int& R, int& C) { const int st = b / 1024, sb = b % 1024, swz = sb ^ (((sb >> 9) & 1) << 5); R = (st >> 1) * 16 + swz / 64; C = (st & 1) * 32 + (swz % 64) / 2; }
__device__ __forceinline__ int perm32(int rho) { const int n = rho >> 4, i = rho & 15; return 8 * (i >> 2) + 4 * n + (i & 3); }

template <bool GATHER> __device__ __forceinline__ void unit_voffA(const Unit& u, int tid, unsigned (&vo)[4]) {
#pragma unroll
    for (int h = 0; h < 2; ++h)
#pragma unroll
        for (int i = 0; i < 2; ++i) { int R, C; stage_rc(tid * 16 + i * 8192, R, C); const int r = h * HALF + R;
            if (GATHER) { int row = u.gidx[r]; row = (unsigned)row < (unsigned)NROW ? row : 0; vo[h * 2 + i] = ((unsigned)row * (unsigned)u.lda + (unsigned)C) * 2u; }
            else vo[h * 2 + i] = ((unsigned)r * (unsigned)u.lda + (unsigned)C) * 2u; }
}

__device__ __forceinline__ __amdgpu_buffer_rsrc_t mk_rsrc(const char* p) {
    const unsigned long long v = (unsigned long long)p;
    const unsigned lo = __builtin_amdgcn_readfirstlane((unsigned)v), hi = __builtin_amdgcn_readfirstlane((unsigned)(v >> 32));
    return __builtin_amdgcn_make_buffer_rsrc((void*)(((unsigned long long)hi << 32) | lo), 0, 0x7fffffff, 0x00020000);
}

template <class Prob>
__device__ __forceinline__ void gemm_phase(LAS unsigned char* lds, const Prob& prob, int G, int bid) {
    constexpr bool GATHER = Prob::GATHER;
    int tid_ = threadIdx.x; asm volatile("" : "+v"(tid_));
    const int tid = tid_, wid = __builtin_amdgcn_readfirstlane(tid >> 6), lane = tid & 63, wr = wid >> 2, wc = wid & 3, fr = lane & 15, fq = lane >> 4;
    constexpr int K = 1024, nt = K / BK;
    unsigned voffB[2];
#pragma unroll
    for (int i = 0; i < 2; ++i) { int R, C; stage_rc(tid * 16 + i * 8192, R, C); const int Rb = (R & ~31) + perm32(R & 31); voffB[i] = (unsigned)(Rb * K + C) * 2u; }
    constexpr int kstep = BK * 2;
    constexpr int hstep = HALF * K * 2;
    const unsigned ldsw = (unsigned)wid * 1024u;
    const int aoff = lds_byte(wr * 64 + fr, fq * 8), boff = lds_byte(wc * 32 + fr, fq * 8);
#define PG8_SA(b, h) (((b) * 2 + (h)) * HTB)
#define PG8_SB(b, h) ((4 + (b) * 2 + (h)) * HTB)
#define PG8_STAGE2(bufoff, rsrc, v0, v1, soff) do { \
        __builtin_amdgcn_raw_ptr_buffer_load_lds(rsrc, (LAS unsigned*)(lds + (bufoff) + ldsw), 16, (int)(v0), (int)(soff), 0, 0); \
        __builtin_amdgcn_raw_ptr_buffer_load_lds(rsrc, (LAS unsigned*)(lds + (bufoff) + ldsw + 8192), 16, (int)(v1), (int)(soff), 0, 0); } while (0)
#define PG8_STAGEB(bufoff, rsrc, soff) PG8_STAGE2(bufoff, rsrc, voffB[0], voffB[1], soff)
#define PG8_LDA(dst, b, h) do { _Pragma("unroll") for (int m = 0; m < 4; ++m) _Pragma("unroll") for (int k = 0; k < 2; ++k) dst[m][k] = *(const LAS bf16x8*)(lds + PG8_SA(b, h) + aoff + m * 2048 + k * 1024); } while (0)
#define PG8_LDB(dst, b, h) do { _Pragma("unroll") for (int n = 0; n < 2; ++n) _Pragma("unroll") for (int k = 0; k < 2; ++k) dst[n][k] = *(const LAS bf16x8*)(lds + PG8_SB(b, h) + boff + n * 2048 + k * 1024); } while (0)
#define PG8_MMA(ai, bj, At, Bt) do { __builtin_amdgcn_s_setprio(1); _Pragma("unroll") for (int m = 0; m < 4; ++m) _Pragma("unroll") for (int n = 0; n < 2; ++n) _Pragma("unroll") for (int k = 0; k < 2; ++k) \
        acc[ai][bj][m][n] = __builtin_amdgcn_mfma_f32_16x16x32_bf16(Bt[n][k], At[m][k], acc[ai][bj][m][n], 0, 0, 0); __builtin_amdgcn_s_setprio(0); } while (0)
#define PG8_WAIT_V(n) asm volatile("s_waitcnt vmcnt(" #n ")" ::: "memory")
#define PG8_WAIT_L(n) asm volatile("s_waitcnt lgkmcnt(" #n ")" ::: "memory")
#define PG8_BAR __builtin_amdgcn_s_barrier()
#define PG8_SCHED __builtin_amdgcn_sched_barrier(0)
    const int nun = prob.nunits();
    int L = bid;
    if (L >= nun) return;
    Unit cur, nxt; prob.unit(L, cur);
    unsigned voA[4], nvoA[4];
    unit_voffA<GATHER>(cur, tid, voA);
    const char* cA = (const char*)cur.A + (GATHER ? (size_t)0 : (size_t)cur.a_row0 * cur.lda * 2); const char* cB = (const char*)cur.B;
    {
        const __amdgpu_buffer_rsrc_t rA = mk_rsrc(cA), rB = mk_rsrc(cB);
        PG8_STAGEB(PG8_SB(0, 0), rB, 0); PG8_STAGEB(PG8_SB(0, 1), rB, hstep); PG8_STAGE2(PG8_SA(0, 0), rA, voA[0], voA[1], 0); PG8_STAGE2(PG8_SA(0, 1), rA, voA[2], voA[3], 0);
        if (wr == 1) PG8_BAR;
        PG8_WAIT_V(2); PG8_BAR;
        PG8_STAGEB(PG8_SB(1, 0), rB, kstep); PG8_STAGE2(PG8_SA(1, 0), rA, voA[0], voA[1], kstep); PG8_STAGEB(PG8_SB(1, 1), rB, hstep + kstep);
        PG8_WAIT_V(6); PG8_BAR; PG8_SCHED;
    }
    f32x4 acc[2][2][4][2];
#pragma unroll
    for (int a = 0; a < 2; ++a)
#pragma unroll
        for (int b = 0; b < 2; ++b)
#pragma unroll
            for (int m = 0; m < 4; ++m)
#pragma unroll
                for (int n = 0; n < 2; ++n) acc[a][b][m][n] = (f32x4){0.f, 0.f, 0.f, 0.f};
    bf16x8 At[4][2], B0[2][2], B1[2][2];
    for (;;) {
        const bool has_next = (L + G < nun);
        const char* nA = cA; const char* nB = cB;
#pragma unroll
        for (int i = 0; i < 4; ++i) nvoA[i] = voA[i];
        if (has_next) { prob.unit(L + G, nxt); if (GATHER) unit_voffA<GATHER>(nxt, tid, nvoA); nA = (const char*)nxt.A + (GATHER ? (size_t)0 : (size_t)nxt.a_row0 * nxt.lda * 2); nB = (const char*)nxt.B; }
        const __amdgpu_buffer_rsrc_t rA1 = mk_rsrc(cA);
        for (int t = 0; t < nt; t += 2) {
            const bool last = (t == nt - 2);
            const __amdgpu_buffer_rsrc_t rA2 = mk_rsrc(last ? nA : cA), rB2 = mk_rsrc(last ? nB : cB);
            const int o1 = (t + 1) * kstep, o2 = last ? 0 : (t + 2) * kstep, o3 = o2 + kstep;
            const unsigned s0 = (GATHER && last) ? nvoA[0] : voA[0], s1 = (GATHER && last) ? nvoA[1] : voA[1], s2 = (GATHER && last) ? nvoA[2] : voA[2], s3 = (GATHER && last) ? nvoA[3] : voA[3];
            PG8_LDB(B0, 0, 0); PG8_LDB(B1, 0, 1); PG8_SCHED; PG8_LDA(At, 0, 0); PG8_STAGE2(PG8_SA(1, 1), rA1, voA[2], voA[3], o1);
            PG8_WAIT_V(8); PG8_WAIT_L(0); PG8_BAR; PG8_MMA(0, 0, At, B0); PG8_MMA(0, 1, At, B1); PG8_BAR; PG8_SCHED;
            PG8_LDA(At, 0, 1); PG8_STAGEB(PG8_SB(0, 0), rB2, o2); PG8_STAGEB(PG8_SB(0, 1), rB2, o2 + hstep); PG8_STAGE2(PG8_SA(0, 0), rA2, s0, s1, o2);
            PG8_WAIT_V(8); PG8_WAIT_L(0); PG8_BAR; PG8_MMA(1, 0, At, B0); PG8_MMA(1, 1, At, B1); PG8_BAR; PG8_SCHED;
            PG8_LDB(B0, 1, 0); PG8_LDB(B1, 1, 1); PG8_SCHED; PG8_LDA(At, 1, 0); PG8_STAGE2(PG8_SA(0, 1), rA2, s2, s3, o2);
            PG8_WAIT_V(8); PG8_WAIT_L(0); PG8_BAR; PG8_MMA(0, 0, At, B0); PG8_MMA(0, 1, At, B1); PG8_BAR; PG8_SCHED;
            PG8_LDA(At, 1, 1); PG8_STAGEB(PG8_SB(1, 0), rB2, o3); PG8_STAGEB(PG8_SB(1, 1), rB2, o3 + hstep); PG8_STAGE2(PG8_SA(1, 0), rA2, s0, s1, o3);
            PG8_WAIT_V(8); PG8_WAIT_L(0); PG8_BAR; PG8_MMA(1, 0, At, B0); PG8_MMA(1, 1, At, B1); PG8_BAR; PG8_SCHED;
        }
        if (wr == 0) PG8_BAR;
        {
            typename Prob::Pre pcur = prob.pre(cur, wr * 64 + fr, wc * 32 + fq * 8);
#pragma unroll
            for (int q = 0; q < 8; ++q) { const int ai = q >> 2, m = q & 3, r = ai * HALF + wr * 64 + m * 16 + fr, qn = q < 7 ? q + 1 : 7, rn = (qn >> 2) * HALF + wr * 64 + (qn & 3) * 16 + fr;
                const typename Prob::Pre pnext = prob.pre(cur, rn, wc * 32 + fq * 8);
                prob.epi(cur, r, wc * 32 + fq * 8, acc[ai][0][m][0], acc[ai][0][m][1], acc[ai][1][m][0], acc[ai][1][m][1], pcur); if (Prob::GATHER || true) { if (!Prob::NOSCHED) PG8_SCHED; }
                pcur = pnext; }
        }
        if (!has_next) break;
#pragma unroll
        for (int a = 0; a < 2; ++a)
#pragma unroll
            for (int b = 0; b < 2; ++b)
#pragma unroll
                for (int m = 0; m < 4; ++m)
#pragma unroll
                    for (int n = 0; n < 2; ++n) acc[a][b][m][n] = (f32x4){0.f, 0.f, 0.f, 0.f};
        cur = nxt; cA = nA; cB = nB; L += G;
#pragma unroll
        for (int i = 0; i < 4; ++i) voA[i] = nvoA[i];
        if (wr == 1) PG8_BAR;
    }
    PG8_WAIT_V(0);
    PG8_BAR;
#undef PG8_SA
#undef PG8_SB
#undef PG8_STAGE2
#undef PG8_STAGEB
#undef PG8_LDA
#undef PG8_LDB
#undef PG8_MMA
#undef PG8_WAIT_V
#undef PG8_WAIT_L
#undef PG8_BAR
#undef PG8_SCHED
}
}

template <class P> __global__ void __launch_bounds__(256) k_gemm_simple(Args args, int layer) {
    __shared__ float As[32][68]; __shared__ float Bs[32][260];
    P prob{&args, layer};
    const int L = blockIdx.x >> 2, rb = blockIdx.x & 3, tid = threadIdx.x, ty = tid >> 4, tx = tid & 15;
    if (L >= prob.nunits()) return;
    Unit u; prob.unit(L, u);
    const int ar = tid >> 2, aq = tid & 3;
    int arow = u.gidx ? u.gidx[rb * 64 + ar] : (u.a_row0 + rb * 64 + ar);
    arow = arow < 0 ? 0 : (arow >= NROW + NLIST ? 0 : arow);
    const bf16* ap = u.A + (size_t)arow * u.lda + aq * 8;
    float acc[2][4][8];
#pragma unroll
    for (int h = 0; h < 2; ++h)
#pragma unroll
        for (int i = 0; i < 4; ++i)
#pragma unroll
            for (int j = 0; j < 8; ++j) acc[h][i][j] = 0.f;
    for (int k0 = 0; k0 < D; k0 += 32) {
        v4u av = *(const v4u*)(ap + k0); v4u bv[4];
#pragma unroll
        for (int j = 0; j < 4; ++j) { const int p = tid + 256 * j; bv[j] = *(const v4u*)(u.B + (size_t)(p >> 2) * D + k0 + (p & 3) * 8); }
        __syncthreads();
        { const int kk = aq * 8; As[kk + 0][ar] = bflo(av.x); As[kk + 1][ar] = bfhi(av.x); As[kk + 2][ar] = bflo(av.y); As[kk + 3][ar] = bfhi(av.y); As[kk + 4][ar] = bflo(av.z); As[kk + 5][ar] = bfhi(av.z); As[kk + 6][ar] = bflo(av.w); As[kk + 7][ar] = bfhi(av.w); }
#pragma unroll
        for (int j = 0; j < 4; ++j) { const int p = tid + 256 * j, br = p >> 2, kk = (p & 3) * 8; Bs[kk + 0][br] = bflo(bv[j].x); Bs[kk + 1][br] = bfhi(bv[j].x); Bs[kk + 2][br] = bflo(bv[j].y); Bs[kk + 3][br] = bfhi(bv[j].y);
            Bs[kk + 4][br] = bflo(bv[j].z); Bs[kk + 5][br] = bfhi(bv[j].z); Bs[kk + 6][br] = bflo(bv[j].w); Bs[kk + 7][br] = bfhi(bv[j].w); }
        __syncthreads();
#pragma unroll 4
        for (int k = 0; k < 32; ++k) {
            const f32x4 a4 = *(const f32x4*)&As[k][ty * 4];
            const f32x4 b0 = *(const f32x4*)&Bs[k][tx * 8], b1 = *(const f32x4*)&Bs[k][tx * 8 + 4], b2 = *(const f32x4*)&Bs[k][128 + tx * 8], b3 = *(const f32x4*)&Bs[k][128 + tx * 8 + 4];
#pragma unroll
            for (int i = 0; i < 4; ++i)
#pragma unroll
                for (int j = 0; j < 4; ++j) { acc[0][i][j] += a4[i] * b0[j]; acc[0][i][4 + j] += a4[i] * b1[j]; acc[1][i][j] += a4[i] * b2[j]; acc[1][i][4 + j] += a4[i] * b3[j]; }
        }
    }
#pragma unroll
    for (int i = 0; i < 4; ++i)
        prob.epi(u, rb * 64 + ty * 4 + i, tx * 8, (f32x4){acc[0][i][0], acc[0][i][1], acc[0][i][2], acc[0][i][3]}, (f32x4){acc[0][i][4], acc[0][i][5], acc[0][i][6], acc[0][i][7]},
                 (f32x4){acc[1][i][0], acc[1][i][1], acc[1][i][2], acc[1][i][3]}, (f32x4){acc[1][i][4], acc[1][i][5], acc[1][i][6], acc[1][i][7]}, prob.pre(u, rb * 64 + ty * 4 + i, tx * 8));
}

__global__ void __launch_bounds__(256) k_ssd_naive(Args args, int l) {
    __shared__ float xs[32][64]; __shared__ float Bsm[32][128]; __shared__ float Csm[32][128]; __shared__ float dts[32];
    const int b = blockIdx.x >> 4, h = blockIdx.x & 15, g = h >> 2, tid = threadIdx.x, p = tid >> 2, nq = tid & 3;
    const bf16* P = (const bf16*)(args.ws + WS_P); bf16* Y = (bf16*)(args.ws + WS_XM); const float* DT = (const float*)(args.ws + WS_DT);
    const float* cw = args.in[I_CONVW] + (size_t)l * 3 * 2048; const float* cb = args.in[I_CONVB] + (size_t)l * 2048;
    const float dskip = args.in[I_DSKIP][l * 16 + h];
    for (int dir = 0; dir < 2; ++dir) {
        float st[32];
#pragma unroll
        for (int i = 0; i < 32; ++i) st[i] = 0.f;
        const float Ah = -__expf(args.in[I_ALOG][(l * 2 + dir) * 16 + h]);
        for (int seg = 0; seg < 2; ++seg) {
            const int base = seg == 0 ? NLAT + b * CTXL : b * SEQ, len = seg == 0 ? CTXL : SEQ;
            const bool wy = !(l == 1 && seg == 0);
            for (int blk = 0; blk < len / 32; ++blk) {
                for (int idx = tid; idx < 32 * 320; idx += 256) {
                    const int tt = idx / 320, ch = idx % 320;
                    const int tok = dir == 0 ? blk * 32 + tt : len - 1 - (blk * 32 + tt);
                    const int col = ch < 64 ? PX + h * 64 + ch : (ch < 192 ? PB + g * 128 + (ch - 64) : PC + g * 128 + (ch - 192));
                    const bf16* pp = P + (size_t)(base + tok) * PW + col;
                    const float cur = bf2f(pp[0]), prv = tok > 0 ? bf2f(pp[-PW]) : 0.f, nxt = tok < len - 1 ? bf2f(pp[PW]) : 0.f;
                    const float v = siluf_(cw[col] * prv + cw[2048 + col] * cur + cw[4096 + col] * nxt + cb[col]);
                    if (ch < 64) xs[tt][ch] = v; else if (ch < 192) Bsm[tt][ch - 64] = v; else Csm[tt][ch - 192] = v;
                }
                if (tid < 32) { const int tok = dir == 0 ? blk * 32 + tid : len - 1 - (blk * 32 + tid); dts[tid] = DT[(size_t)(base + tok) * 32 + dir * 16 + h]; }
                __syncthreads();
                for (int tt = 0; tt < 32; ++tt) {
                    const float dt = dts[tt], dA = __expf(dt * Ah), xr = xs[tt][p], xv = xr * dt;
                    float ys = 0.f;
#pragma unroll
                    for (int i = 0; i < 32; ++i) { const int n = nq * 32 + i; st[i] = st[i] * dA + xv * Bsm[tt][n]; ys += st[i] * Csm[tt][n]; }
                    ys += __shfl_xor(ys, 1); ys += __shfl_xor(ys, 2);
                    if (nq == 0 && wy) { const int tok = dir == 0 ? blk * 32 + tt : len - 1 - (blk * 32 + tt); bf16* yp = Y + (size_t)(base + tok) * D + h * 64 + p;
                        if (dir == 0) *yp = (bf16)f2bf(ys + dskip * xr); else *yp = (bf16)f2bf(bf2f(*yp) + ys); }
                }
                __syncthreads();
            }
        }
    }
}

__global__ void __launch_bounds__(512) k_sgu_naive(Args args, int l) {
    extern __shared__ __attribute__((aligned(16))) unsigned char smem[];
    float* Vn = (float*)smem; float* mu = Vn + 128 * 128; float* rs = mu + 128;
    const int chunk = blockIdx.x >> 3, g = blockIdx.x & 7, tid = threadIdx.x, lane = tid & 63, wave = tid >> 6;
    const int row0 = chunk < 256 ? chunk * 128 : NLAT + (chunk - 256) * 128;
    bf16* P = (bf16*)(args.ws + WS_P);
    for (int rr = 0; rr < 16; ++rr) { const int j = wave * 16 + rr; const bf16* vp = P + (size_t)(row0 + j) * PW + PV;
        float v[16]; float s = 0.f;
#pragma unroll
        for (int q = 0; q < 2; ++q) { const v4u w = *(const v4u*)(vp + lane * 8 + 512 * q); v[q * 8 + 0] = bflo(w.x); v[q * 8 + 1] = bfhi(w.x); v[q * 8 + 2] = bflo(w.y); v[q * 8 + 3] = bfhi(w.y); v[q * 8 + 4] = bflo(w.z); v[q * 8 + 5] = bfhi(w.z); v[q * 8 + 6] = bflo(w.w); v[q * 8 + 7] = bfhi(w.w); }
#pragma unroll
        for (int i = 0; i < 16; ++i) s += v[i];
        const float m = wave_sum(s) * (1.f / D); float s2 = 0.f;
#pragma unroll
        for (int i = 0; i < 16; ++i) { const float d = v[i] - m; s2 += d * d; }
        const float var = wave_sum(s2) * (1.f / D);
        if (lane == 0) { mu[j] = m; rs[j] = rsqrtf(var + EPS); } }
    __syncthreads();
    const float* lnw = args.in[I_LNW] + l * D + g * 128; const float* lnb = args.in[I_LNB] + l * D + g * 128;
    for (int idx = tid; idx < 128 * 128; idx += 512) { const int j = idx >> 7, d = idx & 127; Vn[idx] = (bf2f(P[(size_t)(row0 + j) * PW + PV + g * 128 + d]) - mu[j]) * rs[j] * lnw[d] + lnb[d]; }
    __syncthreads();
    const float* Wsg = args.in[I_WS] + ((size_t)(l * 8 + g) * 128) * 128; const float* bsg = args.in[I_BS] + (l * 8 + g) * 128;
    for (int idx = tid; idx < 128 * 128; idx += 512) { const int i = idx >> 7, d = idx & 127; float s = 0.f;
        for (int j = 0; j < 128; ++j) s += Wsg[i * 128 + j] * Vn[j * 128 + d];
        bf16* up = P + (size_t)(row0 + i) * PW + PU + g * 128 + d; *up = (bf16)f2bf(bf2f(*up) * (s + bsg[i])); }
}

__device__ __forceinline__ void tr_item(const float* W, int ldw, bf16* WT, int K, int k0, int n0, int drow0, LAS float* scr, int lane) {
    float tv[32];
#pragma unroll
    for (int i = 0; i < 32; ++i) tv[i] = W[(size_t)(k0 + 2 * i + (lane >> 5)) * ldw + n0 + (lane & 31)];
#pragma unroll
    for (int i = 0; i < 32; ++i) scr[(2 * i + (lane >> 5)) * 33 + (lane & 31)] = tv[i];
    asm volatile("s_waitcnt lgkmcnt(0)" ::: "memory");
    const int c = lane & 7;
#pragma unroll
    for (int j = 0; j < 4; ++j) { const int n = (lane >> 3) + 8 * j; const LAS float* s = scr + (8 * c) * 33 + n;
        v4u o; o.x = pk2(s[0 * 33], s[1 * 33]); o.y = pk2(s[2 * 33], s[3 * 33]); o.z = pk2(s[4 * 33], s[5 * 33]); o.w = pk2(s[6 * 33], s[7 * 33]);
        *(v4u*)(WT + (size_t)(drow0 + n) * K + k0 + 8 * c) = o; }
    asm volatile("s_waitcnt lgkmcnt(0)" ::: "memory");
}

__device__ __forceinline__ void phase_prologue(const Frame& F) {
    const Args& a = *F.a;
    LAS float* sc = (LAS float*)F.lds; LAS float* red = sc + 17 * 1024;
    if (F.bid < 192) {
        for (int i = F.tid; i < 17 * 1024; i += 512) { const int r = i >> 10, k = i & 1023; const float v = r < 16 ? a.in[I_C][r * 1024 + k] : a.in[I_CCTX][k]; sc[i] = siluf_(v); }
        __syncthreads();
        for (int it = F.bid; it < 192; it += F.G) {
            const int l = it / 96, nb = it % 96, n = nb * 64 + F.lane;
            float acc[17];
#pragma unroll
            for (int r = 0; r < 17; ++r) acc[r] = 0.f;
            const float* W = a.in[I_ADAW] + (size_t)l * 1024 * 6144 + n;
#pragma unroll 4
            for (int kk = 0; kk < 128; ++kk) { const int k = F.wave * 128 + kk; const float wv = W[(size_t)k * 6144];
#pragma unroll
                for (int r = 0; r < 17; ++r) acc[r] += sc[r * 1024 + k] * wv; }
#pragma unroll
            for (int r = 0; r < 17; ++r) red[(F.wave * 17 + r) * 64 + F.lane] = acc[r];
            __syncthreads();
            for (int i = F.tid; i < 17 * 64; i += 512) { const int r = i >> 6, ln = i & 63; float s = 0.f;
#pragma unroll
                for (int w = 0; w < 8; ++w) s += red[(w * 17 + r) * 64 + ln];
                ((float*)(a.ws + WS_MOD))[(size_t)(l * 17 + r) * 6144 + nb * 64 + ln] = s + a.in[I_ADAB][l * 6144 + nb * 64 + ln]; }
            __syncthreads();
        }
    }
    __syncthreads();
    LAS float* scr = (LAS float*)(F.lds + F.wave * 8448);
    const int gw = F.bid * F.nw + F.wave, NGW = F.G * F.nw;
    constexpr int IT_IN = 16 * 225, IT_MX = 16 * 32, IT_L = IT_IN + 3 * IT_MX;
    for (int it = gw; it < 2 * IT_L; it += NGW) {
        const int l = it / IT_L; int r = it % IT_L;
        if (r < IT_IN) { const int kb = r / 225, nb = r % 225, n0 = nb * 32; const int d0 = n0 < 2048 ? n0 : (n0 < 2080 ? 7168 + (n0 - 2048) : n0 - 32);
            tr_item(a.in[I_WIN] + (size_t)l * D * NIN, NIN, (bf16*)(a.ws + WS_WIN) + (size_t)l * WIN_ROWS * D, D, kb * 64, n0, d0, scr, F.lane); }
        else { r -= IT_IN; const int m = r / IT_MX, q = r % IT_MX, kb = q / 32, nb = q % 32;
            const float* W = (m == 0 ? a.in[I_WPA] : (m == 1 ? a.in[I_WPB] : a.in[I_WO])) + (size_t)l * D * D;
            tr_item(W, D, (bf16*)(a.ws + WS_WMIX) + (size_t)(l * 3 + m) * D * D, D, kb * 64, nb * 32, nb * 32, scr, F.lane); }
    }
    for (int i = F.bid * 512 + F.tid; i < 2 * 224 * 128; i += F.G * 512) { const int l = i / (224 * 128), q = i % (224 * 128);
        *(v4u*)((bf16*)(a.ws + WS_WIN) + ((size_t)l * WIN_ROWS + 7200) * D + (size_t)q * 8) = (v4u){0u, 0u, 0u, 0u}; }
    for (int i = F.bid * 512 + F.tid; i < 2 * 8 * 128 * 128 / 4; i += F.G * 512) { const f32x4 v = *(const f32x4*)(a.in[I_WS] + (size_t)i * 4); *(v2u*)((bf16*)(a.ws + WS_WST) + (size_t)i * 4) = pack4(v); }
}

__device__ __forceinline__ void convert_experts(const Frame& F, int l) {
    const Args& a = *F.a;
    LAS float* scr = (LAS float*)(F.lds + 65536 + F.wave * 8448);
    const int gw = F.bid * F.nw + F.wave, NGW = F.G * F.nw;
    for (int it = gw; it < 16 * 3 * 512; it += NGW) {
        const int e = it / 1536, r = it % 1536, m = r / 512, q = r % 512, kb = q / 32, nb = q % 32, n0 = nb * 32;
        const float* W = (m == 0 ? a.in[I_WG] : (m == 1 ? a.in[I_WU] : a.in[I_WD])) + ((size_t)l * 16 + e) * D * D;
        if (m < 2) tr_item(W, D, (bf16*)(a.ws + WS_P + PO_WGU) + (size_t)e * 2048 * D, D, kb * 64, n0, (n0 >> 7) * 256 + m * 128 + (n0 & 127), scr, F.lane);
        else tr_item(W, D, (bf16*)(a.ws + WS_P + PO_WD) + (size_t)e * 1024 * D, D, kb * 64, n0, n0, scr, F.lane);
    }
}

__device__ __forceinline__ void moe_combine(const Frame& F, int lprev, int r, f32x4 (&v)[4]) {
    const Args& a = *F.a;
    const int* inv = (const int*)(a.ws + WS_INV) + (size_t)r * 16;
    const int myslot = F.lane < 16 ? inv[F.lane] : -1;
    const bool lat = r < NLAT; const int b = lat ? (r >> 11) : ((r - NLAT) >> 8);
    f32x4 s[4];
#pragma unroll
    for (int j = 0; j < 4; ++j) s[j] = (f32x4){0.f, 0.f, 0.f, 0.f};
    const bf16* YM = (const bf16*)(a.ws + WS_P + PO_YM);
    for (int e = 0; e < 16; ++e) {
        const int slot = __builtin_amdgcn_readlane(myslot, e);
        if (slot >= 0) { const size_t hrow = lat ? (size_t)((b * 16 + e) * 256 + slot) : (size_t)(LIST_C0 + e * 512 + b * 32 + slot);
            const bf16* yp = YM + hrow * D + 4 * F.lane;
#pragma unroll
            for (int j = 0; j < 4; ++j) s[j] += unpack4(*(const v2u*)(yp + 256 * j)); }
    }
    const float* g2 = modp(a, lprev, batch_row(r)) + 5120 + 4 * F.lane;
#pragma unroll
    for (int j = 0; j < 4; ++j) v[j] += *(const f32x4*)(g2 + 256 * j) * s[j];
}

__device__ __forceinline__ void phase_norm1(const Frame& F, int l) {
    const Args& a = *F.a;
    const int gw = F.bid * F.nw + F.wave, NGW = F.G * F.nw;
    for (int r = gw; r < NROW; r += NGW) {
        const bool lat = r < NLAT;
        const float* hin = (l == 0) ? (lat ? a.in[I_X] + (size_t)r * D : a.in[I_CTX] + (size_t)(r - NLAT) * D) : (lat ? a.out + (size_t)r * D : (const float*)(a.ws + WS_HC) + (size_t)(r - NLAT) * D);
        f32x4 v[4];
#pragma unroll
        for (int j = 0; j < 4; ++j) v[j] = *(const f32x4*)(hin + 4 * F.lane + 256 * j);
        if (l > 0) { moe_combine(F, l - 1, r, v); float* ho = lat ? a.out + (size_t)r * D : (float*)(a.ws + WS_HC) + (size_t)(r - NLAT) * D;
#pragma unroll
            for (int j = 0; j < 4; ++j) *(f32x4*)(ho + 4 * F.lane + 256 * j) = v[j]; }
        float ss = 0.f;
#pragma unroll
        for (int j = 0; j < 4; ++j) ss += v[j].x * v[j].x + v[j].y * v[j].y + v[j].z * v[j].z + v[j].w * v[j].w;
        const float rstd = rsqrtf(wave_sum(ss) * (1.f / D) + EPS);
        const float* md = modp(a, l, batch_row(r)) + 4 * F.lane; const float* nw = a.in[I_N1W] + l * D + 4 * F.lane;
        bf16* o = (bf16*)(a.ws + WS_XM) + (size_t)r * D + 4 * F.lane;
#pragma unroll
        for (int j = 0; j < 4; ++j) { const f32x4 w = *(const f32x4*)(nw + 256 * j), sh = *(const f32x4*)(md + 256 * j), scl = *(const f32x4*)(md + 1024 + 256 * j);
            *(v2u*)(o + 256 * j) = pack4(v[j] * rstd * w * (scl + 1.0f) + sh); }
    }
}

__device__ __forceinline__ void phase_ssdin(const Frame& F, int l) {
    const Args& a = *F.a;
    const int gw = F.bid * F.nw + F.wave, NGW = F.G * F.nw, nrows = l == 0 ? NROW : NLAT;
    const float* nw = a.in[I_SSDNW] + l * D + 4 * F.lane;
    for (int r = gw; r < nrows; r += NGW) {
        const bf16* y = (const bf16*)(a.ws + WS_XM) + (size_t)r * D + 4 * F.lane; bf16* z = (bf16*)(a.ws + WS_P) + (size_t)r * PW + PZ + 4 * F.lane;
#pragma unroll
        for (int j = 0; j < 4; ++j) { const f32x4 g = unpack4(*(const v2u*)(y + 256 * j)) * unpack4(*(const v2u*)(z + 256 * j));
            const float ms = wave_sum(g.x * g.x + g.y * g.y + g.z * g.z + g.w * g.w) * (1.f / 256.f);
            *(v2u*)(z + 256 * j) = pack4(g * rsqrtf(ms + EPS) * *(const f32x4*)(nw + 256 * j)); }
    }
}

__device__ __forceinline__ void phase_norm2(const Frame& F, int l) {
    const Args& a = *F.a;
    LAS float* rwT = (LAS float*)F.lds;
    for (int i = F.tid; i < 16 * 1024; i += 512) { const int k = i >> 4, e = i & 15; rwT[e * 1024 + k] = a.in[I_RW][(size_t)l * D * 16 + i]; }
    __syncthreads();
    const int gw = F.bid * F.nw + F.wave, NGW = F.G * F.nw, nrows = l == 0 ? NROW : NLAT;
    for (int r = gw; r < nrows; r += NGW) {
        const bool lat = r < NLAT;
        const float* hin = lat ? a.out + (size_t)r * D : (const float*)(a.ws + WS_HC) + (size_t)(r - NLAT) * D;
        f32x4 v[4]; float ss = 0.f;
#pragma unroll
        for (int j = 0; j < 4; ++j) { v[j] = *(const f32x4*)(hin + 4 * F.lane + 256 * j); ss += v[j].x * v[j].x + v[j].y * v[j].y + v[j].z * v[j].z + v[j].w * v[j].w; }
        const float rstd = rsqrtf(wave_sum(ss) * (1.f / D) + EPS);
        const float* md = modp(a, l, batch_row(r)) + 3072 + 4 * F.lane; const float* nw = a.in[I_N2W] + l * D + 4 * F.lane;
        bf16* o = (bf16*)(a.ws + WS_XM) + (size_t)r * D + 4 * F.lane;
#pragma unroll
        for (int j = 0; j < 4; ++j) { const f32x4 w = *(const f32x4*)(nw + 256 * j), sh = *(const f32x4*)(md + 256 * j), scl = *(const f32x4*)(md + 1024 + 256 * j);
            v[j] = v[j] * rstd * w * (scl + 1.0f) + sh; *(v2u*)(o + 256 * j) = pack4(v[j]); }
        float mine = 0.f;
#pragma unroll 1
        for (int e = 0; e < 16; ++e) { float s = 0.f;
#pragma unroll
            for (int j = 0; j < 4; ++j) { const f32x4 w = *(const LAS f32x4*)(rwT + e * 1024 + 4 * F.lane + 256 * j); s += v[j].x * w.x + v[j].y * w.y + v[j].z * w.z + v[j].w * w.w; }
            s = wave_sum(s); mine = (F.lane == e) ? s : mine; }
        float mx = mine;
#pragma unroll
        for (int o = 1; o < 16; o <<= 1) mx = fmaxf(mx, __shfl_xor(mx, o));
        const float ex = __expf(mine - mx); float den = ex;
#pragma unroll
        for (int o = 1; o < 16; o <<= 1) den += __shfl_xor(den, o);
        if (F.lane < 16) ((float*)(a.ws + WS_AFF))[(size_t)r * 16 + F.lane] = ex / den;
    }
    __syncthreads();
    convert_experts(F, l);
}

__device__ __forceinline__ int block_excl_scan(int c, LAS int* slots, int wave, int lane, int& total) {
    int inc = c;
#pragma unroll
    for (int o = 1; o < 64; o <<= 1) { const int v = __shfl_up(inc, o); if (lane >= o) inc += v; }
    if (lane == 63) slots[wave] = inc;
    __syncthreads();
    int before = 0, tot = 0;
#pragma unroll
    for (int w2 = 0; w2 < 8; ++w2) { const int v = slots[w2]; tot += v; before += (w2 < wave) ? v : 0; }
    __syncthreads();
    total = tot;
    return before + inc - c;
}
__device__ __forceinline__ void phase_topk(const Frame& F, int l) {
    const Args& a = *F.a;
    LAS int* cnts = (LAS int*)F.lds;
    const int ntask = l == 0 ? 512 : 256;
    const float* AFF = (const float*)(a.ws + WS_AFF); int* INV = (int*)(a.ws + WS_INV); int* IDX = (int*)(a.ws + WS_IDX); float* GATE = (float*)(a.ws + WS_GATE);
    for (int task = F.bid; task < ntask; task += F.G) {
        const bool lat = task < 256; const int t = lat ? task : task - 256, b = t >> 4, e = t & 15;
        const int r0 = lat ? b * SEQ : NLAT + b * CTXL, n = lat ? SEQ : CTXL, cap = lat ? CAP_L : CAP_C;
        const int list0 = lat ? (b * 16 + e) * 256 : LIST_C0 + e * 512 + b * 32;
        unsigned k[4]; bool valid[4];
#pragma unroll
        for (int q = 0; q < 4; ++q) { const int i = 4 * F.tid + q; valid[q] = i < n; k[q] = valid[q] ? __builtin_bit_cast(unsigned, AFF[(size_t)(r0 + i) * 16 + e]) : 0u; }
        unsigned T = 0u;
        for (int bit = 30; bit >= 0; --bit) {
            const unsigned trial = T | (1u << bit);
            int c = 0;
#pragma unroll
            for (int q = 0; q < 4; ++q) c += __builtin_popcountll(__ballot(valid[q] && k[q] >= trial));
            LAS int* sl = cnts + (bit & 1) * 8;
            if (F.lane == 0) sl[F.wave] = c;
            __syncthreads();
            int tot = 0;
#pragma unroll
            for (int w2 = 0; w2 < 8; ++w2) tot += sl[w2];
            if (tot >= cap) T = trial;
        }
        __syncthreads();
        int cgt = 0, ceq = 0;
#pragma unroll
        for (int q = 0; q < 4; ++q) { cgt += (valid[q] && k[q] > T) ? 1 : 0; ceq += (valid[q] && k[q] == T) ? 1 : 0; }
        int ngt, neq;
        (void)block_excl_scan(cgt, cnts + 16, F.wave, F.lane, ngt);
        int eqr = block_excl_scan(ceq, cnts + 16, F.wave, F.lane, neq);
        const int need = cap - ngt;
        bool sel[4]; int csel = 0;
#pragma unroll
        for (int q = 0; q < 4; ++q) { const bool eq = valid[q] && k[q] == T; sel[q] = valid[q] && (k[q] > T || (eq && eqr < need)); eqr += eq ? 1 : 0; csel += sel[q] ? 1 : 0; }
        int nsel; int slot = block_excl_scan(csel, cnts + 16, F.wave, F.lane, nsel);
#pragma unroll
        for (int q = 0; q < 4; ++q) { const int i = 4 * F.tid + q;
            if (valid[q]) { const int sl = sel[q] ? slot : -1; INV[(size_t)(r0 + i) * 16 + e] = sl;
                if (sel[q]) { IDX[list0 + slot] = r0 + i; GATE[list0 + slot] = __builtin_bit_cast(float, k[q]); ++slot; } } }
    }
}

__device__ __forceinline__ void phase_final(const Frame& F) {
    const Args& a = *F.a;
    const int gw = F.bid * F.nw + F.wave, NGW = F.G * F.nw;
    for (int r = gw; r < NLAT; r += NGW) {
        float* h = a.out + (size_t)r * D + 4 * F.lane; f32x4 v[4];
#pragma unroll
        for (int j = 0; j < 4; ++j) v[j] = *(const f32x4*)(h + 256 * j);
        moe_combine(F, 1, r, v);
        float ss = 0.f;
#pragma unroll
        for (int j = 0; j < 4; ++j) ss += v[j].x * v[j].x + v[j].y * v[j].y + v[j].z * v[j].z + v[j].w * v[j].w;
        const float rstd = rsqrtf(wave_sum(ss) * (1.f / D) + EPS);
#pragma unroll
        for (int j = 0; j < 4; ++j) *(f32x4*)(h + 256 * j) = v[j] * rstd * *(const f32x4*)(a.in[I_FNW] + 4 * F.lane + 256 * j);
    }
}


__device__ __forceinline__ void phase_ssd_seq(const Frame& F, int l) {
    const Args& a = *F.a;
    LAS float* xs = (LAS float*)F.lds; LAS float* Bsm = xs + 32 * 64; LAS float* Csm = Bsm + 32 * 128; LAS float* dts = Csm + 32 * 128;
    const bf16* P = (const bf16*)(a.ws + WS_P); bf16* Y = (bf16*)(a.ws + WS_XM); const float* DT = (const float*)(a.ws + WS_DT);
    const float* cw = a.in[I_CONVW] + (size_t)l * 3 * 2048; const float* cb = a.in[I_CONVB] + (size_t)l * 2048;
    const int tid = F.tid, p = tid >> 3, nq = tid & 7;
    for (int task = F.bid; task < 256; task += F.G) {
        const int b = task >> 4, h = task & 15, g = h >> 2;
        const float dskip = a.in[I_DSKIP][l * 16 + h];
        for (int dir = 0; dir < 2; ++dir) {
            float st[16];
#pragma unroll
            for (int i = 0; i < 16; ++i) st[i] = 0.f;
            const float Ah = -__expf(a.in[I_ALOG][(l * 2 + dir) * 16 + h]);
            for (int seg = 0; seg < 2; ++seg) {
                const int base = seg == 0 ? NLAT + b * CTXL : b * SEQ, len = seg == 0 ? CTXL : SEQ;
                const bool wy = !(l == 1 && seg == 0);
                for (int blk = 0; blk < len / 32; ++blk) {
                    for (int idx = tid; idx < 32 * 320; idx += 512) {
                        const int tt = idx / 320, ch = idx % 320;
                        const int tok = dir == 0 ? blk * 32 + tt : len - 1 - (blk * 32 + tt);
                        const int col = ch < 64 ? PX + h * 64 + ch : (ch < 192 ? PB + g * 128 + (ch - 64) : PC + g * 128 + (ch - 192));
                        const bf16* pp = P + (size_t)(base + tok) * PW + col;
                        const float cur = bf2f(pp[0]), prv = tok > 0 ? bf2f(pp[-PW]) : 0.f, nxt = tok < len - 1 ? bf2f(pp[PW]) : 0.f;
                        const float v = siluf_(cw[col] * prv + cw[2048 + col] * cur + cw[4096 + col] * nxt + cb[col]);
                        if (ch < 64) xs[tt * 64 + ch] = v; else if (ch < 192) Bsm[tt * 128 + ch - 64] = v; else Csm[tt * 128 + ch - 192] = v;
                    }
                    if (tid < 32) { const int tok = dir == 0 ? blk * 32 + tid : len - 1 - (blk * 32 + tid); dts[tid] = DT[(size_t)(base + tok) * 32 + dir * 16 + h]; }
                    __syncthreads();
                    for (int tt = 0; tt < 32; ++tt) {
                        const float dt = dts[tt], dA = __expf(dt * Ah), xr = xs[tt * 64 + p], xv = xr * dt;
                        float ys = 0.f;
#pragma unroll
                        for (int i = 0; i < 16; ++i) { const int n = nq * 16 + i; st[i] = st[i] * dA + xv * Bsm[tt * 128 + n]; ys += st[i] * Csm[tt * 128 + n]; }
                        ys += __shfl_xor(ys, 1); ys += __shfl_xor(ys, 2); ys += __shfl_xor(ys, 4);
                        if (nq == 0 && wy) { const int tok = dir == 0 ? blk * 32 + tt : len - 1 - (blk * 32 + tt); bf16* yp = Y + (size_t)(base + tok) * D + h * 64 + p;
                            if (dir == 0) *yp = (bf16)f2bf(ys + dskip * xr); else *yp = (bf16)f2bf(bf2f(*yp) + ys); }
                    }
                    __syncthreads();
                }
            }
        }
    }
}


typedef short s16x4 __attribute__((ext_vector_type(4)));
__device__ __forceinline__ bf16x8 tr_frag(const LAS unsigned char* p, int stride4) {
    const s16x4 lo = __builtin_amdgcn_ds_read_tr16_b64_v4i16((LAS s16x4*)p), hi = __builtin_amdgcn_ds_read_tr16_b64_v4i16((LAS s16x4*)(p + stride4));
    return __builtin_shufflevector(lo, hi, 0, 1, 2, 3, 4, 5, 6, 7);
}
__device__ __forceinline__ void phase_ssd_chunked(const Frame& F, int l) {
    const Args& a = *F.a;
    constexpr int SB = 272, SX = 144;
    constexpr int O_BS = 0, O_CS = 34816, O_HS = 69632, O_XS = 87040, O_XW = 105472, O_DT = 123904, O_AC = 124416, O_SC = 124928, O_TOT = 125440;
    LAS unsigned char* Ls = F.lds;
    LAS float* dtl = (LAS float*)(Ls + O_DT); LAS float* acl = (LAS float*)(Ls + O_AC); LAS float* scl = (LAS float*)(Ls + O_SC); LAS float* totl = (LAS float*)(Ls + O_TOT);
    const bf16* P = (const bf16*)(a.ws + WS_P); bf16* Y = (bf16*)(a.ws + WS_XM); const float* DT = (const float*)(a.ws + WS_DT);
    const float* cw = a.in[I_CONVW] + (size_t)l * 3 * 2048; const float* cb = a.in[I_CONVB] + (size_t)l * 2048;
    const int tid = F.tid, lane = F.lane, w = F.wave, r16 = lane & 15, q4 = lane >> 4;
    for (int task = F.bid; task < 256; task += F.G) {
        const int b = task >> 4, h = task & 15, g = h >> 2;
        const float dskip = a.in[I_DSKIP][l * 16 + h];
        const int cg = tid % 40, rg = tid / 40;
        const int gcol = cg < 8 ? PX + h * 64 + cg * 8 : (cg < 24 ? PB + g * 128 + (cg - 8) * 8 : PC + g * 128 + (cg - 24) * 8);
        const int dstoff = cg < 8 ? O_XS + cg * 16 : (cg < 24 ? O_BS + (cg - 8) * 16 : O_CS + (cg - 24) * 16), dststr = cg < 8 ? SX : SB;
        for (int dir = 0; dir < 2; ++dir) {
            f32x4 acch[4];
#pragma unroll
            for (int i = 0; i < 4; ++i) acch[i] = (f32x4){0.f, 0.f, 0.f, 0.f};
            for (int i = tid; i < 64 * SB / 16; i += 512) *(LAS v4u*)(Ls + O_HS + i * 16) = (v4u){0u, 0u, 0u, 0u};
            const float Ah = -__expf(a.in[I_ALOG][(l * 2 + dir) * 16 + h]);
            v4u rows[10]; bool have_pref = false;
            for (int step = 0; step < 18; ++step) {
                const bool isctx = step < 2;
                const int chunk = dir == 0 ? (isctx ? step : step - 2) : (isctx ? 1 - step : 17 - step);
                const int len = isctx ? CTXL : SEQ, t0 = chunk * 128, base = (isctx ? NLAT + b * CTXL : b * SEQ) + t0;
                const bool wy = !(l == 1 && isctx);
                if (tid < 320) {
                    int gc = gcol; asm volatile("" : "+v"(gc));
                    float w0[8], w1[8], w2[8], bs[8];
#pragma unroll
                    for (int i = 0; i < 8; ++i) { w0[i] = cw[gc + i]; w1[i] = cw[2048 + gc + i]; w2[i] = cw[4096 + gc + i]; bs[i] = cb[gc + i]; }
                    const int i0 = rg * 16;
                    const bf16* pp = P + (size_t)(base + i0) * PW + gc;
                    if (!have_pref) {
#pragma unroll
                        for (int ii = 0; ii < 10; ++ii) { const int t = t0 + i0 + ii - 1; rows[ii] = (t >= 0 && t < len) ? *(const v4u*)(pp + (ptrdiff_t)(ii - 1) * PW) : (v4u){0u, 0u, 0u, 0u}; }
                    }
#define CONV_ROW(p0, p1, p2, rr) do { float o[8]; \
                        o[0] = w0[0] * bflo(p0.x) + w1[0] * bflo(p1.x) + w2[0] * bflo(p2.x) + bs[0]; o[1] = w0[1] * bfhi(p0.x) + w1[1] * bfhi(p1.x) + w2[1] * bfhi(p2.x) + bs[1]; \
                        o[2] = w0[2] * bflo(p0.y) + w1[2] * bflo(p1.y) + w2[2] * bflo(p2.y) + bs[2]; o[3] = w0[3] * bfhi(p0.y) + w1[3] * bfhi(p1.y) + w2[3] * bfhi(p2.y) + bs[3]; \
                        o[4] = w0[4] * bflo(p0.z) + w1[4] * bflo(p1.z) + w2[4] * bflo(p2.z) + bs[4]; o[5] = w0[5] * bfhi(p0.z) + w1[5] * bfhi(p1.z) + w2[5] * bfhi(p2.z) + bs[5]; \
                        o[6] = w0[6] * bflo(p0.w) + w1[6] * bflo(p1.w) + w2[6] * bflo(p2.w) + bs[6]; o[7] = w0[7] * bfhi(p0.w) + w1[7] * bfhi(p1.w) + w2[7] * bfhi(p2.w) + bs[7]; \
                        v4u ov; ov.x = pk2(siluf_(o[0]), siluf_(o[1])); ov.y = pk2(siluf_(o[2]), siluf_(o[3])); ov.z = pk2(siluf_(o[4]), siluf_(o[5])); ov.w = pk2(siluf_(o[6]), siluf_(o[7])); \
                        *(LAS v4u*)(Ls + dstoff + (rr) * dststr) = ov; } while (0)
#pragma unroll
                    for (int ii = 0; ii < 8; ++ii) CONV_ROW(rows[ii], rows[ii + 1], rows[ii + 2], i0 + ii);
                    v4u rowsB[10];
#pragma unroll
                    for (int ii = 0; ii < 10; ++ii) { const int t = t0 + i0 + ii + 7; rowsB[ii] = (t >= 0 && t < len) ? *(const v4u*)(pp + (ptrdiff_t)(ii + 7) * PW) : (v4u){0u, 0u, 0u, 0u}; }
#pragma unroll
                    for (int ii = 0; ii < 8; ++ii) CONV_ROW(rowsB[ii], rowsB[ii + 1], rowsB[ii + 2], i0 + 8 + ii);
#undef CONV_ROW
                } else if (w == 7) {
                    const int t = 2 * lane;
                    const float d0 = DT[(size_t)(base + t) * 32 + dir * 16 + h], d1 = DT[(size_t)(base + t + 1) * 32 + dir * 16 + h];
                    const float a0 = d0 * Ah, a1 = d1 * Ah;
                    float incl = a0 + a1;
#pragma unroll
                    for (int o = 1; o < 64; o <<= 1) { const float v = __shfl_up(incl, o); if (lane >= o) incl += v; }
                    const float tot = __shfl(incl, 63), excl = incl - (a0 + a1);
                    float c0, c1;
                    if (dir == 0) { c0 = excl + a0; c1 = incl; } else { c0 = tot - excl; c1 = tot - excl - a0; }
                    dtl[t] = d0; dtl[t + 1] = d1; acl[t] = c0; acl[t + 1] = c1; scl[t] = d0 * __expf(tot - c0); scl[t + 1] = d1 * __expf(tot - c1);
                    if (lane == 0) totl[0] = tot;
                }
                __syncthreads();
                { const int j = tid >> 2, c0 = (tid & 3) * 16; const float sc = scl[j];
                    const v4u x0 = *(const LAS v4u*)(Ls + O_XS + j * SX + c0 * 2), x1 = *(const LAS v4u*)(Ls + O_XS + j * SX + c0 * 2 + 16); v4u y0, y1;
                    y0.x = pk2(bflo(x0.x) * sc, bfhi(x0.x) * sc); y0.y = pk2(bflo(x0.y) * sc, bfhi(x0.y) * sc); y0.z = pk2(bflo(x0.z) * sc, bfhi(x0.z) * sc); y0.w = pk2(bflo(x0.w) * sc, bfhi(x0.w) * sc);
                    y1.x = pk2(bflo(x1.x) * sc, bfhi(x1.x) * sc); y1.y = pk2(bflo(x1.y) * sc, bfhi(x1.y) * sc); y1.z = pk2(bflo(x1.z) * sc, bfhi(x1.z) * sc); y1.w = pk2(bflo(x1.w) * sc, bfhi(x1.w) * sc);
                    *(LAS v4u*)(Ls + O_XW + j * SX + c0 * 2) = y0; *(LAS v4u*)(Ls + O_XW + j * SX + c0 * 2 + 16) = y1; }
                float yold[4][4];
#pragma unroll
                for (int pt = 0; pt < 4; ++pt)
#pragma unroll
                    for (int rg4 = 0; rg4 < 4; ++rg4) yold[pt][rg4] = (wy && dir == 1) ? bf2f(Y[(size_t)(base + 16 * w + 4 * q4 + rg4) * D + h * 64 + 16 * pt + r16]) : 0.f;
                if (wy) {
                    bf16x8 cf[4];
#pragma unroll
                    for (int ks = 0; ks < 4; ++ks) cf[ks] = *(const LAS bf16x8*)(Ls + O_CS + (16 * w + r16) * SB + (32 * ks + 8 * q4) * 2);
                    f32x4 aoff[4];
#pragma unroll
                    for (int pt = 0; pt < 4; ++pt) { aoff[pt] = (f32x4){0.f, 0.f, 0.f, 0.f};
#pragma unroll
                        for (int ks = 0; ks < 4; ++ks) aoff[pt] = __builtin_amdgcn_mfma_f32_16x16x32_bf16(cf[ks], *(const LAS bf16x8*)(Ls + O_HS + (16 * pt + r16) * SB + (32 * ks + 8 * q4) * 2), aoff[pt], 0, 0, 0); }
                    float aci[4];
#pragma unroll
                    for (int rg4 = 0; rg4 < 4; ++rg4) aci[rg4] = acl[16 * w + 4 * q4 + rg4];
#pragma unroll
                    for (int jt = 0; jt < 8; ++jt) {
                        const bool live = dir == 0 ? (jt <= w) : (jt >= w);
                        f32x4 cbv = (f32x4){0.f, 0.f, 0.f, 0.f};
                        if (live) {
#pragma unroll
                            for (int ks = 0; ks < 4; ++ks) cbv = __builtin_amdgcn_mfma_f32_16x16x32_bf16(cf[ks], *(const LAS bf16x8*)(Ls + O_BS + (16 * jt + r16) * SB + (32 * ks + 8 * q4) * 2), cbv, 0, 0, 0);
                            const int j = 16 * jt + r16; const float acj = acl[j], dtj = dtl[j];
#pragma unroll
                            for (int rg4 = 0; rg4 < 4; ++rg4) { const int i = 16 * w + 4 * q4 + rg4; const bool ok = dir == 0 ? (j <= i) : (j >= i);
                                cbv[rg4] = ok ? cbv[rg4] * __expf(fminf(aci[rg4] - acj, 0.f)) * dtj : 0.f; }
                        }
#pragma unroll
                        for (int rg4 = 0; rg4 < 4; ++rg4) *(LAS bf16*)(Ls + O_CS + (16 * w + 4 * q4 + rg4) * SB + (16 * jt + r16) * 2) = (bf16)f2bf(cbv[rg4]);
                    }
                    f32x4 ad[4];
#pragma unroll
                    for (int pt = 0; pt < 4; ++pt) { ad[pt] = (f32x4){0.f, 0.f, 0.f, 0.f};
#pragma unroll
                        for (int ks = 0; ks < 4; ++ks) ad[pt] = __builtin_amdgcn_mfma_f32_16x16x32_bf16(*(const LAS bf16x8*)(Ls + O_CS + (16 * w + r16) * SB + (32 * ks + 8 * q4) * 2),
                            tr_frag(Ls + O_XS + (32 * ks + 8 * q4 + (r16 >> 2)) * SX + (16 * pt + 4 * (r16 & 3)) * 2, 4 * SX), ad[pt], 0, 0, 0); }
#pragma unroll
                    for (int pt = 0; pt < 4; ++pt)
#pragma unroll
                        for (int rg4 = 0; rg4 < 4; ++rg4) { const int i = 16 * w + 4 * q4 + rg4, p = 16 * pt + r16;
                            float v = ad[pt][rg4] + __expf(aci[rg4]) * aoff[pt][rg4];
                            bf16* yp = Y + (size_t)(base + i) * D + h * 64 + p;
                            if (dir == 0) v += dskip * bf2f(*(const LAS bf16*)(Ls + O_XS + i * SX + p * 2)); else v += yold[pt][rg4];
                            *yp = (bf16)f2bf(v); }
                }
                have_pref = false;
                if (step < 17 && tid < 320) {
                    const int ns = step + 1; const bool nctx = ns < 2;
                    const int nchunk = dir == 0 ? (nctx ? ns : ns - 2) : (nctx ? 1 - ns : 17 - ns);
                    const int nlen = nctx ? CTXL : SEQ, nt0 = nchunk * 128, nbase = (nctx ? NLAT + b * CTXL : b * SEQ) + nt0, i0 = rg * 16;
                    const bf16* pp = P + (size_t)(nbase + i0) * PW + gcol;
#pragma unroll
                    for (int ii = 0; ii < 10; ++ii) { const int t = nt0 + i0 + ii - 1; rows[ii] = (t >= 0 && t < nlen) ? *(const v4u*)(pp + (ptrdiff_t)(ii - 1) * PW) : (v4u){0u, 0u, 0u, 0u}; }
                    have_pref = true;
                }
                __syncthreads();
                {
                    const float dec = __expf(totl[0]);
                    bf16x8 bfr[4];
#pragma unroll
                    for (int ks = 0; ks < 4; ++ks) bfr[ks] = tr_frag(Ls + O_BS + (32 * ks + 8 * q4 + (r16 >> 2)) * SB + (16 * w + 4 * (r16 & 3)) * 2, 4 * SB);
#pragma unroll
                    for (int pt = 0; pt < 4; ++pt) { acch[pt] *= dec;
#pragma unroll
                        for (int ks = 0; ks < 4; ++ks) acch[pt] = __builtin_amdgcn_mfma_f32_16x16x32_bf16(tr_frag(Ls + O_XW + (32 * ks + 8 * q4 + (r16 >> 2)) * SX + (16 * pt + 4 * (r16 & 3)) * 2, 4 * SX), bfr[ks], acch[pt], 0, 0, 0);
#pragma unroll
                        for (int rg4 = 0; rg4 < 4; ++rg4) *(LAS bf16*)(Ls + O_HS + (16 * pt + 4 * q4 + rg4) * SB + (16 * w + r16) * 2) = (bf16)f2bf(acch[pt][rg4]); }
                }
                __syncthreads();
            }
        }
    }
}


__device__ __forceinline__ void phase_vstats(const Frame& F, int l) {
    const Args& a = *F.a;
    const int gw = F.bid * F.nw + F.wave, NGW = F.G * F.nw, nrows = l == 0 ? NROW : NLAT;
    for (int r = gw; r < nrows; r += NGW) {
        const bf16* vp = (const bf16*)(a.ws + WS_P) + (size_t)r * PW + PV + F.lane * 8;
        const v4u w0 = *(const v4u*)vp, w1 = *(const v4u*)(vp + 512);
        float v[16] = {bflo(w0.x), bfhi(w0.x), bflo(w0.y), bfhi(w0.y), bflo(w0.z), bfhi(w0.z), bflo(w0.w), bfhi(w0.w), bflo(w1.x), bfhi(w1.x), bflo(w1.y), bfhi(w1.y), bflo(w1.z), bfhi(w1.z), bflo(w1.w), bfhi(w1.w)};
        float sm = 0.f;
#pragma unroll
        for (int i = 0; i < 16; ++i) sm += v[i];
        const float m = wave_sum(sm) * (1.f / D); float s2 = 0.f;
#pragma unroll
        for (int i = 0; i < 16; ++i) { const float d = v[i] - m; s2 += d * d; }
        const float var = wave_sum(s2) * (1.f / D);
        if (F.lane == 0) *(f32x2*)((float*)(a.ws + WS_VSTAT) + (size_t)r * 2) = (f32x2){m, rsqrtf(var + EPS)};
    }
}

__device__ __forceinline__ void phase_sgu_mfma(const Frame& F, int l) {
    const Args& a = *F.a;
    constexpr int SV = 272, SO = 528;
    constexpr int O_VN = 0, O_OUT = 34816;
    LAS unsigned char* Ls = F.lds;
    bf16* P = (bf16*)(a.ws + WS_P);
    const int ntask = (l == 0 ? 288 : 256) * 8, tid = F.tid, lane = F.lane, w = F.wave, r16 = lane & 15, q4 = lane >> 4;
    for (int task = F.bid; task < ntask; task += F.G) {
        const int chunk = task >> 3, g = task & 7;
        const int row0 = chunk < 256 ? chunk * 128 : NLAT + (chunk - 256) * 128;
        const float* lnw = a.in[I_LNW] + l * D + g * 128; const float* lnb = a.in[I_LNB] + l * D + g * 128;
#pragma unroll
        for (int q = 0; q < 4; ++q) { const int piece = tid + 512 * q, j = piece >> 4, d8 = (piece & 15) * 8;
            const v4u vv = *(const v4u*)(P + (size_t)(row0 + j) * PW + PV + g * 128 + d8);
            const f32x2 st = *(const f32x2*)((const float*)(a.ws + WS_VSTAT) + (size_t)(row0 + j) * 2);
            const f32x4 w0 = *(const f32x4*)(lnw + d8), w1 = *(const f32x4*)(lnw + d8 + 4), b0 = *(const f32x4*)(lnb + d8), b1 = *(const f32x4*)(lnb + d8 + 4);
            v4u o; o.x = pk2((bflo(vv.x) - st.x) * st.y * w0.x + b0.x, (bfhi(vv.x) - st.x) * st.y * w0.y + b0.y); o.y = pk2((bflo(vv.y) - st.x) * st.y * w0.z + b0.z, (bfhi(vv.y) - st.x) * st.y * w0.w + b0.w);
            o.z = pk2((bflo(vv.z) - st.x) * st.y * w1.x + b1.x, (bfhi(vv.z) - st.x) * st.y * w1.y + b1.y); o.w = pk2((bflo(vv.w) - st.x) * st.y * w1.z + b1.z, (bfhi(vv.w) - st.x) * st.y * w1.w + b1.w);
            *(LAS v4u*)(Ls + O_VN + j * SV + d8 * 2) = o; }
        bf16x8 af[4];
        const bf16* wsg = (const bf16*)(a.ws + WS_WST) + ((size_t)(l * 8 + g) * 128 + 16 * w + r16) * 128 + 8 * q4;
#pragma unroll
        for (int ks = 0; ks < 4; ++ks) af[ks] = *(const bf16x8*)(wsg + 32 * ks);
        float bi[4];
#pragma unroll
        for (int rg4 = 0; rg4 < 4; ++rg4) bi[rg4] = a.in[I_BS][(l * 8 + g) * 128 + 16 * w + 4 * q4 + rg4];
        __syncthreads();
#pragma unroll
        for (int dt = 0; dt < 8; ++dt) { f32x4 acc = (f32x4){0.f, 0.f, 0.f, 0.f};
#pragma unroll
            for (int ks = 0; ks < 4; ++ks) acc = __builtin_amdgcn_mfma_f32_16x16x32_bf16(af[ks], tr_frag(Ls + O_VN + (32 * ks + 8 * q4 + (r16 >> 2)) * SV + (16 * dt + 4 * (r16 & 3)) * 2, 4 * SV), acc, 0, 0, 0);
#pragma unroll
            for (int rg4 = 0; rg4 < 4; ++rg4) *(LAS float*)(Ls + O_OUT + (16 * w + 4 * q4 + rg4) * SO + (16 * dt + r16) * 4) = acc[rg4] + bi[rg4]; }
        __syncthreads();
#pragma unroll
        for (int q = 0; q < 4; ++q) { const int piece = tid + 512 * q, i = piece >> 4, d8 = (piece & 15) * 8;
            bf16* up = P + (size_t)(row0 + i) * PW + PU + g * 128 + d8; const v4u uv = *(const v4u*)up;
            const f32x4 m0 = *(const LAS f32x4*)(Ls + O_OUT + i * SO + d8 * 4), m1 = *(const LAS f32x4*)(Ls + O_OUT + i * SO + d8 * 4 + 16);
            v4u o; o.x = pk2(bflo(uv.x) * m0.x, bfhi(uv.x) * m0.y); o.y = pk2(bflo(uv.y) * m0.z, bfhi(uv.y) * m0.w); o.z = pk2(bflo(uv.z) * m1.x, bfhi(uv.z) * m1.y); o.w = pk2(bflo(uv.w) * m1.z, bfhi(uv.w) * m1.w);
            *(v4u*)up = o; }
        __syncthreads();
    }
}

__device__ __forceinline__ void phase_sgu_simple(const Frame& F, int l) {
    const Args& a = *F.a;
    LAS float* Vn = (LAS float*)F.lds; LAS float* mu = Vn + 128 * 128; LAS float* rs = mu + 128;
    bf16* P = (bf16*)(a.ws + WS_P);
    const int ntask = (l == 0 ? 288 : 256) * 8, tid = F.tid, lane = F.lane, wave = F.wave;
    for (int task = F.bid; task < ntask; task += F.G) {
        const int chunk = task >> 3, g = task & 7;
        const int row0 = chunk < 256 ? chunk * 128 : NLAT + (chunk - 256) * 128;
        for (int rr = 0; rr < 16; ++rr) { const int j = wave * 16 + rr; const bf16* vp = P + (size_t)(row0 + j) * PW + PV;
            float v[16]; float sm = 0.f;
#pragma unroll
            for (int q = 0; q < 2; ++q) { const v4u w = *(const v4u*)(vp + lane * 8 + 512 * q); v[q * 8 + 0] = bflo(w.x); v[q * 8 + 1] = bfhi(w.x); v[q * 8 + 2] = bflo(w.y); v[q * 8 + 3] = bfhi(w.y); v[q * 8 + 4] = bflo(w.z); v[q * 8 + 5] = bfhi(w.z); v[q * 8 + 6] = bflo(w.w); v[q * 8 + 7] = bfhi(w.w); }
#pragma unroll
            for (int i = 0; i < 16; ++i) sm += v[i];
            const float m = wave_sum(sm) * (1.f / D); float s2 = 0.f;
#pragma unroll
            for (int i = 0; i < 16; ++i) { const float d = v[i] - m; s2 += d * d; }
            const float var = wave_sum(s2) * (1.f / D);
            if (lane == 0) { mu[j] = m; rs[j] = rsqrtf(var + EPS); } }
        __syncthreads();
        const float* lnw = a.in[I_LNW] + l * D + g * 128; const float* lnb = a.in[I_LNB] + l * D + g * 128;
        for (int idx = tid; idx < 128 * 128; idx += 512) { const int j = idx >> 7, d = idx & 127; Vn[idx] = (bf2f(P[(size_t)(row0 + j) * PW + PV + g * 128 + d]) - mu[j]) * rs[j] * lnw[d] + lnb[d]; }
        __syncthreads();
        const float* Wsg = a.in[I_WS] + ((size_t)(l * 8 + g) * 128) * 128; const float* bsg = a.in[I_BS] + (l * 8 + g) * 128;
        for (int idx = tid; idx < 128 * 128; idx += 512) { const int i = idx >> 7, d = idx & 127; float sm = 0.f;
#pragma unroll 8
            for (int j = 0; j < 128; ++j) sm += Wsg[i * 128 + j] * Vn[j * 128 + d];
            bf16* up = P + (size_t)(row0 + i) * PW + PU + g * 128 + d; *up = (bf16)f2bf(bf2f(*up) * (sm + bsg[i])); }
        __syncthreads();
    }
}

#define XB_TMO      128
#define XB_XCNT(j)  (256  + 64 * (j))
#define XB_XSUB(j)  (1280 + 64 * (j))
#define XB_XGEN(j)  (2304 + 64 * (j))
#define XB_TOP      3328
#define XB_TOPGEN   3392
#define XCD_BAR_WORDS 3456
#define XB_SPIN_CAP (1u << 22)
__device__ __forceinline__ unsigned xb_ld(unsigned* p)              { return __hip_atomic_load(p, __ATOMIC_RELAXED, __HIP_MEMORY_SCOPE_AGENT); }
__device__ __forceinline__ unsigned xb_add(unsigned* p, unsigned v) { return __hip_atomic_fetch_add(p, v, __ATOMIC_RELAXED, __HIP_MEMORY_SCOPE_AGENT); }
__device__ __forceinline__ unsigned xb_xcc_id() { return (unsigned)__builtin_amdgcn_s_getreg((3 << 11) | 20) & 0xFu; }
#define XB_SPIN(cond, bar) do { unsigned _sp = 0; while (cond) { __builtin_amdgcn_s_sleep(1); \
    if ((++_sp & 255u) == 0u) { if (xb_ld(&(bar)[XB_TMO])) break; if (_sp > XB_SPIN_CAP) { atomicAdd(&(bar)[XB_TMO], 1u); break; } } } } while (0)
struct XcdBarrier { unsigned* bar; unsigned x; volatile LAS unsigned* st; };
__device__ __forceinline__ XcdBarrier xcd_barrier_post(unsigned* bar, volatile LAS unsigned* st) {
    XcdBarrier b; b.bar = bar; b.x = xb_xcc_id(); b.st = st;
    if (threadIdx.x == 0) (void)xb_add(&bar[XB_XCNT(b.x)], 1u);
    return b;
}
__device__ __forceinline__ void xcd_barrier_complete(unsigned* bar, unsigned x, unsigned& nloc, unsigned& nx) {
    const unsigned G = gridDim.x * gridDim.y * gridDim.z;
    unsigned sum, cnt, mine, sp = 0u;
    for (;;) {
        sum = 0u; cnt = 0u; mine = 0u;
#pragma unroll
        for (unsigned j = 0; j < 16; ++j) { const unsigned c = xb_ld(&bar[XB_XCNT(j)]); sum += c; cnt += (c > 0u) ? 1u : 0u; mine = (j == x) ? c : mine; }
        if (sum == G) break;
        __builtin_amdgcn_s_sleep(1);
        if ((++sp & 255u) == 0u) { if (xb_ld(&bar[XB_TMO])) break; if (sp > XB_SPIN_CAP) { atomicAdd(&bar[XB_TMO], 1u); break; } }
    }
    nloc = mine > 0u ? mine : 1u; nx = cnt > 0u ? cnt : 1u;
}
__device__ __forceinline__ void xcd_barrier(const XcdBarrier& b) {
    asm volatile("s_waitcnt vmcnt(0)" ::: "memory");
    __syncthreads();
    if (threadIdx.x == 0) {
        unsigned* bar = b.bar;
        __builtin_amdgcn_s_waitcnt(0);
        unsigned nloc = b.st[0], nx = b.st[1];
        if (nloc == 0u) { xcd_barrier_complete(bar, b.x, nloc, nx); b.st[0] = nloc; b.st[1] = nx; }
        const unsigned old = xb_add(&bar[XB_XSUB(b.x)], 1u);
        const unsigned gen = old / nloc;
        if (old + 1u == (gen + 1u) * nloc) {
            __builtin_amdgcn_fence(__ATOMIC_RELEASE, "agent");
            asm volatile("s_waitcnt vmcnt(0)" ::: "memory");
            const unsigned og = xb_add(&bar[XB_TOP], 1u);
            const unsigned tg = og / nx;
            if (og + 1u == (tg + 1u) * nx) xb_add(&bar[XB_TOPGEN], 1u);
            else XB_SPIN(xb_ld(&bar[XB_TOPGEN]) == tg, bar);
            __builtin_amdgcn_fence(__ATOMIC_ACQUIRE, "agent");
            xb_add(&bar[XB_XGEN(b.x)], 1u);
            asm volatile("s_waitcnt vmcnt(0)" ::: "memory");
        } else {
            XB_SPIN(xb_ld(&bar[XB_XGEN(b.x)]) == gen, bar);
            __builtin_amdgcn_fence(__ATOMIC_ACQUIRE, "agent");
            asm volatile("s_waitcnt vmcnt(0)" ::: "memory");
        }
    }
    __syncthreads();
}

constexpr int LDS_BYTES = 147456, LDS_MISC = 139264;
constexpr int CW_BAR = 4096;
constexpr int NPHASE = 22;
__global__ void __launch_bounds__(512, 2) mk_fwd(Args args) {
    extern __shared__ __attribute__((aligned(16))) unsigned char lds[];
    Frame F; F.lds = (LAS unsigned char*)lds; F.tid = threadIdx.x; F.lane = F.tid & 63; F.wave = __builtin_amdgcn_readfirstlane(F.tid >> 6); F.nw = 8; F.G = gridDim.x; F.bid = blockIdx.x; F.a = &args;
    const int lo = args.ph_lo, hi = args.ph_hi;
    volatile LAS unsigned* MISC = (volatile LAS unsigned*)(F.lds + LDS_MISC);
    if (F.tid < 64) MISC[F.tid] = 0u;
    __syncthreads();
    XcdBarrier bar; bar.bar = (unsigned*)(args.ws + WS_CTL) + CW_BAR; bar.x = 0; bar.st = MISC + 8;
    if (hi - lo > 1) bar = xcd_barrier_post((unsigned*)(args.ws + WS_CTL) + CW_BAR, MISC + 8);
#define IN(k) (lo <= (k) && (k) < hi)
#define SEAM(k) do { if (IN(k) && IN((k) + 1)) { XcdBarrier b2_ = bar; asm volatile("" : "+s"(b2_.bar)); xcd_barrier(b2_); } } while (0)
#define REP(k) for (int rep_ = 0; rep_ < ((k) == REPEAT_PH ? 2 : 1); ++rep_)
#define FRESH(Fp) Frame Fp = F; { int t_ = threadIdx.x; asm volatile("" : "+v"(t_)); Fp.tid = t_; Fp.lane = t_ & 63; Fp.wave = __builtin_amdgcn_readfirstlane(t_ >> 6); }
    if (IN(0)) REP(0) { FRESH(Fp); phase_prologue(Fp); __syncthreads(); } SEAM(0);
#pragma unroll 1
    for (int l = 0; l < 2; ++l) {
        const int base = 1 + 10 * l;
        if (IN(base + 0)) { FRESH(Fp); phase_norm1(Fp, l); } SEAM(base + 0);
        if (IN(base + 1)) REP(base + 1) { ProbIn p{&args, l}; pg8::gemm_phase(F.lds, p, F.G, F.bid); } SEAM(base + 1);
        if (IN(base + 2)) REP(base + 2) { FRESH(Fp); if (USE_SSD_SEQ) phase_ssd_seq(Fp, l); else phase_ssd_chunked(Fp, l); __syncthreads(); phase_vstats(Fp, l); } SEAM(base + 2);
        if (IN(base + 3)) { { FRESH(Fp); phase_ssdin(Fp, l); } { FRESH(Fp); phase_sgu_mfma(Fp, l); } } SEAM(base + 3);
        if (IN(base + 4)) { { ProbMix<0> p{&args, l}; pg8::gemm_phase(F.lds, p, F.G, F.bid); } { ProbMix<1> p{&args, l}; pg8::gemm_phase(F.lds, p, F.G, F.bid); } } SEAM(base + 4);
        if (IN(base + 5)) { ProbMix<2> p{&args, l}; pg8::gemm_phase(F.lds, p, F.G, F.bid); } SEAM(base + 5);
        if (IN(base + 6)) REP(base + 6) { FRESH(Fp); phase_norm2(Fp, l); } SEAM(base + 6);
        if (IN(base + 7)) REP(base + 7) { FRESH(Fp); phase_topk(Fp, l); } SEAM(base + 7);
        if (IN(base + 8)) REP(base + 8) { ProbMoe<0> p{&args, l}; pg8::gemm_phase(F.lds, p, F.G, F.bid); } SEAM(base + 8);
        if (IN(base + 9)) REP(base + 9) { ProbMoe<1> p{&args, l}; pg8::gemm_phase(F.lds, p, F.G, F.bid); } SEAM(base + 9);
    }
    if (IN(21)) { FRESH(Fp); phase_final(Fp); }
#undef IN
#undef SEAM
#undef FRESH
#undef REP
}

#ifndef USE_SSD_SEQ
#define USE_SSD_SEQ 0
#endif
#ifndef MK_ONE_LAUNCH
#define MK_ONE_LAUNCH 1
#endif
#ifndef STOP_AT
#define STOP_AT 99
#endif
__global__ void k_dump(float* o, size_t base, const unsigned char* src, int mode, size_t n) { for (size_t i = (size_t)blockIdx.x * blockDim.x + threadIdx.x; i < n; i += (size_t)gridDim.x * blockDim.x) {
    float v = mode == 0 ? bf2f(((const bf16*)src)[i]) : (mode == 1 ? ((const float*)src)[i] : (float)((const int*)src)[i]); o[base + i] = v; } }
#ifndef DUMP_SET
#define DUMP_SET 0
#endif
__global__ void k_fill(float* o, size_t n) { for (size_t i = (size_t)blockIdx.x * blockDim.x + threadIdx.x; i < n; i += (size_t)gridDim.x * blockDim.x) o[i] = 0.f; }
extern "C" void kernel_launch(void* const* d_in, const int* in_sizes, int n_in, void* d_out, int out_size, void* d_ws, size_t ws_size, hipStream_t stream) {
    static int grid = 0;
    if (grid == 0) {
        if (n_in != 27 || out_size != NLAT * D || ws_size < WS_END) { fprintf(stderr, "kernel_launch: unexpected shapes (n_in %d, out %d, ws %zu < %zu)\n", n_in, out_size, ws_size, (size_t)WS_END); grid = -1; return; }
        int dev = 0, cus = 0;
        if (hipGetDevice(&dev) != hipSuccess || hipDeviceGetAttribute(&cus, hipDeviceAttributeMultiprocessorCount, dev) != hipSuccess) { grid = -1; return; }
        if (hipFuncSetAttribute((const void*)mk_fwd, hipFuncAttributeMaxDynamicSharedMemorySize, LDS_BYTES) != hipSuccess) { grid = -1; return; }
        if (hipFuncSetAttribute((const void*)k_sgu_naive, hipFuncAttributeMaxDynamicSharedMemorySize, 128 * 128 * 4 + 1024) != hipSuccess) { grid = -1; return; }
        (void)hipGetLastError();
        grid = cus;
    }
    if (grid < 0) return;
    (void)hipMemsetAsync((char*)d_ws + WS_CTL, 0, CTL_ZERO_BYTES, stream);
    Args a{};
    for (int i = 0; i < 27; ++i) a.in[i] = (const float*)d_in[i];
    a.out = (float*)d_out; a.ws = (unsigned char*)d_ws;
    auto run = [&](int lo, int hi) { a.ph_lo = lo; a.ph_hi = hi; hipLaunchKernelGGL(mk_fwd, dim3(grid), dim3(512), LDS_BYTES, stream, a); };
#if MK_ONE_LAUNCH
    run(0, NPHASE);
#else
    for (int ph = 0; ph < NPHASE; ++ph) run(ph, ph + 1);
#endif
}
```

```cpp
#include <hip/hip_runtime.h>
#include <cstdio>
#include <cstdint>

#ifndef USE_SSD_SEQ
#define USE_SSD_SEQ 0
#endif
#ifndef REPEAT_PH
#define REPEAT_PH -1
#endif
#define GAS __attribute__((address_space(1)))
#define LAS __attribute__((address_space(3)))
typedef unsigned short bf16;
typedef unsigned v4u __attribute__((ext_vector_type(4)));
typedef unsigned v2u __attribute__((ext_vector_type(2)));
typedef float f32x4 __attribute__((ext_vector_type(4)));
typedef float f32x2 __attribute__((ext_vector_type(2)));
typedef short bf16x8 __attribute__((ext_vector_type(8)));

constexpr int D = 1024, NB = 16, SEQ = 2048, CTXL = 256, NLAT = NB * SEQ, NCTX = NB * CTXL, NROW = NLAT + NCTX;
constexpr int HEADS = 16, HD = 64, NST = 128, NIN = 7200;
constexpr int NEXP = 16, CAP_L = 256, CAP_C = 32;
constexpr float EPS = 1e-6f;
constexpr int PW = 7168, PX = 0, PB = 1024, PC = 1536, PZ = 2048, PU = 3072, PV = 4096, PGA = 5120, PGB = 6144;
constexpr int WIN_ROWS = 7424;
constexpr int NLIST = NB * NEXP * CAP_L + NEXP * NB * CAP_C;
constexpr int LIST_C0 = NB * NEXP * CAP_L;

constexpr size_t MiB = 1u << 20;
constexpr size_t WS_CTL = 0, CTL_ZERO_BYTES = 1 * MiB;
constexpr size_t WS_MOD = 1 * MiB;
constexpr size_t WS_WST = 2 * MiB;
constexpr size_t WS_VSTAT = 2 * MiB + 512 * 1024;
constexpr size_t WS_DT = 3 * MiB;
constexpr size_t WS_AFF = 8 * MiB;
constexpr size_t WS_INV = 11 * MiB;
constexpr size_t WS_IDX = 14 * MiB;
constexpr size_t WS_GATE = 14 * MiB + 512 * 1024;
constexpr size_t WS_WIN = 16 * MiB;
constexpr size_t WS_WMIX = 45 * MiB;
constexpr size_t WS_HC = 57 * MiB;
constexpr size_t WS_XM = 73 * MiB;
constexpr size_t WS_P = 145 * MiB;
constexpr size_t WS_END = 649 * MiB;
constexpr size_t PO_WGU = 0, PO_WD = 64 * MiB, PO_HID = 96 * MiB, PO_YM = 240 * MiB;

typedef __bf16 bf16x2_t __attribute__((ext_vector_type(2)));
__device__ __forceinline__ unsigned pk2(float lo, float hi) { const f32x2 v = {lo, hi}; return __builtin_bit_cast(unsigned, __builtin_convertvector(v, bf16x2_t)); }
__device__ __forceinline__ unsigned f2bf(float f) { return pk2(f, 0.f) & 0xffffu; }
__device__ __forceinline__ float bflo(unsigned w) { return __builtin_bit_cast(float, w << 16); }
__device__ __forceinline__ float bfhi(unsigned w) { return __builtin_bit_cast(float, w & 0xffff0000u); }
__device__ __forceinline__ float bf2f(bf16 b) { return __builtin_bit_cast(float, ((unsigned)b) << 16); }
__device__ __forceinline__ float rcpf_(float x) { return __builtin_amdgcn_rcpf(x); }
__device__ __forceinline__ float sigmoidf_(float x) { return rcpf_(1.0f + __expf(-x)); }
__device__ __forceinline__ float siluf_(float x) { return x * rcpf_(1.0f + __expf(-x)); }
__device__ __forceinline__ float gelu_tanh(float x) { const float u = 1.5957691216057308f * (x + 0.044715f * x * x * x); return x * rcpf_(1.0f + __expf(-u)); }
__device__ __forceinline__ float softplusf_(float x) { return fmaxf(x, 0.f) + log1pf(__expf(-fabsf(x))); }
__device__ __forceinline__ float wave_sum(float v) {
#pragma unroll
    for (int o = 1; o < 64; o <<= 1) v += __shfl_xor(v, o);
    return v;
}
__device__ __forceinline__ v2u pack4(f32x4 v) { v2u r; r.x = pk2(v.x, v.y); r.y = pk2(v.z, v.w); return r; }
__device__ __forceinline__ f32x4 unpack4(v2u w) { return (f32x4){bflo(w.x), bfhi(w.x), bflo(w.y), bfhi(w.y)}; }

struct Args { const float* in[27]; float* out; unsigned char* ws; int ph_lo, ph_hi; };
enum { I_X = 0, I_C, I_CTX, I_CCTX, I_ADAW, I_ADAB, I_N1W, I_N2W, I_WIN, I_CONVW, I_CONVB, I_DTB, I_ALOG, I_DSKIP, I_SSDNW, I_LNW, I_LNB, I_WS, I_BS, I_WPA, I_WPB, I_WO, I_RW, I_WG, I_WU, I_WD, I_FNW };

struct Frame {
    LAS unsigned char* lds; int tid, lane, wave, nw, G, bid;
    const Args* a;
};
__device__ __forceinline__ const float* modp(const Args& a, int l, int br) { return (const float*)(a.ws + WS_MOD) + (size_t)(l * 17 + br) * 6144; }
__device__ __forceinline__ int batch_row(int r) { return r < NLAT ? (r >> 11) : 16; }

struct Unit { const bf16* A; const bf16* B; const int* gidx; int lda, a_row0, pm, pn, aux; };

struct ProbIn {      static constexpr bool GATHER = false, NOSCHED = true;
    const Args* a; int l; int noepi = 0;
    __device__ int nunits() const { return l == 0 ? 144 * 29 : 128 * 29 + 16 * 9; }
    __device__ void unit(int L, Unit& u) const {
        int pm, pn;
        const int nfull = (l == 0 ? 144 : 128), nun = nunits();
        const int wg = (L & 7) * (nun >> 3) + (L >> 3);
        if (wg < nfull * 29) { const int grp = wg / (8 * 29), w = wg % (8 * 29); pm = grp * 8 + (w & 7); pn = w >> 3; }
        else { const int w = wg - nfull * 29, g2 = w / 72, w2 = w % 72; pm = 128 + g2 * 8 + (w2 & 7); const int q = w2 >> 3; pn = q < 8 ? q : 28; }
        u.A = (const bf16*)(a->ws + WS_XM); u.lda = D; u.a_row0 = pm * 256; u.gidx = nullptr; u.pm = pm; u.pn = pn; u.aux = 0;
        u.B = (const bf16*)(a->ws + WS_WIN) + ((size_t)l * WIN_ROWS + (size_t)pn * 256) * D;
    }
    struct Pre { int dummy; };
    __device__ __forceinline__ Pre pre(const Unit&, int, int) const { return Pre{0}; }
    __device__ __forceinline__ void epi(const Unit& u, int r, int c, f32x4 lo0, f32x4 lo1, f32x4 hi0, f32x4 hi1, const Pre&) const {
        if (noepi) return;
        const int row = u.pm * 256 + r, pn = u.pn;
        if (pn == 28) {
            if (c < 32) { float* dt = (float*)(a->ws + WS_DT) + (size_t)row * 32 + c; const float* db = a->in[I_DTB] + l * 32 + c;
                f32x4 o0, o1;
#pragma unroll
                for (int i = 0; i < 4; ++i) { o0[i] = softplusf_(lo0[i] + db[i]); o1[i] = softplusf_(lo1[i] + db[4 + i]); }
                *(f32x4*)dt = o0; *(f32x4*)(dt + 4) = o1; }
            return;
        }
        if (pn >= 8 && pn < 12) {
#pragma unroll
            for (int i = 0; i < 4; ++i) { lo0[i] = siluf_(lo0[i]); lo1[i] = siluf_(lo1[i]); hi0[i] = siluf_(hi0[i]); hi1[i] = siluf_(hi1[i]); } }
        else if (pn >= 12 && pn < 20) {
#pragma unroll
            for (int i = 0; i < 4; ++i) { lo0[i] = gelu_tanh(lo0[i]); lo1[i] = gelu_tanh(lo1[i]); hi0[i] = gelu_tanh(hi0[i]); hi1[i] = gelu_tanh(hi1[i]); } }
        else if (pn >= 20) {
#pragma unroll
            for (int i = 0; i < 4; ++i) { lo0[i] = sigmoidf_(lo0[i]); lo1[i] = sigmoidf_(lo1[i]); hi0[i] = sigmoidf_(hi0[i]); hi1[i] = sigmoidf_(hi1[i]); } }
        bf16* o = (bf16*)(a->ws + WS_P) + (size_t)row * PW + pn * 256 + c;
        v4u w; w.x = pk2(lo0[0], lo0[1]); w.y = pk2(lo0[2], lo0[3]); w.z = pk2(lo1[0], lo1[1]); w.w = pk2(lo1[2], lo1[3]); *(v4u*)o = w;
        w.x = pk2(hi0[0], hi0[1]); w.y = pk2(hi0[2], hi0[3]); w.z = pk2(hi1[0], hi1[1]); w.w = pk2(hi1[2], hi1[3]); *(v4u*)(o + 128) = w;
    }
};

template <int MODE> struct ProbMix {
    static constexpr bool GATHER = false, NOSCHED = false;
    const Args* a; int l;
    __device__ int nunits() const { return (l == 0 ? 144 : 128) * 4; }
    __device__ void unit(int L, Unit& u) const {
        const int wg = (L & 7) * (nunits() >> 3) + (L >> 3);
        const int grp = wg / 32, w = wg % 32; const int pm = grp * 8 + (w & 7), pn = w >> 3;
        u.pm = pm; u.pn = pn; u.aux = 0; u.gidx = nullptr; u.a_row0 = pm * 256;
        if (MODE == 0) { u.A = (const bf16*)(a->ws + WS_P) + PZ; u.lda = PW; }
        else if (MODE == 1) { u.A = (const bf16*)(a->ws + WS_P) + PU; u.lda = PW; }
        else { u.A = (const bf16*)(a->ws + WS_XM); u.lda = D; }
        u.B = (const bf16*)(a->ws + WS_WMIX) + ((size_t)(l * 3 + MODE) * D + (size_t)pn * 256) * D;
    }
    struct Pre { v4u q0, q1, q2, q3; f32x4 f0, f1, f2, f3, g0, g1, g2, g3; };
    __device__ __forceinline__ Pre pre(const Unit& u, int r, int c) const {
        const int row = u.pm * 256 + r, col = u.pn * 256 + c; Pre p;
        if (MODE == 0) { const bf16* g = (const bf16*)(a->ws + WS_P) + (size_t)row * PW + PGA + col; p.q0 = *(const v4u*)g; p.q1 = *(const v4u*)(g + 128); }
        else if (MODE == 1) { const bf16* t = (const bf16*)(a->ws + WS_P) + (size_t)row * PW + PGA + col; const bf16* g = t + (PGB - PGA);
            p.q0 = *(const v4u*)t; p.q1 = *(const v4u*)(t + 128); p.q2 = *(const v4u*)g; p.q3 = *(const v4u*)(g + 128); }
        else { const bool lat = row < NLAT;
            const float* hin = ((l == 0) ? (lat ? a->in[I_X] + (size_t)row * D : a->in[I_CTX] + (size_t)(row - NLAT) * D) : (lat ? a->out + (size_t)row * D : (const float*)(a->ws + WS_HC) + (size_t)(row - NLAT) * D)) + col;
            const float* g1 = modp(*a, l, batch_row(row)) + 2048 + col;
            p.f0 = *(const f32x4*)hin; p.f1 = *(const f32x4*)(hin + 4); p.f2 = *(const f32x4*)(hin + 128); p.f3 = *(const f32x4*)(hin + 132);
            p.g0 = *(const f32x4*)g1; p.g1 = *(const f32x4*)(g1 + 4); p.g2 = *(const f32x4*)(g1 + 128); p.g3 = *(const f32x4*)(g1 + 132); }
        return p;
    }
    __device__ __forceinline__ void epi(const Unit& u, int r, int c, f32x4 lo0, f32x4 lo1, f32x4 hi0, f32x4 hi1, const Pre& p) const {
        const int row = u.pm * 256 + r, col = u.pn * 256 + c;
        if (MODE == 0) {
            bf16* g = (bf16*)(a->ws + WS_P) + (size_t)row * PW + PGA + col;
            const v4u gl = p.q0, gh = p.q1; v4u w;
            w.x = pk2(bflo(gl.x) * lo0[0], bfhi(gl.x) * lo0[1]); w.y = pk2(bflo(gl.y) * lo0[2], bfhi(gl.y) * lo0[3]); w.z = pk2(bflo(gl.z) * lo1[0], bfhi(gl.z) * lo1[1]); w.w = pk2(bflo(gl.w) * lo1[2], bfhi(gl.w) * lo1[3]); *(v4u*)g = w;
            w.x = pk2(bflo(gh.x) * hi0[0], bfhi(gh.x) * hi0[1]); w.y = pk2(bflo(gh.y) * hi0[2], bfhi(gh.y) * hi0[3]); w.z = pk2(bflo(gh.z) * hi1[0], bfhi(gh.z) * hi1[1]); w.w = pk2(bflo(gh.w) * hi1[2], bfhi(gh.w) * hi1[3]); *(v4u*)(g + 128) = w;
        } else if (MODE == 1) {
            bf16* o = (bf16*)(a->ws + WS_XM) + (size_t)row * D + col;
            const v4u tl = p.q0, th = p.q1, gl = p.q2, gh = p.q3; v4u w;
            w.x = pk2(bflo(tl.x) + bflo(gl.x) * lo0[0], bfhi(tl.x) + bfhi(gl.x) * lo0[1]); w.y = pk2(bflo(tl.y) + bflo(gl.y) * lo0[2], bfhi(tl.y) + bfhi(gl.y) * lo0[3]);
            w.z = pk2(bflo(tl.z) + bflo(gl.z) * lo1[0], bfhi(tl.z) + bfhi(gl.z) * lo1[1]); w.w = pk2(bflo(tl.w) + bflo(gl.w) * lo1[2], bfhi(tl.w) + bfhi(gl.w) * lo1[3]); *(v4u*)o = w;
            w.x = pk2(bflo(th.x) + bflo(gh.x) * hi0[0], bfhi(th.x) + bfhi(gh.x) * hi0[1]); w.y = pk2(bflo(th.y) + bflo(gh.y) * hi0[2], bfhi(th.y) + bfhi(gh.y) * hi0[3]);
            w.z = pk2(bflo(th.z) + bflo(gh.z) * hi1[0], bfhi(th.z) + bfhi(gh.z) * hi1[1]); w.w = pk2(bflo(th.w) + bflo(gh.w) * hi1[2], bfhi(th.w) + bfhi(gh.w) * hi1[3]); *(v4u*)(o + 128) = w;
        } else {
            const bool lat = row < NLAT;
            float* hout = (lat ? a->out + (size_t)row * D : (float*)(a->ws + WS_HC) + (size_t)(row - NLAT) * D) + col;
            *(f32x4*)hout = p.f0 + p.g0 * lo0; *(f32x4*)(hout + 4) = p.f1 + p.g1 * lo1; *(f32x4*)(hout + 128) = p.f2 + p.g2 * hi0; *(f32x4*)(hout + 132) = p.f3 + p.g3 * hi1;
        }
    }
};

template <int MODE> struct ProbMoe {
    static constexpr bool GATHER = (MODE == 0), NOSCHED = false;
    const Args* a; int l;
    __device__ int nunits() const { const int per = MODE == 0 ? 8 : 4; return (256 + (l == 0 ? 32 : 0)) * per; }
    __device__ void unit(int L, Unit& u) const {
        constexpr int per = MODE == 0 ? 8 : 4;
        const int x = L & 7, off = L >> 3;
        int pn, t;
        if (off < 32 * per) { const int e = 2 * x + off / (16 * per), r = off % (16 * per); t = (r / per) * 16 + e; pn = r % per; }
        else { const int o = off - 32 * per; t = 256 + 4 * x + o / per; pn = o % per; }
        const int e = t < 256 ? (t & 15) : ((t - 256) >> 1);
        const int list0 = t < 256 ? t * 256 : LIST_C0 + (t - 256) * 256;
        u.pm = t; u.pn = pn; u.aux = list0;
        if (MODE == 0) { u.A = (const bf16*)(a->ws + WS_XM); u.lda = D; u.a_row0 = 0; u.gidx = (const int*)(a->ws + WS_IDX) + list0;
            u.B = (const bf16*)(a->ws + WS_P + PO_WGU) + ((size_t)e * 2048 + (size_t)pn * 256) * D; }
        else { u.A = (const bf16*)(a->ws + WS_P + PO_HID); u.lda = D; u.a_row0 = list0; u.gidx = nullptr;
            u.B = (const bf16*)(a->ws + WS_P + PO_WD) + ((size_t)e * 1024 + (size_t)pn * 256) * D; }
    }
    struct Pre { float gt; };
    __device__ __forceinline__ Pre pre(const Unit& u, int r, int) const { Pre p; p.gt = MODE == 1 ? ((const float*)(a->ws + WS_GATE))[(size_t)u.aux + r] : 0.f; return p; }
    __device__ __forceinline__ void epi(const Unit& u, int r, int c, f32x4 lo0, f32x4 lo1, f32x4 hi0, f32x4 hi1, const Pre& pr) const {
        const size_t hrow = (size_t)u.aux + r;
        if (MODE == 0) {
            bf16* o = (bf16*)(a->ws + WS_P + PO_HID) + hrow * D + u.pn * 128 + c;
            v4u w; w.x = pk2(siluf_(lo0[0]) * hi0[0], siluf_(lo0[1]) * hi0[1]); w.y = pk2(siluf_(lo0[2]) * hi0[2], siluf_(lo0[3]) * hi0[3]);
            w.z = pk2(siluf_(lo1[0]) * hi1[0], siluf_(lo1[1]) * hi1[1]); w.w = pk2(siluf_(lo1[2]) * hi1[2], siluf_(lo1[3]) * hi1[3]); *(v4u*)o = w;
        } else {
            const float gt = pr.gt;
            bf16* o = (bf16*)(a->ws + WS_P + PO_YM) + hrow * D + u.pn * 256 + c;
            v4u w; w.x = pk2(gt * lo0[0], gt * lo0[1]); w.y = pk2(gt * lo0[2], gt * lo0[3]); w.z = pk2(gt * lo1[0], gt * lo1[1]); w.w = pk2(gt * lo1[2], gt * lo1[3]); *(v4u*)o = w;
            w.x = pk2(gt * hi0[0], gt * hi0[1]); w.y = pk2(gt * hi0[2], gt * hi0[3]); w.z = pk2(gt * hi1[0], gt * hi1[1]); w.w = pk2(gt * hi1[2], gt * hi1[3]); *(v4u*)(o + 128) = w;
        }
    }
};


namespace pg8 {
constexpr int BM = 256, BK = 64, HALF = 128, HTB = HALF * BK * 2, STAGE_BYTES = 8 * HTB;
__device__ __forceinline__ int lds_byte(int r, int c) { const int st = (r >> 4) * 2 + (c >> 5), rr = r & 15, cc = c & 31, ob = rr * 64 + cc * 2; return st * 1024 + (ob ^ (((ob >> 9) & 1) << 5)); }
__device__ __forceinline__ void stage_rc(int b, int& R, int& C) { const int st = b / 1024, sb = b % 1024, swz = sb ^ (((sb >> 9) & 1) << 5); R = (st >> 1) * 16 + swz / 64; C = (st & 1) * 32 + (swz % 64) / 2; }
__device__ __forceinline__ int perm32(int rho) { const int n = rho >> 4, i = rho & 15; return 8 * (i >> 2) + 4 * n + (i & 3); }

template <bool GATHER> __device__ __forceinline__ void unit_voffA(const Unit& u, int tid, unsigned (&vo)[4]) {
#pragma unroll
    for (int h = 0; h < 2; ++h)
#pragma unroll
        for (int i = 0; i < 2; ++i) { int R, C; stage_rc(tid * 16 + i * 8192, R, C); const int r = h * HALF + R;
            if (GATHER) { int row = u.gidx[r]; row = (unsigned)row < (unsigned)NROW ? row : 0; vo[h * 2 + i] = ((unsigned)row * (unsigned)u.lda + (unsigned)C) * 2u; }
            else vo[h * 2 + i] = ((unsigned)r * (unsigned)u.lda + (unsigned)C) * 2u; }
}

__device__ __forceinline__ __amdgpu_buffer_rsrc_t mk_rsrc(const char* p) {
    const unsigned long long v = (unsigned long long)p;
    const unsigned lo = __builtin_amdgcn_readfirstlane((unsigned)v), hi = __builtin_amdgcn_readfirstlane((unsigned)(v >> 32));
    return __builtin_amdgcn_make_buffer_rsrc((void*)(((unsigned long long)hi << 32) | lo), 0, 0x7fffffff, 0x00020000);
}

template <class Prob>
__device__ __forceinline__ void gemm_phase(LAS unsigned char* lds, const Prob& prob, int G, int bid) {
    constexpr bool GATHER = Prob::GATHER;
    int tid_ = threadIdx.x; asm volatile("" : "+v"(tid_));
    const int tid = tid_, wid = __builtin_amdgcn_readfirstlane(tid >> 6), lane = tid & 63, wr = wid >> 2, wc = wid & 3, fr = lane & 15, fq = lane >> 4;
    constexpr int K = 1024, nt = K / BK;
    unsigned voffB[2];
#pragma unroll
    for (int i = 0; i < 2; ++i) { int R, C; stage_rc(tid * 16 + i * 8192, R, C); const int Rb = (R & ~31) + perm32(R & 31); voffB[i] = (unsigned)(Rb * K + C) * 2u; }
    constexpr int kstep = BK * 2;
    constexpr int hstep = HALF * K * 2;
    const unsigned ldsw = (unsigned)wid * 1024u;
    const int aoff = lds_byte(wr * 64 + fr, fq * 8), boff = lds_byte(wc * 32 + fr, fq * 8);
#define PG8_SA(b, h) (((b) * 2 + (h)) * HTB)
#define PG8_SB(b, h) ((4 + (b) * 2 + (h)) * HTB)
#define PG8_STAGE2(bufoff, rsrc, v0, v1, soff) do { \
        __builtin_amdgcn_raw_ptr_buffer_load_lds(rsrc, (LAS unsigned*)(lds + (bufoff) + ldsw), 16, (int)(v0), (int)(soff), 0, 0); \
        __builtin_amdgcn_raw_ptr_buffer_load_lds(rsrc, (LAS unsigned*)(lds + (bufoff) + ldsw + 8192), 16, (int)(v1), (int)(soff), 0, 0); } while (0)
#define PG8_STAGEB(bufoff, rsrc, soff) PG8_STAGE2(bufoff, rsrc, voffB[0], voffB[1], soff)
#define PG8_LDA(dst, b, h) do { _Pragma("unroll") for (int m = 0; m < 4; ++m) _Pragma("unroll") for (int k = 0; k < 2; ++k) dst[m][k] = *(const LAS bf16x8*)(lds + PG8_SA(b, h) + aoff + m * 2048 + k * 1024); } while (0)
#define PG8_LDB(dst, b, h) do { _Pragma("unroll") for (int n = 0; n < 2; ++n) _Pragma("unroll") for (int k = 0; k < 2; ++k) dst[n][k] = *(const LAS bf16x8*)(lds + PG8_SB(b, h) + boff + n * 2048 + k * 1024); } while (0)
#define PG8_MMA(ai, bj, At, Bt) do { __builtin_amdgcn_s_setprio(1); _Pragma("unroll") for (int m = 0; m < 4; ++m) _Pragma("unroll") for (int n = 0; n < 2; ++n) _Pragma("unroll") for (int k = 0; k < 2; ++k) \
        acc[ai][bj][m][n] = __builtin_amdgcn_mfma_f32_16x16x32_bf16(Bt[n][k], At[m][k], acc[ai][bj][m][n], 0, 0, 0); __builtin_amdgcn_s_setprio(0); } while (0)
#define PG8_WAIT_V(n) asm volatile("s_waitcnt vmcnt(" #n ")" ::: "memory")
#define PG8_WAIT_L(n) asm volatile("s_waitcnt lgkmcnt(" #n ")" ::: "memory")
#define PG8_BAR __builtin_amdgcn_s_barrier()
#define PG8_SCHED __builtin_amdgcn_sched_barrier(0)
    const int nun = prob.nunits();
    int L = bid;
    if (L >= nun) return;
    Unit cur, nxt; prob.unit(L, cur);
    unsigned voA[4], nvoA[4];
    unit_voffA<GATHER>(cur, tid, voA);
    const char* cA = (const char*)cur.A + (GATHER ? (size_t)0 : (size_t)cur.a_row0 * cur.lda * 2); const char* cB = (const char*)cur.B;
    {
        const __amdgpu_buffer_rsrc_t rA = mk_rsrc(cA), rB = mk_rsrc(cB);
        PG8_STAGEB(PG8_SB(0, 0), rB, 0); PG8_STAGEB(PG8_SB(0, 1), rB, hstep); PG8_STAGE2(PG8_SA(0, 0), rA, voA[0], voA[1], 0); PG8_STAGE2(PG8_SA(0, 1), rA, voA[2], voA[3], 0);
        if (wr == 1) PG8_BAR;
        PG8_WAIT_V(2); PG8_BAR;
        PG8_STAGEB(PG8_SB(1, 0), rB, kstep); PG8_STAGE2(PG8_SA(1, 0), rA, voA[0], voA[1], kstep); PG8_STAGEB(PG8_SB(1, 1), rB, hstep + kstep);
        PG8_WAIT_V(6); PG8_BAR; PG8_SCHED;
    }
    f32x4 acc[2][2][4][2];
#pragma unroll
    for (int a = 0; a < 2; ++a)
#pragma unroll
        for (int b = 0; b < 2; ++b)
#pragma unroll
            for (int m = 0; m < 4; ++m)
#pragma unroll
                for (int n = 0; n < 2; ++n) acc[a][b][m][n] = (f32x4){0.f, 0.f, 0.f, 0.f};
    bf16x8 At[4][2], B0[2][2], B1[2][2];
    for (;;) {
        const bool has_next = (L + G < nun);
        const char* nA = cA; const char* nB = cB;
#pragma unroll
        for (int i = 0; i < 4; ++i) nvoA[i] = voA[i];
        if (has_next) { prob.unit(L + G, nxt); if (GATHER) unit_voffA<GATHER>(nxt, tid, nvoA); nA = (const char*)nxt.A + (GATHER ? (size_t)0 : (size_t)nxt.a_row0 * nxt.lda * 2); nB = (const char*)nxt.B; }
        const __amdgpu_buffer_rsrc_t rA1 = mk_rsrc(cA);
        for (int t = 0; t < nt; t += 2) {
            const bool last = (t == nt - 2);
            const __amdgpu_buffer_rsrc_t rA2 = mk_rsrc(last ? nA : cA), rB2 = mk_rsrc(last ? nB : cB);
            const int o1 = (t + 1) * kstep, o2 = last ? 0 : (t + 2) * kstep, o3 = o2 + kstep;
            const unsigned s0 = (GATHER && last) ? nvoA[0] : voA[0], s1 = (GATHER && last) ? nvoA[1] : voA[1], s2 = (GATHER && last) ? nvoA[2] : voA[2], s3 = (GATHER && last) ? nvoA[3] : voA[3];
            PG8_LDB(B0, 0, 0); PG8_LDB(B1, 0, 1); PG8_SCHED; PG8_LDA(At, 0, 0); PG8_STAGE2(PG8_SA(1, 1), rA1, voA[2], voA[3], o1);
            PG8_WAIT_V(8); PG8_WAIT_L(0); PG8_BAR; PG8_MMA(0, 0, At, B0); PG8_MMA(0, 1, At, B1); PG8_BAR; PG8_SCHED;
            PG8_LDA(At, 0, 1); PG8_STAGEB(PG8_SB(0, 0), rB2, o2); PG8_STAGEB(PG8_SB(0, 1), rB2, o2 + hstep); PG8_STAGE2(PG8_SA(0, 0), rA2, s0, s1, o2);
            PG8_WAIT_V(8); PG8_WAIT_L(0); PG8_BAR; PG8_MMA(1, 0, At, B0); PG8_MMA(1, 1, At, B1); PG8_BAR; PG8_SCHED;
            PG8_LDB(B0, 1, 0); PG8_LDB(B1, 1, 1); PG8_SCHED; PG8_LDA(At, 1, 0); PG8_STAGE2(PG8_SA(0, 1), rA2, s2, s3, o2);
            PG8_WAIT_V(8); PG8_WAIT_L(0); PG8_BAR; PG8_MMA(0, 0, At, B0); PG8_MMA(0, 1, At, B1); PG8_BAR; PG8_SCHED;
            PG8_LDA(At, 1, 1); PG8_STAGEB(PG8_SB(1, 0), rB2, o3); PG8_STAGEB(PG8_SB(1, 1), rB2, o3 + hstep); PG8_STAGE2(PG8_SA(1, 0), rA2, s0, s1, o3);
            PG8_WAIT_V(8); PG8_WAIT_L(0); PG8_BAR; PG8_MMA(1, 0, At, B0); PG8_MMA(1, 1, At, B1); PG8_BAR; PG8_SCHED;
        }
        if (wr == 0) PG8_BAR;
        {
            typename Prob::Pre pcur = prob.pre(cur, wr * 64 + fr, wc * 32 + fq * 8);
#pragma unroll
            for (int q = 0; q < 8; ++q) { const int ai = q >> 2, m = q & 3, r = ai * HALF + wr * 64 + m * 16 + fr, qn = q < 7 ? q + 1 : 7, rn = (qn >> 2) * HALF + wr * 64 + (qn & 3) * 16 + fr;
                const typename Prob::Pre pnext = prob.pre(cur, rn, wc * 32 + fq * 8);
                prob.epi(cur, r, wc * 32 + fq * 8, acc[ai][0][m][0], acc[ai][0][m][1], acc[ai][1][m][0], acc[ai][1][m][1], pcur); if (Prob::GATHER || true) { if (!Prob::NOSCHED) PG8_SCHED; }
                pcur = pnext; }
        }
        if (!has_next) break;
#pragma unroll
        for (int a = 0; a < 2; ++a)
#pragma unroll
            for (int b = 0; b < 2; ++b)
#pragma unroll
                for (int m = 0; m < 4; ++m)
#pragma unroll
                    for (int n = 0; n < 2; ++n) acc[a][b][m][n] = (f32x4){0.f, 0.f, 0.f, 0.f};
        cur = nxt; cA = nA; cB = nB; L += G;
#pragma unroll
        for (int i = 0; i < 4; ++i) voA[i] = nvoA[i];
        if (wr == 1) PG8_BAR;
    }
    PG8_WAIT_V(0);
    PG8_BAR;
#undef PG8_SA
#undef PG8_SB
#undef PG8_STAGE2
#undef PG8_STAGEB
#undef PG8_LDA
#undef PG8_LDB
#undef PG8_MMA
#undef PG8_WAIT_V
#undef PG8_WAIT_L
#undef PG8_BAR
#undef PG8_SCHED
}
}

template <class P> __global__ void __launch_bounds__(256) k_gemm_simple(Args args, int layer) {
    __shared__ float As[32][68]; __shared__ float Bs[32][260];
    P prob{&args, layer};
    const int L = blockIdx.x >> 2, rb = blockIdx.x & 3, tid = threadIdx.x, ty = tid >> 4, tx = tid & 15;
    if (L >= prob.nunits()) return;
    Unit u; prob.unit(L, u);
    const int ar = tid >> 2, aq = tid & 3;
    int arow = u.gidx ? u.gidx[rb * 64 + ar] : (u.a_row0 + rb * 64 + ar);
    arow = arow < 0 ? 0 : (arow >= NROW + NLIST ? 0 : arow);
    const bf16* ap = u.A + (size_t)arow * u.lda + aq * 8;
    float acc[2][4][8];
#pragma unroll
    for (int h = 0; h < 2; ++h)
#pragma unroll
        for (int i = 0; i < 4; ++i)
#pragma unroll
            for (int j = 0; j < 8; ++j) acc[h][i][j] = 0.f;
    for (int k0 = 0; k0 < D; k0 += 32) {
        v4u av = *(const v4u*)(ap + k0); v4u bv[4];
#pragma unroll
        for (int j = 0; j < 4; ++j) { const int p = tid + 256 * j; bv[j] = *(const v4u*)(u.B + (size_t)(p >> 2) * D + k0 + (p & 3) * 8); }
        __syncthreads();
        { const int kk = aq * 8; As[kk + 0][ar] = bflo(av.x); As[kk + 1][ar] = bfhi(av.x); As[kk + 2][ar] = bflo(av.y); As[kk + 3][ar] = bfhi(av.y); As[kk + 4][ar] = bflo(av.z); As[kk + 5][ar] = bfhi(av.z); As[kk + 6][ar] = bflo(av.w); As[kk + 7][ar] = bfhi(av.w); }
#pragma unroll
        for (int j = 0; j < 4; ++j) { const int p = tid + 256 * j, br = p >> 2, kk = (p & 3) * 8; Bs[kk + 0][br] = bflo(bv[j].x); Bs[kk + 1][br] = bfhi(bv[j].x); Bs[kk + 2][br] = bflo(bv[j].y); Bs[kk + 3][br] = bfhi(bv[j].y);
            Bs[kk + 4][br] = bflo(bv[j].z); Bs[kk + 5][br] = bfhi(bv[j].z); Bs[kk + 6][br] = bflo(bv[j].w); Bs[kk + 7][br] = bfhi(bv[j].w); }
        __syncthreads();
#pragma unroll 4
        for (int k = 0; k < 32; ++k) {
            const f32x4 a4 = *(const f32x4*)&As[k][ty * 4];
            const f32x4 b0 = *(const f32x4*)&Bs[k][tx * 8], b1 = *(const f32x4*)&Bs[k][tx * 8 + 4], b2 = *(const f32x4*)&Bs[k][128 + tx * 8], b3 = *(const f32x4*)&Bs[k][128 + tx * 8 + 4];
#pragma unroll
            for (int i = 0; i < 4; ++i)
#pragma unroll
                for (int j = 0; j < 4; ++j) { acc[0][i][j] += a4[i] * b0[j]; acc[0][i][4 + j] += a4[i] * b1[j]; acc[1][i][j] += a4[i] * b2[j]; acc[1][i][4 + j] += a4[i] * b3[j]; }
        }
    }
#pragma unroll
    for (int i = 0; i < 4; ++i)
        prob.epi(u, rb * 64 + ty * 4 + i, tx * 8, (f32x4){acc[0][i][0], acc[0][i][1], acc[0][i][2], acc[0][i][3]}, (f32x4){acc[0][i][4], acc[0][i][5], acc[0][i][6], acc[0][i][7]},
                 (f32x4){acc[1][i][0], acc[1][i][1], acc[1][i][2], acc[1][i][3]}, (f32x4){acc[1][i][4], acc[1][i][5], acc[1][i][6], acc[1][i][7]}, prob.pre(u, rb * 64 + ty * 4 + i, tx * 8));
}

__global__ void __launch_bounds__(256) k_ssd_naive(Args args, int l) {
    __shared__ float xs[32][64]; __shared__ float Bsm[32][128]; __shared__ float Csm[32][128]; __shared__ float dts[32];
    const int b = blockIdx.x >> 4, h = blockIdx.x & 15, g = h >> 2, tid = threadIdx.x, p = tid >> 2, nq = tid & 3;
    const bf16* P = (const bf16*)(args.ws + WS_P); bf16* Y = (bf16*)(args.ws + WS_XM); const float* DT = (const float*)(args.ws + WS_DT);
    const float* cw = args.in[I_CONVW] + (size_t)l * 3 * 2048; const float* cb = args.in[I_CONVB] + (size_t)l * 2048;
    const float dskip = args.in[I_DSKIP][l * 16 + h];
    for (int dir = 0; dir < 2; ++dir) {
        float st[32];
#pragma unroll
        for (int i = 0; i < 32; ++i) st[i] = 0.f;
        const float Ah = -__expf(args.in[I_ALOG][(l * 2 + dir) * 16 + h]);
        for (int seg = 0; seg < 2; ++seg) {
            const int base = seg == 0 ? NLAT + b * CTXL : b * SEQ, len = seg == 0 ? CTXL : SEQ;
            const bool wy = !(l == 1 && seg == 0);
            for (int blk = 0; blk < len / 32; ++blk) {
                for (int idx = tid; idx < 32 * 320; idx += 256) {
                    const int tt = idx / 320, ch = idx % 320;
                    const int tok = dir == 0 ? blk * 32 + tt : len - 1 - (blk * 32 + tt);
                    const int col = ch < 64 ? PX + h * 64 + ch : (ch < 192 ? PB + g * 128 + (ch - 64) : PC + g * 128 + (ch - 192));
                    const bf16* pp = P + (size_t)(base + tok) * PW + col;
                    const float cur = bf2f(pp[0]), prv = tok > 0 ? bf2f(pp[-PW]) : 0.f, nxt = tok < len - 1 ? bf2f(pp[PW]) : 0.f;
                    const float v = siluf_(cw[col] * prv + cw[2048 + col] * cur + cw[4096 + col] * nxt + cb[col]);
                    if (ch < 64) xs[tt][ch] = v; else if (ch < 192) Bsm[tt][ch - 64] = v; else Csm[tt][ch - 192] = v;
                }
                if (tid < 32) { const int tok = dir == 0 ? blk * 32 + tid : len - 1 - (blk * 32 + tid); dts[tid] = DT[(size_t)(base + tok) * 32 + dir * 16 + h]; }
                __syncthreads();
                for (int tt = 0; tt < 32; ++tt) {
                    const float dt = dts[tt], dA = __expf(dt * Ah), xr = xs[tt][p], xv = xr * dt;
                    float ys = 0.f;
#pragma unroll
                    for (int i = 0; i < 32; ++i) { const int n = nq * 32 + i; st[i] = st[i] * dA + xv * Bsm[tt][n]; ys += st[i] * Csm[tt][n]; }
                    ys += __shfl_xor(ys, 1); ys += __shfl_xor(ys, 2);
                    if (nq == 0 && wy) { const int tok = dir == 0 ? blk * 32 + tt : len - 1 - (blk * 32 + tt); bf16* yp = Y + (size_t)(base + tok) * D + h * 64 + p;
                        if (dir == 0) *yp = (bf16)f2bf(ys + dskip * xr); else *yp = (bf16)f2bf(bf2f(*yp) + ys); }
                }
                __syncthreads();
            }
        }
    }
}

__global__ void __launch_bounds__(512) k_sgu_naive(Args args, int l) {
    extern __shared__ __attribute__((aligned(16))) unsigned char smem[];
    float* Vn = (float*)smem; float* mu = Vn + 128 * 128; float* rs = mu + 128;
    const int chunk = blockIdx.x >> 3, g = blockIdx.x & 7, tid = threadIdx.x, lane = tid & 63, wave = tid >> 6;
    const int row0 = chunk < 256 ? chunk * 128 : NLAT + (chunk - 256) * 128;
    bf16* P = (bf16*)(args.ws + WS_P);
    for (int rr = 0; rr < 16; ++rr) { const int j = wave * 16 + rr; const bf16* vp = P + (size_t)(row0 + j) * PW + PV;
        float v[16]; float s = 0.f;
#pragma unroll
        for (int q = 0; q < 2; ++q) { const v4u w = *(const v4u*)(vp + lane * 8 + 512 * q); v[q * 8 + 0] = bflo(w.x); v[q * 8 + 1] = bfhi(w.x); v[q * 8 + 2] = bflo(w.y); v[q * 8 + 3] = bfhi(w.y); v[q * 8 + 4] = bflo(w.z); v[q * 8 + 5] = bfhi(w.z); v[q * 8 + 6] = bflo(w.w); v[q * 8 + 7] = bfhi(w.w); }
#pragma unroll
        for (int i = 0; i < 16; ++i) s += v[i];
        const float m = wave_sum(s) * (1.f / D); float s2 = 0.f;
#pragma unroll
        for (int i = 0; i < 16; ++i) { const float d = v[i] - m; s2 += d * d; }
        const float var = wave_sum(s2) * (1.f / D);
        if (lane == 0) { mu[j] = m; rs[j] = rsqrtf(var + EPS); } }
    __syncthreads();
    const float* lnw = args.in[I_LNW] + l * D + g * 128; const float* lnb = args.in[I_LNB] + l * D + g * 128;
    for (int idx = tid; idx < 128 * 128; idx += 512) { const int j = idx >> 7, d = idx & 127; Vn[idx] = (bf2f(P[(size_t)(row0 + j) * PW + PV + g * 128 + d]) - mu[j]) * rs[j] * lnw[d] + lnb[d]; }
    __syncthreads();
    const float* Wsg = args.in[I_WS] + ((size_t)(l * 8 + g) * 128) * 128; const float* bsg = args.in[I_BS] + (l * 8 + g) * 128;
    for (int idx = tid; idx < 128 * 128; idx += 512) { const int i = idx >> 7, d = idx & 127; float s = 0.f;
        for (int j = 0; j < 128; ++j) s += Wsg[i * 128 + j] * Vn[j * 128 + d];
        bf16* up = P + (size_t)(row0 + i) * PW + PU + g * 128 + d; *up = (bf16)f2bf(bf2f(*up) * (s + bsg[i])); }
}

__device__ __forceinline__ void tr_item(const float* W, int ldw, bf16* WT, int K, int k0, int n0, int drow0, LAS float* scr, int lane) {
    float tv[32];
#pragma unroll
    for (int i = 0; i < 32; ++i) tv[i] = W[(size_t)(k0 + 2 * i + (lane >> 5)) * ldw + n0 + (lane & 31)];
#pragma unroll
    for (int i = 0; i < 32; ++i) scr[(2 * i + (lane >> 5)) * 33 + (lane & 31)] = tv[i];
    asm volatile("s_waitcnt lgkmcnt(0)" ::: "memory");
    const int c = lane & 7;
#pragma unroll
    for (int j = 0; j < 4; ++j) { const int n = (lane >> 3) + 8 * j; const LAS float* s = scr + (8 * c) * 33 + n;
        v4u o; o.x = pk2(s[0 * 33], s[1 * 33]); o.y = pk2(s[2 * 33], s[3 * 33]); o.z = pk2(s[4 * 33], s[5 * 33]); o.w = pk2(s[6 * 33], s[7 * 33]);
        *(v4u*)(WT + (size_t)(drow0 + n) * K + k0 + 8 * c) = o; }
    asm volatile("s_waitcnt lgkmcnt(0)" ::: "memory");
}

__device__ __forceinline__ void phase_prologue(const Frame& F) {
    const Args& a = *F.a;
    LAS float* sc = (LAS float*)F.lds; LAS float* red = sc + 17 * 1024;
    if (F.bid < 192) {
        for (int i = F.tid; i < 17 * 1024; i += 512) { const int r = i >> 10, k = i & 1023; const float v = r < 16 ? a.in[I_C][r * 1024 + k] : a.in[I_CCTX][k]; sc[i] = siluf_(v); }
        __syncthreads();
        for (int it = F.bid; it < 192; it += F.G) {
            const int l = it / 96, nb = it % 96, n = nb * 64 + F.lane;
            float acc[17];
#pragma unroll
            for (int r = 0; r < 17; ++r) acc[r] = 0.f;
            const float* W = a.in[I_ADAW] + (size_t)l * 1024 * 6144 + n;
#pragma unroll 4
            for (int kk = 0; kk < 128; ++kk) { const int k = F.wave * 128 + kk; const float wv = W[(size_t)k * 6144];
#pragma unroll
                for (int r = 0; r < 17; ++r) acc[r] += sc[r * 1024 + k] * wv; }
#pragma unroll
            for (int r = 0; r < 17; ++r) red[(F.wave * 17 + r) * 64 + F.lane] = acc[r];
            __syncthreads();
            for (int i = F.tid; i < 17 * 64; i += 512) { const int r = i >> 6, ln = i & 63; float s = 0.f;
#pragma unroll
                for (int w = 0; w < 8; ++w) s += red[(w * 17 + r) * 64 + ln];
                ((float*)(a.ws + WS_MOD))[(size_t)(l * 17 + r) * 6144 + nb * 64 + ln] = s + a.in[I_ADAB][l * 6144 + nb * 64 + ln]; }
            __syncthreads();
        }
    }
    __syncthreads();
    LAS float* scr = (LAS float*)(F.lds + F.wave * 8448);
    const int gw = F.bid * F.nw + F.wave, NGW = F.G * F.nw;
    constexpr int IT_IN = 16 * 225, IT_MX = 16 * 32, IT_L = IT_IN + 3 * IT_MX;
    for (int it = gw; it < 2 * IT_L; it += NGW) {
        const int l = it / IT_L; int r = it % IT_L;
        if (r < IT_IN) { const int kb = r / 225, nb = r % 225, n0 = nb * 32; const int d0 = n0 < 2048 ? n0 : (n0 < 2080 ? 7168 + (n0 - 2048) : n0 - 32);
            tr_item(a.in[I_WIN] + (size_t)l * D * NIN, NIN, (bf16*)(a.ws + WS_WIN) + (size_t)l * WIN_ROWS * D, D, kb * 64, n0, d0, scr, F.lane); }
        else { r -= IT_IN; const int m = r / IT_MX, q = r % IT_MX, kb = q / 32, nb = q % 32;
            const float* W = (m == 0 ? a.in[I_WPA] : (m == 1 ? a.in[I_WPB] : a.in[I_WO])) + (size_t)l * D * D;
            tr_item(W, D, (bf16*)(a.ws + WS_WMIX) + (size_t)(l * 3 + m) * D * D, D, kb * 64, nb * 32, nb * 32, scr, F.lane); }
    }
    for (int i = F.bid * 512 + F.tid; i < 2 * 224 * 128; i += F.G * 512) { const int l = i / (224 * 128), q = i % (224 * 128);
        *(v4u*)((bf16*)(a.ws + WS_WIN) + ((size_t)l * WIN_ROWS + 7200) * D + (size_t)q * 8) = (v4u){0u, 0u, 0u, 0u}; }
    for (int i = F.bid * 512 + F.tid; i < 2 * 8 * 128 * 128 / 4; i += F.G * 512) { const f32x4 v = *(const f32x4*)(a.in[I_WS] + (size_t)i * 4); *(v2u*)((bf16*)(a.ws + WS_WST) + (size_t)i * 4) = pack4(v); }
}

__device__ __forceinline__ void convert_experts(const Frame& F, int l) {
    const Args& a = *F.a;
    LAS float* scr = (LAS float*)(F.lds + 65536 + F.wave * 8448);
    const int gw = F.bid * F.nw + F.wave, NGW = F.G * F.nw;
    for (int it = gw; it < 16 * 3 * 512; it += NGW) {
        const int e = it / 1536, r = it % 1536, m = r / 512, q = r % 512, kb = q / 32, nb = q % 32, n0 = nb * 32;
        const float* W = (m == 0 ? a.in[I_WG] : (m == 1 ? a.in[I_WU] : a.in[I_WD])) + ((size_t)l * 16 + e) * D * D;
        if (m < 2) tr_item(W, D, (bf16*)(a.ws + WS_P + PO_WGU) + (size_t)e * 2048 * D, D, kb * 64, n0, (n0 >> 7) * 256 + m * 128 + (n0 & 127), scr, F.lane);
        else tr_item(W, D, (bf16*)(a.ws + WS_P + PO_WD) + (size_t)e * 1024 * D, D, kb * 64, n0, n0, scr, F.lane);
    }
}

__device__ __forceinline__ void moe_combine(const Frame& F, int lprev, int r, f32x4 (&v)[4]) {
    const Args& a = *F.a;
    const int* inv = (const int*)(a.ws + WS_INV) + (size_t)r * 16;
    const int myslot = F.lane < 16 ? inv[F.lane] : -1;
    const bool lat = r < NLAT; const int b = lat ? (r >> 11) : ((r - NLAT) >> 8);
    f32x4 s[4];
#pragma unroll
    for (int j = 0; j < 4; ++j) s[j] = (f32x4){0.f, 0.f, 0.f, 0.f};
    const bf16* YM = (const bf16*)(a.ws + WS_P + PO_YM);
    for (int e = 0; e < 16; ++e) {
        const int slot = __builtin_amdgcn_readlane(myslot, e);
        if (slot >= 0) { const size_t hrow = lat ? (size_t)((b * 16 + e) * 256 + slot) : (size_t)(LIST_C0 + e * 512 + b * 32 + slot);
            const bf16* yp = YM + hrow * D + 4 * F.lane;
#pragma unroll
            for (int j = 0; j < 4; ++j) s[j] += unpack4(*(const v2u*)(yp + 256 * j)); }
    }
    const float* g2 = modp(a, lprev, batch_row(r)) + 5120 + 4 * F.lane;
#pragma unroll
    for (int j = 0; j < 4; ++j) v[j] += *(const f32x4*)(g2 + 256 * j) * s[j];
}

__device__ __forceinline__ const float* hrow_in(const Args& a, int l, int r) {
    const bool lat = r < NLAT;
    return (l == 0) ? (lat ? a.in[I_X] + (size_t)r * D : a.in[I_CTX] + (size_t)(r - NLAT) * D) : (lat ? a.out + (size_t)r * D : (const float*)(a.ws + WS_HC) + (size_t)(r - NLAT) * D);
}
__device__ __forceinline__ void phase_norm1(const Frame& F, int l) {
    const Args& a = *F.a;
    const int gw = F.bid * F.nw + F.wave, NGW = F.G * F.nw;
    f32x4 v[4], vn[4];
    if (gw < NROW) { const float* hin = hrow_in(a, l, gw) + 4 * F.lane;
#pragma unroll
        for (int j = 0; j < 4; ++j) v[j] = *(const f32x4*)(hin + 256 * j); }
    for (int r = gw; r < NROW; r += NGW) {
        const bool lat = r < NLAT;
        { const int rn = r + NGW < NROW ? r + NGW : r; const float* hn = hrow_in(a, l, rn) + 4 * F.lane;
#pragma unroll
            for (int j = 0; j < 4; ++j) vn[j] = *(const f32x4*)(hn + 256 * j); }
        if (l > 0) { moe_combine(F, l - 1, r, v); float* ho = lat ? a.out + (size_t)r * D : (float*)(a.ws + WS_HC) + (size_t)(r - NLAT) * D;
#pragma unroll
            for (int j = 0; j < 4; ++j) *(f32x4*)(ho + 4 * F.lane + 256 * j) = v[j]; }
        float ss = 0.f;
#pragma unroll
        for (int j = 0; j < 4; ++j) ss += v[j].x * v[j].x + v[j].y * v[j].y + v[j].z * v[j].z + v[j].w * v[j].w;
        const float rstd = rsqrtf(wave_sum(ss) * (1.f / D) + EPS);
        const float* md = modp(a, l, batch_row(r)) + 4 * F.lane; const float* nw = a.in[I_N1W] + l * D + 4 * F.lane;
        bf16* o = (bf16*)(a.ws + WS_XM) + (size_t)r * D + 4 * F.lane;
#pragma unroll
        for (int j = 0; j < 4; ++j) { const f32x4 w = *(const f32x4*)(nw + 256 * j), sh = *(const f32x4*)(md + 256 * j), scl = *(const f32x4*)(md + 1024 + 256 * j);
            *(v2u*)(o + 256 * j) = pack4(v[j] * rstd * w * (scl + 1.0f) + sh); }
#pragma unroll
        for (int j = 0; j < 4; ++j) v[j] = vn[j];
    }
}

__device__ __forceinline__ void phase_ssdin(const Frame& F, int l) {
    const Args& a = *F.a;
    const int gw = F.bid * F.nw + F.wave, NGW = F.G * F.nw, nrows = l == 0 ? NROW : NLAT;
    const float* nw = a.in[I_SSDNW] + l * D + 4 * F.lane;
    v2u yv[4], zv[4], yn[4], zn[4];
    if (gw < nrows) {
#pragma unroll
        for (int j = 0; j < 4; ++j) { yv[j] = *(const v2u*)((const bf16*)(a.ws + WS_XM) + (size_t)gw * D + 4 * F.lane + 256 * j); zv[j] = *(const v2u*)((const bf16*)(a.ws + WS_P) + (size_t)gw * PW + PZ + 4 * F.lane + 256 * j); } }
    for (int r = gw; r < nrows; r += NGW) {
        const int rn = r + NGW < nrows ? r + NGW : r;
#pragma unroll
        for (int j = 0; j < 4; ++j) { yn[j] = *(const v2u*)((const bf16*)(a.ws + WS_XM) + (size_t)rn * D + 4 * F.lane + 256 * j); zn[j] = *(const v2u*)((const bf16*)(a.ws + WS_P) + (size_t)rn * PW + PZ + 4 * F.lane + 256 * j); }
        bf16* z = (bf16*)(a.ws + WS_P) + (size_t)r * PW + PZ + 4 * F.lane;
#pragma unroll
        for (int j = 0; j < 4; ++j) { const f32x4 g = unpack4(yv[j]) * unpack4(zv[j]);
            const float ms = wave_sum(g.x * g.x + g.y * g.y + g.z * g.z + g.w * g.w) * (1.f / 256.f);
            *(v2u*)(z + 256 * j) = pack4(g * rsqrtf(ms + EPS) * *(const f32x4*)(nw + 256 * j)); }
#pragma unroll
        for (int j = 0; j < 4; ++j) { yv[j] = yn[j]; zv[j] = zn[j]; }
    }
}

__device__ __forceinline__ void phase_norm2(const Frame& F, int l) {
    const Args& a = *F.a;
    LAS float* rwT = (LAS float*)F.lds;
    for (int i = F.tid; i < 16 * 1024; i += 512) { const int k = i >> 4, e = i & 15; rwT[e * 1024 + k] = a.in[I_RW][(size_t)l * D * 16 + i]; }
    __syncthreads();
    const int gw = F.bid * F.nw + F.wave, NGW = F.G * F.nw, nrows = l == 0 ? NROW : NLAT;
    f32x4 v[4], vn[4];
    if (gw < nrows) { const float* hin = hrow_in(a, 1, gw) + 4 * F.lane;
#pragma unroll
        for (int j = 0; j < 4; ++j) v[j] = *(const f32x4*)(hin + 256 * j); }
    for (int r = gw; r < nrows; r += NGW) {
        { const int rn = r + NGW < nrows ? r + NGW : r; const float* hn = hrow_in(a, 1, rn) + 4 * F.lane;
#pragma unroll
            for (int j = 0; j < 4; ++j) vn[j] = *(const f32x4*)(hn + 256 * j); }
        float ss = 0.f;
#pragma unroll
        for (int j = 0; j < 4; ++j) ss += v[j].x * v[j].x + v[j].y * v[j].y + v[j].z * v[j].z + v[j].w * v[j].w;
        const float rstd = rsqrtf(wave_sum(ss) * (1.f / D) + EPS);
        const float* md = modp(a, l, batch_row(r)) + 3072 + 4 * F.lane; const float* nw = a.in[I_N2W] + l * D + 4 * F.lane;
        bf16* o = (bf16*)(a.ws + WS_XM) + (size_t)r * D + 4 * F.lane;
#pragma unroll
        for (int j = 0; j < 4; ++j) { const f32x4 w = *(const f32x4*)(nw + 256 * j), sh = *(const f32x4*)(md + 256 * j), scl = *(const f32x4*)(md + 1024 + 256 * j);
            v[j] = v[j] * rstd * w * (scl + 1.0f) + sh; *(v2u*)(o + 256 * j) = pack4(v[j]); }
        float mine = 0.f;
#pragma unroll 1
        for (int e = 0; e < 16; ++e) { float s = 0.f;
#pragma unroll
            for (int j = 0; j < 4; ++j) { const f32x4 w = *(const LAS f32x4*)(rwT + e * 1024 + 4 * F.lane + 256 * j); s += v[j].x * w.x + v[j].y * w.y + v[j].z * w.z + v[j].w * w.w; }
            s = wave_sum(s); mine = (F.lane == e) ? s : mine; }
        float mx = mine;
#pragma unroll
        for (int o = 1; o < 16; o <<= 1) mx = fmaxf(mx, __shfl_xor(mx, o));
        const float ex = __expf(mine - mx); float den = ex;
#pragma unroll
        for (int o = 1; o < 16; o <<= 1) den += __shfl_xor(den, o);
        if (F.lane < 16) ((float*)(a.ws + WS_AFF))[(size_t)r * 16 + F.lane] = ex / den;
#pragma unroll
        for (int j = 0; j < 4; ++j) v[j] = vn[j];
    }
    __syncthreads();
    convert_experts(F, l);
}

__device__ __forceinline__ int block_excl_scan(int c, LAS int* slots, int wave, int lane, int& total) {
    int inc = c;
#pragma unroll
    for (int o = 1; o < 64; o <<= 1) { const int v = __shfl_up(inc, o); if (lane >= o) inc += v; }
    if (lane == 63) slots[wave] = inc;
    __syncthreads();
    int before = 0, tot = 0;
#pragma unroll
    for (int w2 = 0; w2 < 8; ++w2) { const int v = slots[w2]; tot += v; before += (w2 < wave) ? v : 0; }
    __syncthreads();
    total = tot;
    return before + inc - c;
}
__device__ __forceinline__ void phase_topk(const Frame& F, int l) {
    const Args& a = *F.a;
    LAS int* cnts = (LAS int*)F.lds;
    const int ntask = l == 0 ? 512 : 256;
    const float* AFF = (const float*)(a.ws + WS_AFF); int* INV = (int*)(a.ws + WS_INV); int* IDX = (int*)(a.ws + WS_IDX); float* GATE = (float*)(a.ws + WS_GATE);
    for (int task = F.bid; task < ntask; task += F.G) {
        const bool lat = task < 256; const int t = lat ? task : task - 256, b = t >> 4, e = t & 15;
        const int r0 = lat ? b * SEQ : NLAT + b * CTXL, n = lat ? SEQ : CTXL, cap = lat ? CAP_L : CAP_C;
        const int list0 = lat ? (b * 16 + e) * 256 : LIST_C0 + e * 512 + b * 32;
        unsigned k[4]; bool valid[4];
#pragma unroll
        for (int q = 0; q < 4; ++q) { const int i = 4 * F.tid + q; valid[q] = i < n; k[q] = valid[q] ? __builtin_bit_cast(unsigned, AFF[(size_t)(r0 + i) * 16 + e]) : 0u; }
        unsigned T = 0u;
        for (int bit = 30; bit >= 0; --bit) {
            const unsigned trial = T | (1u << bit);
            int c = 0;
#pragma unroll
            for (int q = 0; q < 4; ++q) c += __builtin_popcountll(__ballot(valid[q] && k[q] >= trial));
            LAS int* sl = cnts + (bit & 1) * 8;
            if (F.lane == 0) sl[F.wave] = c;
            __syncthreads();
            int tot = 0;
#pragma unroll
            for (int w2 = 0; w2 < 8; ++w2) tot += sl[w2];
            if (tot >= cap) T = trial;
        }
        __syncthreads();
        int cgt = 0, ceq = 0;
#pragma unroll
        for (int q = 0; q < 4; ++q) { cgt += (valid[q] && k[q] > T) ? 1 : 0; ceq += (valid[q] && k[q] == T) ? 1 : 0; }
        int ngt, neq;
        (void)block_excl_scan(cgt, cnts + 16, F.wave, F.lane, ngt);
        int eqr = block_excl_scan(ceq, cnts + 16, F.wave, F.lane, neq);
        const int need = cap - ngt;
        bool sel[4]; int csel = 0;
#pragma unroll
        for (int q = 0; q < 4; ++q) { const bool eq = valid[q] && k[q] == T; sel[q] = valid[q] && (k[q] > T || (eq && eqr < need)); eqr += eq ? 1 : 0; csel += sel[q] ? 1 : 0; }
        int nsel; int slot = block_excl_scan(csel, cnts + 16, F.wave, F.lane, nsel);
#pragma unroll
        for (int q = 0; q < 4; ++q) { const int i = 4 * F.tid + q;
            if (valid[q]) { const int sl = sel[q] ? slot : -1; INV[(size_t)(r0 + i) * 16 + e] = sl;
                if (sel[q]) { IDX[list0 + slot] = r0 + i; GATE[list0 + slot] = __builtin_bit_cast(float, k[q]); ++slot; } } }
    }
}

__device__ __forceinline__ void phase_final(const Frame& F) {
    const Args& a = *F.a;
    const int gw = F.bid * F.nw + F.wave, NGW = F.G * F.nw;
    for (int r = gw; r < NLAT; r += NGW) {
        float* h = a.out + (size_t)r * D + 4 * F.lane; f32x4 v[4];
#pragma unroll
        for (int j = 0; j < 4; ++j) v[j] = *(const f32x4*)(h + 256 * j);
        moe_combine(F, 1, r, v);
        float ss = 0.f;
#pragma unroll
        for (int j = 0; j < 4; ++j) ss += v[j].x * v[j].x + v[j].y * v[j].y + v[j].z * v[j].z + v[j].w * v[j].w;
        const float rstd = rsqrtf(wave_sum(ss) * (1.f / D) + EPS);
#pragma unroll
        for (int j = 0; j < 4; ++j) *(f32x4*)(h + 256 * j) = v[j] * rstd * *(const f32x4*)(a.in[I_FNW] + 4 * F.lane + 256 * j);
    }
}


__device__ __forceinline__ void phase_ssd_seq(const Frame& F, int l) {
    const Args& a = *F.a;
    LAS float* xs = (LAS float*)F.lds; LAS float* Bsm = xs + 32 * 64; LAS float* Csm = Bsm + 32 * 128; LAS float* dts = Csm + 32 * 128;
    const bf16* P = (const bf16*)(a.ws + WS_P); bf16* Y = (bf16*)(a.ws + WS_XM); const float* DT = (const float*)(a.ws + WS_DT);
    const float* cw = a.in[I_CONVW] + (size_t)l * 3 * 2048; const float* cb = a.in[I_CONVB] + (size_t)l * 2048;
    const int tid = F.tid, p = tid >> 3, nq = tid & 7;
    for (int task = F.bid; task < 256; task += F.G) {
        const int b = task >> 4, h = task & 15, g = h >> 2;
        const float dskip = a.in[I_DSKIP][l * 16 + h];
        for (int dir = 0; dir < 2; ++dir) {
            float st[16];
#pragma unroll
            for (int i = 0; i < 16; ++i) st[i] = 0.f;
            const float Ah = -__expf(a.in[I_ALOG][(l * 2 + dir) * 16 + h]);
            for (int seg = 0; seg < 2; ++seg) {
                const int base = seg == 0 ? NLAT + b * CTXL : b * SEQ, len = seg == 0 ? CTXL : SEQ;
                const bool wy = !(l == 1 && seg == 0);
                for (int blk = 0; blk < len / 32; ++blk) {
                    for (int idx = tid; idx < 32 * 320; idx += 512) {
                        const int tt = idx / 320, ch = idx % 320;
                        const int tok = dir == 0 ? blk * 32 + tt : len - 1 - (blk * 32 + tt);
                        const int col = ch < 64 ? PX + h * 64 + ch : (ch < 192 ? PB + g * 128 + (ch - 64) : PC + g * 128 + (ch - 192));
                        const bf16* pp = P + (size_t)(base + tok) * PW + col;
                        const float cur = bf2f(pp[0]), prv = tok > 0 ? bf2f(pp[-PW]) : 0.f, nxt = tok < len - 1 ? bf2f(pp[PW]) : 0.f;
                        const float v = siluf_(cw[col] * prv + cw[2048 + col] * cur + cw[4096 + col] * nxt + cb[col]);
                        if (ch < 64) xs[tt * 64 + ch] = v; else if (ch < 192) Bsm[tt * 128 + ch - 64] = v; else Csm[tt * 128 + ch - 192] = v;
                    }
                    if (tid < 32) { const int tok = dir == 0 ? blk * 32 + tid : len - 1 - (blk * 32 + tid); dts[tid] = DT[(size_t)(base + tok) * 32 + dir * 16 + h]; }
                    __syncthreads();
                    for (int tt = 0; tt < 32; ++tt) {
                        const float dt = dts[tt], dA = __expf(dt * Ah), xr = xs[tt * 64 + p], xv = xr * dt;
                        float ys = 0.f;
#pragma unroll
                        for (int i = 0; i < 16; ++i) { const int n = nq * 16 + i; st[i] = st[i] * dA + xv * Bsm[tt * 128 + n]; ys += st[i] * Csm[tt * 128 + n]; }
                        ys += __shfl_xor(ys, 1); ys += __shfl_xor(ys, 2); ys += __shfl_xor(ys, 4);
                        if (nq == 0 && wy) { const int tok = dir == 0 ? blk * 32 + tt : len - 1 - (blk * 32 + tt); bf16* yp = Y + (size_t)(base + tok) * D + h * 64 + p;
                            if (dir == 0) *yp = (bf16)f2bf(ys + dskip * xr); else *yp = (bf16)f2bf(bf2f(*yp) + ys); }
                    }
                    __syncthreads();
                }
            }
        }
    }
}


typedef short s16x4 __attribute__((ext_vector_type(4)));
__device__ __forceinline__ bf16x8 tr_frag(const LAS unsigned char* p, int stride4) {
    const s16x4 lo = __builtin_amdgcn_ds_read_tr16_b64_v4i16((LAS s16x4*)p), hi = __builtin_amdgcn_ds_read_tr16_b64_v4i16((LAS s16x4*)(p + stride4));
    return __builtin_shufflevector(lo, hi, 0, 1, 2, 3, 4, 5, 6, 7);
}
__device__ __forceinline__ void phase_ssd_chunked(const Frame& F, int l) {
    const Args& a = *F.a;
    constexpr int SB = 272, SX = 144;
    constexpr int O_BS = 0, O_CS = 34816, O_HS = 69632, O_XS = 87040, O_XW = 105472, O_DT = 123904, O_AC = 124416, O_SC = 124928, O_TOT = 125440;
    LAS unsigned char* Ls = F.lds;
    LAS float* dtl = (LAS float*)(Ls + O_DT); LAS float* acl = (LAS float*)(Ls + O_AC); LAS float* scl = (LAS float*)(Ls + O_SC); LAS float* totl = (LAS float*)(Ls + O_TOT);
    const bf16* P = (const bf16*)(a.ws + WS_P); bf16* Y = (bf16*)(a.ws + WS_XM); const float* DT = (const float*)(a.ws + WS_DT);
    const float* cw = a.in[I_CONVW] + (size_t)l * 3 * 2048; const float* cb = a.in[I_CONVB] + (size_t)l * 2048;
    const int tid = F.tid, lane = F.lane, w = F.wave, r16 = lane & 15, q4 = lane >> 4;
    for (int task = F.bid; task < 256; task += F.G) {
        const int b = task >> 4, h = task & 15, g = h >> 2;
        const float dskip = a.in[I_DSKIP][l * 16 + h];
        const int cg = tid % 40, rg = tid / 40;
        const int gcol = cg < 8 ? PX + h * 64 + cg * 8 : (cg < 24 ? PB + g * 128 + (cg - 8) * 8 : PC + g * 128 + (cg - 24) * 8);
        const int dstoff = cg < 8 ? O_XS + cg * 16 : (cg < 24 ? O_BS + (cg - 8) * 16 : O_CS + (cg - 24) * 16), dststr = cg < 8 ? SX : SB;
        for (int dir = 0; dir < 2; ++dir) {
            f32x4 acch[4];
#pragma unroll
            for (int i = 0; i < 4; ++i) acch[i] = (f32x4){0.f, 0.f, 0.f, 0.f};
            for (int i = tid; i < 64 * SB / 16; i += 512) *(LAS v4u*)(Ls + O_HS + i * 16) = (v4u){0u, 0u, 0u, 0u};
            const float Ah = -__expf(a.in[I_ALOG][(l * 2 + dir) * 16 + h]);
            v4u rows[13]; bool have_pref = false;
            for (int step = 0; step < 18; ++step) {
                const bool isctx = step < 2;
                const int chunk = dir == 0 ? (isctx ? step : step - 2) : (isctx ? 1 - step : 17 - step);
                const int len = isctx ? CTXL : SEQ, t0 = chunk * 128, base = (isctx ? NLAT + b * CTXL : b * SEQ) + t0;
                const bool wy = !(l == 1 && isctx);
                if (tid < 480) {
                    int gc = gcol; asm volatile("" : "+v"(gc));
                    float w0[8], w1[8], w2[8], bs[8];
#pragma unroll
                    for (int i = 0; i < 8; ++i) { w0[i] = cw[gc + i]; w1[i] = cw[2048 + gc + i]; w2[i] = cw[4096 + gc + i]; bs[i] = cb[gc + i]; }
                    const int i0 = rg * 11;
                    if (!have_pref) {
                        const bf16* pp = P + (size_t)(base + i0) * PW + gc;
#pragma unroll
                        for (int ii = 0; ii < 13; ++ii) { const int t = t0 + i0 + ii - 1; rows[ii] = (t >= 0 && t < len) ? *(const v4u*)(pp + (ptrdiff_t)(ii - 1) * PW) : (v4u){0u, 0u, 0u, 0u}; }
                    }
#pragma unroll
                    for (int ii = 0; ii < 11; ++ii) { const v4u p0 = rows[ii], p1 = rows[ii + 1], p2 = rows[ii + 2]; float o[8];
                        o[0] = w0[0] * bflo(p0.x) + w1[0] * bflo(p1.x) + w2[0] * bflo(p2.x) + bs[0]; o[1] = w0[1] * bfhi(p0.x) + w1[1] * bfhi(p1.x) + w2[1] * bfhi(p2.x) + bs[1];
                        o[2] = w0[2] * bflo(p0.y) + w1[2] * bflo(p1.y) + w2[2] * bflo(p2.y) + bs[2]; o[3] = w0[3] * bfhi(p0.y) + w1[3] * bfhi(p1.y) + w2[3] * bfhi(p2.y) + bs[3];
                        o[4] = w0[4] * bflo(p0.z) + w1[4] * bflo(p1.z) + w2[4] * bflo(p2.z) + bs[4]; o[5] = w0[5] * bfhi(p0.z) + w1[5] * bfhi(p1.z) + w2[5] * bfhi(p2.z) + bs[5];
                        o[6] = w0[6] * bflo(p0.w) + w1[6] * bflo(p1.w) + w2[6] * bflo(p2.w) + bs[6]; o[7] = w0[7] * bfhi(p0.w) + w1[7] * bfhi(p1.w) + w2[7] * bfhi(p2.w) + bs[7];
                        v4u ov; ov.x = pk2(siluf_(o[0]), siluf_(o[1])); ov.y = pk2(siluf_(o[2]), siluf_(o[3])); ov.z = pk2(siluf_(o[4]), siluf_(o[5])); ov.w = pk2(siluf_(o[6]), siluf_(o[7]));
                        if (i0 + ii < 128) *(LAS v4u*)(Ls + dstoff + (i0 + ii) * dststr) = ov; }
                }
                if (w == 7) {
                    const int t = 2 * lane;
                    const float d0 = DT[(size_t)(base + t) * 32 + dir * 16 + h], d1 = DT[(size_t)(base + t + 1) * 32 + dir * 16 + h];
                    const float a0 = d0 * Ah, a1 = d1 * Ah;
                    float incl = a0 + a1;
#pragma unroll
                    for (int o = 1; o < 64; o <<= 1) { const float v = __shfl_up(incl, o); if (lane >= o) incl += v; }
                    const float tot = __shfl(incl, 63), excl = incl - (a0 + a1);
                    float c0, c1;
                    if (dir == 0) { c0 = excl + a0; c1 = incl; } else { c0 = tot - excl; c1 = tot - excl - a0; }
                    dtl[t] = d0; dtl[t + 1] = d1; acl[t] = c0; acl[t + 1] = c1; scl[t] = d0 * __expf(tot - c0); scl[t + 1] = d1 * __expf(tot - c1);
                    if (lane == 0) totl[0] = tot;
                }
                __syncthreads();
                { const int j = tid >> 2, c0 = (tid & 3) * 16; const float sc = scl[j];
                    const v4u x0 = *(const LAS v4u*)(Ls + O_XS + j * SX + c0 * 2), x1 = *(const LAS v4u*)(Ls + O_XS + j * SX + c0 * 2 + 16); v4u y0, y1;
                    y0.x = pk2(bflo(x0.x) * sc, bfhi(x0.x) * sc); y0.y = pk2(bflo(x0.y) * sc, bfhi(x0.y) * sc); y0.z = pk2(bflo(x0.z) * sc, bfhi(x0.z) * sc); y0.w = pk2(bflo(x0.w) * sc, bfhi(x0.w) * sc);
                    y1.x = pk2(bflo(x1.x) * sc, bfhi(x1.x) * sc); y1.y = pk2(bflo(x1.y) * sc, bfhi(x1.y) * sc); y1.z = pk2(bflo(x1.z) * sc, bfhi(x1.z) * sc); y1.w = pk2(bflo(x1.w) * sc, bfhi(x1.w) * sc);
                    *(LAS v4u*)(Ls + O_XW + j * SX + c0 * 2) = y0; *(LAS v4u*)(Ls + O_XW + j * SX + c0 * 2 + 16) = y1; }
                float yold[4][4];
#pragma unroll
                for (int pt = 0; pt < 4; ++pt)
#pragma unroll
                    for (int rg4 = 0; rg4 < 4; ++rg4) yold[pt][rg4] = (wy && dir == 1) ? bf2f(Y[(size_t)(base + 16 * w + 4 * q4 + rg4) * D + h * 64 + 16 * pt + r16]) : 0.f;
                if (wy) {
                    bf16x8 cf[4];
#pragma unroll
                    for (int ks = 0; ks < 4; ++ks) cf[ks] = *(const LAS bf16x8*)(Ls + O_CS + (16 * w + r16) * SB + (32 * ks + 8 * q4) * 2);
                    f32x4 aoff[4];
#pragma unroll
                    for (int pt = 0; pt < 4; ++pt) { aoff[pt] = (f32x4){0.f, 0.f, 0.f, 0.f};
#pragma unroll
                        for (int ks = 0; ks < 4; ++ks) aoff[pt] = __builtin_amdgcn_mfma_f32_16x16x32_bf16(cf[ks], *(const LAS bf16x8*)(Ls + O_HS + (16 * pt + r16) * SB + (32 * ks + 8 * q4) * 2), aoff[pt], 0, 0, 0); }
                    float aci[4];
#pragma unroll
                    for (int rg4 = 0; rg4 < 4; ++rg4) aci[rg4] = acl[16 * w + 4 * q4 + rg4];
#pragma unroll
                    for (int jt = 0; jt < 8; ++jt) {
                        const bool live = dir == 0 ? (jt <= w) : (jt >= w);
                        f32x4 cbv = (f32x4){0.f, 0.f, 0.f, 0.f};
                        if (live) {
#pragma unroll
                            for (int ks = 0; ks < 4; ++ks) cbv = __builtin_amdgcn_mfma_f32_16x16x32_bf16(cf[ks], *(const LAS bf16x8*)(Ls + O_BS + (16 * jt + r16) * SB + (32 * ks + 8 * q4) * 2), cbv, 0, 0, 0);
                            const int j = 16 * jt + r16; const float acj = acl[j], dtj = dtl[j];
#pragma unroll
                            for (int rg4 = 0; rg4 < 4; ++rg4) { const int i = 16 * w + 4 * q4 + rg4; const bool ok = dir == 0 ? (j <= i) : (j >= i);
                                cbv[rg4] = ok ? cbv[rg4] * __expf(fminf(aci[rg4] - acj, 0.f)) * dtj : 0.f; }
                        }
#pragma unroll
                        for (int rg4 = 0; rg4 < 4; ++rg4) *(LAS bf16*)(Ls + O_CS + (16 * w + 4 * q4 + rg4) * SB + (16 * jt + r16) * 2) = (bf16)f2bf(cbv[rg4]);
                    }
                    f32x4 ad[4];
#pragma unroll
                    for (int pt = 0; pt < 4; ++pt) { ad[pt] = (f32x4){0.f, 0.f, 0.f, 0.f};
#pragma unroll
                        for (int ks = 0; ks < 4; ++ks) ad[pt] = __builtin_amdgcn_mfma_f32_16x16x32_bf16(*(const LAS bf16x8*)(Ls + O_CS + (16 * w + r16) * SB + (32 * ks + 8 * q4) * 2),
                            tr_frag(Ls + O_XS + (32 * ks + 8 * q4 + (r16 >> 2)) * SX + (16 * pt + 4 * (r16 & 3)) * 2, 4 * SX), ad[pt], 0, 0, 0); }
#pragma unroll
                    for (int pt = 0; pt < 4; ++pt)
#pragma unroll
                        for (int rg4 = 0; rg4 < 4; ++rg4) { const int i = 16 * w + 4 * q4 + rg4, p = 16 * pt + r16;
                            float v = ad[pt][rg4] + __expf(aci[rg4]) * aoff[pt][rg4];
                            bf16* yp = Y + (size_t)(base + i) * D + h * 64 + p;
                            if (dir == 0) v += dskip * bf2f(*(const LAS bf16*)(Ls + O_XS + i * SX + p * 2)); else v += yold[pt][rg4];
                            *yp = (bf16)f2bf(v); }
                }
                have_pref = false;
                if (step < 17 && tid < 480) {
                    const int ns = step + 1; const bool nctx = ns < 2;
                    const int nchunk = dir == 0 ? (nctx ? ns : ns - 2) : (nctx ? 1 - ns : 17 - ns);
                    const int nlen = nctx ? CTXL : SEQ, nt0 = nchunk * 128, nbase = (nctx ? NLAT + b * CTXL : b * SEQ) + nt0, i0 = rg * 11;
                    const bf16* pp = P + (size_t)(nbase + i0) * PW + gcol;
#pragma unroll
                    for (int ii = 0; ii < 13; ++ii) { const int t = nt0 + i0 + ii - 1; rows[ii] = (t >= 0 && t < nlen) ? *(const v4u*)(pp + (ptrdiff_t)(ii - 1) * PW) : (v4u){0u, 0u, 0u, 0u}; }
                    have_pref = true;
                }
                __syncthreads();
                {
                    const float dec = __expf(totl[0]);
                    bf16x8 bfr[4];
#pragma unroll
                    for (int ks = 0; ks < 4; ++ks) bfr[ks] = tr_frag(Ls + O_BS + (32 * ks + 8 * q4 + (r16 >> 2)) * SB + (16 * w + 4 * (r16 & 3)) * 2, 4 * SB);
#pragma unroll
                    for (int pt = 0; pt < 4; ++pt) { acch[pt] *= dec;
#pragma unroll
                        for (int ks = 0; ks < 4; ++ks) acch[pt] = __builtin_amdgcn_mfma_f32_16x16x32_bf16(tr_frag(Ls + O_XW + (32 * ks + 8 * q4 + (r16 >> 2)) * SX + (16 * pt + 4 * (r16 & 3)) * 2, 4 * SX), bfr[ks], acch[pt], 0, 0, 0);
#pragma unroll
                        for (int rg4 = 0; rg4 < 4; ++rg4) *(LAS bf16*)(Ls + O_HS + (16 * pt + 4 * q4 + rg4) * SB + (16 * w + r16) * 2) = (bf16)f2bf(acch[pt][rg4]); }
                }
                __syncthreads();
            }
        }
    }
}


__device__ __forceinline__ void phase_vstats(const Frame& F, int l) {
    const Args& a = *F.a;
    const int gw = F.bid * F.nw + F.wave, NGW = F.G * F.nw, nrows = l == 0 ? NROW : NLAT;
    for (int r = gw; r < nrows; r += NGW) {
        const bf16* vp = (const bf16*)(a.ws + WS_P) + (size_t)r * PW + PV + F.lane * 8;
        const v4u w0 = *(const v4u*)vp, w1 = *(const v4u*)(vp + 512);
        float v[16] = {bflo(w0.x), bfhi(w0.x), bflo(w0.y), bfhi(w0.y), bflo(w0.z), bfhi(w0.z), bflo(w0.w), bfhi(w0.w), bflo(w1.x), bfhi(w1.x), bflo(w1.y), bfhi(w1.y), bflo(w1.z), bfhi(w1.z), bflo(w1.w), bfhi(w1.w)};
        float sm = 0.f;
#pragma unroll
        for (int i = 0; i < 16; ++i) sm += v[i];
        const float m = wave_sum(sm) * (1.f / D); float s2 = 0.f;
#pragma unroll
        for (int i = 0; i < 16; ++i) { const float d = v[i] - m; s2 += d * d; }
        const float var = wave_sum(s2) * (1.f / D);
        if (F.lane == 0) *(f32x2*)((float*)(a.ws + WS_VSTAT) + (size_t)r * 2) = (f32x2){m, rsqrtf(var + EPS)};
    }
}

__device__ __forceinline__ void phase_sgu_mfma(const Frame& F, int l) {
    const Args& a = *F.a;
    constexpr int SV = 272, SO = 528;
    constexpr int O_VN = 0, O_OUT = 34816;
    LAS unsigned char* Ls = F.lds;
    bf16* P = (bf16*)(a.ws + WS_P);
    const int ntask = (l == 0 ? 288 : 256) * 8, tid = F.tid, lane = F.lane, w = F.wave, r16 = lane & 15, q4 = lane >> 4;
    for (int task = F.bid; task < ntask; task += F.G) {
        const int chunk = task >> 3, g = task & 7;
        const int row0 = chunk < 256 ? chunk * 128 : NLAT + (chunk - 256) * 128;
        const float* lnw = a.in[I_LNW] + l * D + g * 128; const float* lnb = a.in[I_LNB] + l * D + g * 128;
#pragma unroll
        for (int q = 0; q < 4; ++q) { const int piece = tid + 512 * q, j = piece >> 4, d8 = (piece & 15) * 8;
            const v4u vv = *(const v4u*)(P + (size_t)(row0 + j) * PW + PV + g * 128 + d8);
            const f32x2 st = *(const f32x2*)((const float*)(a.ws + WS_VSTAT) + (size_t)(row0 + j) * 2);
            const f32x4 w0 = *(const f32x4*)(lnw + d8), w1 = *(const f32x4*)(lnw + d8 + 4), b0 = *(const f32x4*)(lnb + d8), b1 = *(const f32x4*)(lnb + d8 + 4);
            v4u o; o.x = pk2((bflo(vv.x) - st.x) * st.y * w0.x + b0.x, (bfhi(vv.x) - st.x) * st.y * w0.y + b0.y); o.y = pk2((bflo(vv.y) - st.x) * st.y * w0.z + b0.z, (bfhi(vv.y) - st.x) * st.y * w0.w + b0.w);
            o.z = pk2((bflo(vv.z) - st.x) * st.y * w1.x + b1.x, (bfhi(vv.z) - st.x) * st.y * w1.y + b1.y); o.w = pk2((bflo(vv.w) - st.x) * st.y * w1.z + b1.z, (bfhi(vv.w) - st.x) * st.y * w1.w + b1.w);
            *(LAS v4u*)(Ls + O_VN + j * SV + d8 * 2) = o; }
        bf16x8 af[4];
        const bf16* wsg = (const bf16*)(a.ws + WS_WST) + ((size_t)(l * 8 + g) * 128 + 16 * w + r16) * 128 + 8 * q4;
#pragma unroll
        for (int ks = 0; ks < 4; ++ks) af[ks] = *(const bf16x8*)(wsg + 32 * ks);
        float bi[4];
#pragma unroll
        for (int rg4 = 0; rg4 < 4; ++rg4) bi[rg4] = a.in[I_BS][(l * 8 + g) * 128 + 16 * w + 4 * q4 + rg4];
        __syncthreads();
#pragma unroll
        for (int dt = 0; dt < 8; ++dt) { f32x4 acc = (f32x4){0.f, 0.f, 0.f, 0.f};
#pragma unroll
            for (int ks = 0; ks < 4; ++ks) acc = __builtin_amdgcn_mfma_f32_16x16x32_bf16(af[ks], tr_frag(Ls + O_VN + (32 * ks + 8 * q4 + (r16 >> 2)) * SV + (16 * dt + 4 * (r16 & 3)) * 2, 4 * SV), acc, 0, 0, 0);
#pragma unroll
            for (int rg4 = 0; rg4 < 4; ++rg4) *(LAS float*)(Ls + O_OUT + (16 * w + 4 * q4 + rg4) * SO + (16 * dt + r16) * 4) = acc[rg4] + bi[rg4]; }
        __syncthreads();
#pragma unroll
        for (int q = 0; q < 4; ++q) { const int piece = tid + 512 * q, i = piece >> 4, d8 = (piece & 15) * 8;
            bf16* up = P + (size_t)(row0 + i) * PW + PU + g * 128 + d8; const v4u uv = *(const v4u*)up;
            const f32x4 m0 = *(const LAS f32x4*)(Ls + O_OUT + i * SO + d8 * 4), m1 = *(const LAS f32x4*)(Ls + O_OUT + i * SO + d8 * 4 + 16);
            v4u o; o.x = pk2(bflo(uv.x) * m0.x, bfhi(uv.x) * m0.y); o.y = pk2(bflo(uv.y) * m0.z, bfhi(uv.y) * m0.w); o.z = pk2(bflo(uv.z) * m1.x, bfhi(uv.z) * m1.y); o.w = pk2(bflo(uv.w) * m1.z, bfhi(uv.w) * m1.w);
            *(v4u*)up = o; }
        __syncthreads();
    }
}

__device__ __forceinline__ void phase_sgu_simple(const Frame& F, int l) {
    const Args& a = *F.a;
    LAS float* Vn = (LAS float*)F.lds; LAS float* mu = Vn + 128 * 128; LAS float* rs = mu + 128;
    bf16* P = (bf16*)(a.ws + WS_P);
    const int ntask = (l == 0 ? 288 : 256) * 8, tid = F.tid, lane = F.lane, wave = F.wave;
    for (int task = F.bid; task < ntask; task += F.G) {
        const int chunk = task >> 3, g = task & 7;
        const int row0 = chunk < 256 ? chunk * 128 : NLAT + (chunk - 256) * 128;
        for (int rr = 0; rr < 16; ++rr) { const int j = wave * 16 + rr; const bf16* vp = P + (size_t)(row0 + j) * PW + PV;
            float v[16]; float sm = 0.f;
#pragma unroll
            for (int q = 0; q < 2; ++q) { const v4u w = *(const v4u*)(vp + lane * 8 + 512 * q); v[q * 8 + 0] = bflo(w.x); v[q * 8 + 1] = bfhi(w.x); v[q * 8 + 2] = bflo(w.y); v[q * 8 + 3] = bfhi(w.y); v[q * 8 + 4] = bflo(w.z); v[q * 8 + 5] = bfhi(w.z); v[q * 8 + 6] = bflo(w.w); v[q * 8 + 7] = bfhi(w.w); }
#pragma unroll
            for (int i = 0; i < 16; ++i) sm += v[i];
            const float m = wave_sum(sm) * (1.f / D); float s2 = 0.f;
#pragma unroll
            for (int i = 0; i < 16; ++i) { const float d = v[i] - m; s2 += d * d; }
            const float var = wave_sum(s2) * (1.f / D);
            if (lane == 0) { mu[j] = m; rs[j] = rsqrtf(var + EPS); } }
        __syncthreads();
        const float* lnw = a.in[I_LNW] + l * D + g * 128; const float* lnb = a.in[I_LNB] + l * D + g * 128;
        for (int idx = tid; idx < 128 * 128; idx += 512) { const int j = idx >> 7, d = idx & 127; Vn[idx] = (bf2f(P[(size_t)(row0 + j) * PW + PV + g * 128 + d]) - mu[j]) * rs[j] * lnw[d] + lnb[d]; }
        __syncthreads();
        const float* Wsg = a.in[I_WS] + ((size_t)(l * 8 + g) * 128) * 128; const float* bsg = a.in[I_BS] + (l * 8 + g) * 128;
        for (int idx = tid; idx < 128 * 128; idx += 512) { const int i = idx >> 7, d = idx & 127; float sm = 0.f;
#pragma unroll 8
            for (int j = 0; j < 128; ++j) sm += Wsg[i * 128 + j] * Vn[j * 128 + d];
            bf16* up = P + (size_t)(row0 + i) * PW + PU + g * 128 + d; *up = (bf16)f2bf(bf2f(*up) * (sm + bsg[i])); }
        __syncthreads();
    }
}

#define XB_TMO      128
#define XB_XCNT(j)  (256  + 64 * (j))
#define XB_XSUB(j)  (1280 + 64 * (j))
#define XB_XGEN(j)  (2304 + 64 * (j))
#define XB_TOP      3328
#define XB_TOPGEN   3392
#define XCD_BAR_WORDS 3456
#define XB_SPIN_CAP (1u << 22)
__device__ __forceinline__ unsigned xb_ld(unsigned* p)              { return __hip_atomic_load(p, __ATOMIC_RELAXED, __HIP_MEMORY_SCOPE_AGENT); }
__device__ __forceinline__ unsigned xb_add(unsigned* p, unsigned v) { return __hip_atomic_fetch_add(p, v, __ATOMIC_RELAXED, __HIP_MEMORY_SCOPE_AGENT); }
__device__ __forceinline__ unsigned xb_xcc_id() { return (unsigned)__builtin_amdgcn_s_getreg((3 << 11) | 20) & 0xFu; }
#define XB_SPIN(cond, bar) do { unsigned _sp = 0; while (cond) { __builtin_amdgcn_s_sleep(1); \
    if ((++_sp & 255u) == 0u) { if (xb_ld(&(bar)[XB_TMO])) break; if (_sp > XB_SPIN_CAP) { atomicAdd(&(bar)[XB_TMO], 1u); break; } } } } while (0)
struct XcdBarrier { unsigned* bar; unsigned x; volatile LAS unsigned* st; };
__device__ __forceinline__ XcdBarrier xcd_barrier_post(unsigned* bar, volatile LAS unsigned* st) {
    XcdBarrier b; b.bar = bar; b.x = xb_xcc_id(); b.st = st;
    if (threadIdx.x == 0) (void)xb_add(&bar[XB_XCNT(b.x)], 1u);
    return b;
}
__device__ __forceinline__ void xcd_barrier_complete(unsigned* bar, unsigned x, unsigned& nloc, unsigned& nx) {
    const unsigned G = gridDim.x * gridDim.y * gridDim.z;
    unsigned sum, cnt, mine, sp = 0u;
    for (;;) {
        sum = 0u; cnt = 0u; mine = 0u;
#pragma unroll
        for (unsigned j = 0; j < 16; ++j) { const unsigned c = xb_ld(&bar[XB_XCNT(j)]); sum += c; cnt += (c > 0u) ? 1u : 0u; mine = (j == x) ? c : mine; }
        if (sum == G) break;
        __builtin_amdgcn_s_sleep(1);
        if ((++sp & 255u) == 0u) { if (xb_ld(&bar[XB_TMO])) break; if (sp > XB_SPIN_CAP) { atomicAdd(&bar[XB_TMO], 1u); break; } }
    }
    nloc = mine > 0u ? mine : 1u; nx = cnt > 0u ? cnt : 1u;
}
__device__ __forceinline__ void xcd_barrier(const XcdBarrier& b) {
    asm volatile("s_waitcnt vmcnt(0)" ::: "memory");
    __syncthreads();
    if (threadIdx.x == 0) {
        unsigned* bar = b.bar;
        __builtin_amdgcn_s_waitcnt(0);
        unsigned nloc = b.st[0], nx = b.st[1];
        if (nloc == 0u) { xcd_barrier_complete(bar, b.x, nloc, nx); b.st[0] = nloc; b.st[1] = nx; }
        const unsigned old = xb_add(&bar[XB_XSUB(b.x)], 1u);
        const unsigned gen = old / nloc;
        if (old + 1u == (gen + 1u) * nloc) {
            __builtin_amdgcn_fence(__ATOMIC_RELEASE, "agent");
            asm volatile("s_waitcnt vmcnt(0)" ::: "memory");
            const unsigned og = xb_add(&bar[XB_TOP], 1u);
            const unsigned tg = og / nx;
            if (og + 1u == (tg + 1u) * nx) xb_add(&bar[XB_TOPGEN], 1u);
            else XB_SPIN(xb_ld(&bar[XB_TOPGEN]) == tg, bar);
            __builtin_amdgcn_fence(__ATOMIC_ACQUIRE, "agent");
            xb_add(&bar[XB_XGEN(b.x)], 1u);
            asm volatile("s_waitcnt vmcnt(0)" ::: "memory");
        } else {
            XB_SPIN(xb_ld(&bar[XB_XGEN(b.x)]) == gen, bar);
            __builtin_amdgcn_fence(__ATOMIC_ACQUIRE, "agent");
            asm volatile("s_waitcnt vmcnt(0)" ::: "memory");
        }
    }
    __syncthreads();
}

constexpr int LDS_BYTES = 147456, LDS_MISC = 139264;
constexpr int CW_BAR = 4096;
constexpr int NPHASE = 22;
__global__ void __launch_bounds__(512, 2) mk_fwd(Args args) {
    extern __shared__ __attribute__((aligned(16))) unsigned char lds[];
    Frame F; F.lds = (LAS unsigned char*)lds; F.tid = threadIdx.x; F.lane = F.tid & 63; F.wave = __builtin_amdgcn_readfirstlane(F.tid >> 6); F.nw = 8; F.G = gridDim.x; F.bid = blockIdx.x; F.a = &args;
    const int lo = args.ph_lo, hi = args.ph_hi;
    volatile LAS unsigned* MISC = (volatile LAS unsigned*)(F.lds + LDS_MISC);
    if (F.tid < 64) MISC[F.tid] = 0u;
    __syncthreads();
    XcdBarrier bar; bar.bar = (unsigned*)(args.ws + WS_CTL) + CW_BAR; bar.x = 0; bar.st = MISC + 8;
    if (hi - lo > 1) bar = xcd_barrier_post((unsigned*)(args.ws + WS_CTL) + CW_BAR, MISC + 8);
#define IN(k) (lo <= (k) && (k) < hi)
#define SEAM(k) do { if (IN(k) && IN((k) + 1)) { XcdBarrier b2_ = bar; asm volatile("" : "+s"(b2_.bar)); xcd_barrier(b2_); } } while (0)
#define REP(k) for (int rep_ = 0; rep_ < ((k) == REPEAT_PH ? 2 : 1); ++rep_)
#define FRESH(Fp) Frame Fp = F; { int t_ = threadIdx.x; asm volatile("" : "+v"(t_)); Fp.tid = t_; Fp.lane = t_ & 63; Fp.wave = __builtin_amdgcn_readfirstlane(t_ >> 6); }
    if (IN(0)) REP(0) { FRESH(Fp); phase_prologue(Fp); __syncthreads(); } SEAM(0);
#pragma unroll 1
    for (int l = 0; l < 2; ++l) {
        const int base = 1 + 10 * l;
        if (IN(base + 0)) { FRESH(Fp); phase_norm1(Fp, l); } SEAM(base + 0);
        if (IN(base + 1)) REP(base + 1) { ProbIn p{&args, l}; pg8::gemm_phase(F.lds, p, F.G, F.bid); } SEAM(base + 1);
        if (IN(base + 2)) REP(base + 2) { FRESH(Fp); if (USE_SSD_SEQ) phase_ssd_seq(Fp, l); else phase_ssd_chunked(Fp, l); __syncthreads(); phase_vstats(Fp, l); } SEAM(base + 2);
        if (IN(base + 3)) { { FRESH(Fp); phase_ssdin(Fp, l); } { FRESH(Fp); phase_sgu_mfma(Fp, l); } } SEAM(base + 3);
        if (IN(base + 4)) { { ProbMix<0> p{&args, l}; pg8::gemm_phase(F.lds, p, F.G, F.bid); } { ProbMix<1> p{&args, l}; pg8::gemm_phase(F.lds, p, F.G, F.bid); } } SEAM(base + 4);
        if (IN(base + 5)) { ProbMix<2> p{&args, l}; pg8::gemm_phase(F.lds, p, F.G, F.bid); } SEAM(base + 5);
        if (IN(base + 6)) REP(base + 6) { FRESH(Fp); phase_norm2(Fp, l); } SEAM(base + 6);
        if (IN(base + 7)) REP(base + 7) { FRESH(Fp); phase_topk(Fp, l); } SEAM(base + 7);
        if (IN(base + 8)) REP(base + 8) { ProbMoe<0> p{&args, l}; pg8::gemm_phase(F.lds, p, F.G, F.bid); } SEAM(base + 8);
        if (IN(base + 9)) REP(base + 9) { ProbMoe<1> p{&args, l}; pg8::gemm_phase(F.lds, p, F.G, F.bid); } SEAM(base + 9);
    }
    if (IN(21)) { FRESH(Fp); phase_final(Fp); }
#undef IN
#undef SEAM
#undef FRESH
#undef REP
}

#ifndef USE_SSD_SEQ
#define USE_SSD_SEQ 0
#endif
#ifndef MK_ONE_LAUNCH
#define MK_ONE_LAUNCH 1
#endif
#ifndef STOP_AT
#define STOP_AT 99
#endif
__global__ void k_dump(float* o, size_t base, const unsigned char* src, int mode, size_t n) { for (size_t i = (size_t)blockIdx.x * blockDim.x + threadIdx.x; i < n; i += (size_t)gridDim.x * blockDim.x) {
    float v = mode == 0 ? bf2f(((const bf16*)src)[i]) : (mode == 1 ? ((const float*)src)[i] : (float)((const int*)src)[i]); o[base + i] = v; } }
#ifndef DUMP_SET
#define DUMP_SET 0
#endif
__global__ void k_fill(float* o, size_t n) { for (size_t i = (size_t)blockIdx.x * blockDim.x + threadIdx.x; i < n; i += (size_t)gridDim.x * blockDim.x) o[i] = 0.f; }
extern "C" void kernel_launch(void* const* d_in, const int* in_sizes, int n_in, void* d_out, int out_size, void* d_ws, size_t ws_size, hipStream_t stream) {
    static int grid = 0;
    if (grid == 0) {
        if (n_in != 27 || out_size != NLAT * D || ws_size < WS_END) { fprintf(stderr, "kernel_launch: unexpected shapes (n_in %d, out %d, ws %zu < %zu)\n", n_in, out_size, ws_size, (size_t)WS_END); grid = -1; return; }
        int dev = 0, cus = 0;
        if (hipGetDevice(&dev) != hipSuccess || hipDeviceGetAttribute(&cus, hipDeviceAttributeMultiprocessorCount, dev) != hipSuccess) { grid = -1; return; }
        if (hipFuncSetAttribute((const void*)mk_fwd, hipFuncAttributeMaxDynamicSharedMemorySize, LDS_BYTES) != hipSuccess) { grid = -1; return; }
        if (hipFuncSetAttribute((const void*)k_sgu_naive, hipFuncAttributeMaxDynamicSharedMemorySize, 128 * 128 * 4 + 1024) != hipSuccess) { grid = -1; return; }
        (void)hipGetLastError();
        grid = cus;
    }
    if (grid < 0) return;
    (void)hipMemsetAsync((char*)d_ws + WS_CTL, 0, CTL_ZERO_BYTES, stream);
    Args a{};
    for (int i = 0; i < 27; ++i) a.in[i] = (const float*)d_in[i];
    a.out = (float*)d_out; a.ws = (unsigned char*)d_ws;
    auto run = [&](int lo, int hi) { a.ph_lo = lo; a.ph_hi = hi; hipLaunchKernelGGL(mk_fwd, dim3(grid), dim3(512), LDS_BYTES, stream, a); };
#if MK_ONE_LAUNCH
    run(0, NPHASE);
#else
    for (int ph = 0; ph < NPHASE; ++ph) run(ph, ph + 1);
#endif
}
```

```cpp
#include <hip/hip_runtime.h>
#include <cstdio>
#include <cstdint>

#ifndef USE_SSD_SEQ
#define USE_SSD_SEQ 0
#endif
#ifndef REPEAT_PH
#define REPEAT_PH -1
#endif
#define GAS __attribute__((address_space(1)))
#define LAS __attribute__((address_space(3)))
typedef unsigned short bf16;
typedef unsigned v4u __attribute__((ext_vector_type(4)));
typedef unsigned v2u __attribute__((ext_vector_type(2)));
typedef float f32x4 __attribute__((ext_vector_type(4)));
typedef float f32x2 __attribute__((ext_vector_type(2)));
typedef short bf16x8 __attribute__((ext_vector_type(8)));

constexpr int D = 1024, NB = 16, SEQ = 2048, CTXL = 256, NLAT = NB * SEQ, NCTX = NB * CTXL, NROW = NLAT + NCTX;
constexpr int HEADS = 16, HD = 64, NST = 128, NIN = 7200;
constexpr int NEXP = 16, CAP_L = 256, CAP_C = 32;
constexpr float EPS = 1e-6f;
constexpr int PW = 7168, PX = 0, PB = 1024, PC = 1536, PZ = 2048, PU = 3072, PV = 4096, PGA = 5120, PGB = 6144;
constexpr int WIN_ROWS = 7424;
constexpr int NLIST = NB * NEXP * CAP_L + NEXP * NB * CAP_C;
constexpr int LIST_C0 = NB * NEXP * CAP_L;

constexpr size_t MiB = 1u << 20;
constexpr size_t WS_CTL = 0, CTL_ZERO_BYTES = 1 * MiB;
constexpr size_t WS_MOD = 1 * MiB;
constexpr size_t WS_WST = 2 * MiB;
constexpr size_t WS_VSTAT = 2 * MiB + 512 * 1024;
constexpr size_t WS_DT = 3 * MiB;
constexpr size_t WS_AFF = 8 * MiB;
constexpr size_t WS_INV = 11 * MiB;
constexpr size_t WS_IDX = 14 * MiB;
constexpr size_t WS_GATE = 14 * MiB + 512 * 1024;
constexpr size_t WS_WIN = 16 * MiB;
constexpr size_t WS_WMIX = 45 * MiB;
constexpr size_t WS_HC = 57 * MiB;
constexpr size_t WS_XM = 73 * MiB;
constexpr size_t WS_P = 145 * MiB;
constexpr size_t WS_END = 649 * MiB;
constexpr size_t PO_WGU = 0, PO_WD = 64 * MiB, PO_HID = 96 * MiB, PO_YM = 240 * MiB;

typedef __bf16 bf16x2_t __attribute__((ext_vector_type(2)));
__device__ __forceinline__ unsigned pk2(float lo, float hi) { const f32x2 v = {lo, hi}; return __builtin_bit_cast(unsigned, __builtin_convertvector(v, bf16x2_t)); }
__device__ __forceinline__ unsigned f2bf(float f) { return pk2(f, 0.f) & 0xffffu; }
__device__ __forceinline__ float bflo(unsigned w) { return __builtin_bit_cast(float, w << 16); }
__device__ __forceinline__ float bfhi(unsigned w) { return __builtin_bit_cast(float, w & 0xffff0000u); }
__device__ __forceinline__ float bf2f(bf16 b) { return __builtin_bit_cast(float, ((unsigned)b) << 16); }
__device__ __forceinline__ float rcpf_(float x) { return __builtin_amdgcn_rcpf(x); }
__device__ __forceinline__ float sigmoidf_(float x) { return rcpf_(1.0f + __expf(-x)); }
__device__ __forceinline__ float siluf_(float x) { return x * rcpf_(1.0f + __expf(-x)); }
__device__ __forceinline__ float gelu_tanh(float x) { const float u = 1.5957691216057308f * (x + 0.044715f * x * x * x); return x * rcpf_(1.0f + __expf(-u)); }
__device__ __forceinline__ float softplusf_(float x) { return fmaxf(x, 0.f) + log1pf(__expf(-fabsf(x))); }
__device__ __forceinline__ float wave_sum(float v) {
#pragma unroll
    for (int o = 1; o < 64; o <<= 1) v += __shfl_xor(v, o);
    return v;
}
__device__ __forceinline__ v2u pack4(f32x4 v) { v2u r; r.x = pk2(v.x, v.y); r.y = pk2(v.z, v.w); return r; }
__device__ __forceinline__ f32x4 unpack4(v2u w) { return (f32x4){bflo(w.x), bfhi(w.x), bflo(w.y), bfhi(w.y)}; }

struct Args { const float* in[27]; float* out; unsigned char* ws; int ph_lo, ph_hi; };
enum { I_X = 0, I_C, I_CTX, I_CCTX, I_ADAW, I_ADAB, I_N1W, I_N2W, I_WIN, I_CONVW, I_CONVB, I_DTB, I_ALOG, I_DSKIP, I_SSDNW, I_LNW, I_LNB, I_WS, I_BS, I_WPA, I_WPB, I_WO, I_RW, I_WG, I_WU, I_WD, I_FNW };

struct Frame {
    LAS unsigned char* lds; int tid, lane, wave, nw, G, bid;
    const Args* a;
};
__device__ __forceinline__ const float* modp(const Args& a, int l, int br) { return (const float*)(a.ws + WS_MOD) + (size_t)(l * 17 + br) * 6144; }
__device__ __forceinline__ int batch_row(int r) { return r < NLAT ? (r >> 11) : 16; }

struct Unit { const bf16* A; const bf16* B; const int* gidx; int lda, a_row0, pm, pn, aux; };

struct ProbIn {      static constexpr bool GATHER = false, NOSCHED = true;
    const Args* a; int l; int noepi = 0;
    __device__ int nunits() const { return l == 0 ? 144 * 29 : 128 * 29 + 16 * 9; }
    __device__ void unit(int L, Unit& u) const {
        int pm, pn;
        const int nfull = (l == 0 ? 144 : 128), nun = nunits();
        const int wg = (L & 7) * (nun >> 3) + (L >> 3);
        if (wg < nfull * 29) { const int grp = wg / (8 * 29), w = wg % (8 * 29); pm = grp * 8 + (w & 7); pn = w >> 3; }
        else { const int w = wg - nfull * 29, g2 = w / 72, w2 = w % 72; pm = 128 + g2 * 8 + (w2 & 7); const int q = w2 >> 3; pn = q < 8 ? q : 28; }
        u.A = (const bf16*)(a->ws + WS_XM); u.lda = D; u.a_row0 = pm * 256; u.gidx = nullptr; u.pm = pm; u.pn = pn; u.aux = 0;
        u.B = (const bf16*)(a->ws + WS_WIN) + ((size_t)l * WIN_ROWS + (size_t)pn * 256) * D;
    }
    struct Pre { int dummy; };
    __device__ __forceinline__ Pre pre(const Unit&, int, int) const { return Pre{0}; }
    __device__ __forceinline__ void epi(const Unit& u, int r, int c, f32x4 lo0, f32x4 lo1, f32x4 hi0, f32x4 hi1, const Pre&) const {
        if (noepi) return;
        const int row = u.pm * 256 + r, pn = u.pn;
        if (pn == 28) {
            if (c < 32) { float* dt = (float*)(a->ws + WS_DT) + (size_t)row * 32 + c; const float* db = a->in[I_DTB] + l * 32 + c;
                f32x4 o0, o1;
#pragma unroll
                for (int i = 0; i < 4; ++i) { o0[i] = softplusf_(lo0[i] + db[i]); o1[i] = softplusf_(lo1[i] + db[4 + i]); }
                *(f32x4*)dt = o0; *(f32x4*)(dt + 4) = o1; }
            return;
        }
        if (pn >= 8 && pn < 12) {
#pragma unroll
            for (int i = 0; i < 4; ++i) { lo0[i] = siluf_(lo0[i]); lo1[i] = siluf_(lo1[i]); hi0[i] = siluf_(hi0[i]); hi1[i] = siluf_(hi1[i]); } }
        else if (pn >= 12 && pn < 20) {
#pragma unroll
            for (int i = 0; i < 4; ++i) { lo0[i] = gelu_tanh(lo0[i]); lo1[i] = gelu_tanh(lo1[i]); hi0[i] = gelu_tanh(hi0[i]); hi1[i] = gelu_tanh(hi1[i]); } }
        else if (pn >= 20) {
#pragma unroll
            for (int i = 0; i < 4; ++i) { lo0[i] = sigmoidf_(lo0[i]); lo1[i] = sigmoidf_(lo1[i]); hi0[i] = sigmoidf_(hi0[i]); hi1[i] = sigmoidf_(hi1[i]); } }
        bf16* o = (bf16*)(a->ws + WS_P) + (size_t)row * PW + pn * 256 + c;
        v4u w; w.x = pk2(lo0[0], lo0[1]); w.y = pk2(lo0[2], lo0[3]); w.z = pk2(lo1[0], lo1[1]); w.w = pk2(lo1[2], lo1[3]); *(v4u*)o = w;
        w.x = pk2(hi0[0], hi0[1]); w.y = pk2(hi0[2], hi0[3]); w.z = pk2(hi1[0], hi1[1]); w.w = pk2(hi1[2], hi1[3]); *(v4u*)(o + 128) = w;
    }
};

template <int MODE> struct ProbMix {
    static constexpr bool GATHER = false, NOSCHED = true;
    const Args* a; int l;
    __device__ int nunits() const { return (l == 0 ? 144 : 128) * 4; }
    __device__ void unit(int L, Unit& u) const {
        const int wg = (L & 7) * (nunits() >> 3) + (L >> 3);
        const int grp = wg / 32, w = wg % 32; const int pm = grp * 8 + (w & 7), pn = w >> 3;
        u.pm = pm; u.pn = pn; u.aux = 0; u.gidx = nullptr; u.a_row0 = pm * 256;
        if (MODE == 0) { u.A = (const bf16*)(a->ws + WS_P) + PZ; u.lda = PW; }
        else if (MODE == 1) { u.A = (const bf16*)(a->ws + WS_P) + PU; u.lda = PW; }
        else { u.A = (const bf16*)(a->ws + WS_XM); u.lda = D; }
        u.B = (const bf16*)(a->ws + WS_WMIX) + ((size_t)(l * 3 + MODE) * D + (size_t)pn * 256) * D;
    }
    struct Pre { v4u q0, q1, q2, q3; f32x4 f0, f1, f2, f3, g0, g1, g2, g3; };
    __device__ __forceinline__ Pre pre(const Unit& u, int r, int c) const {
        const int row = u.pm * 256 + r, col = u.pn * 256 + c; Pre p;
        if (MODE == 0) { const bf16* g = (const bf16*)(a->ws + WS_P) + (size_t)row * PW + PGA + col; p.q0 = *(const v4u*)g; p.q1 = *(const v4u*)(g + 128); }
        else if (MODE == 1) { const bf16* t = (const bf16*)(a->ws + WS_P) + (size_t)row * PW + PGA + col; const bf16* g = t + (PGB - PGA);
            p.q0 = *(const v4u*)t; p.q1 = *(const v4u*)(t + 128); p.q2 = *(const v4u*)g; p.q3 = *(const v4u*)(g + 128); }
        else { const bool lat = row < NLAT;
            const float* hin = ((l == 0) ? (lat ? a->in[I_X] + (size_t)row * D : a->in[I_CTX] + (size_t)(row - NLAT) * D) : (lat ? a->out + (size_t)row * D : (const float*)(a->ws + WS_HC) + (size_t)(row - NLAT) * D)) + col;
            const float* g1 = modp(*a, l, batch_row(row)) + 2048 + col;
            p.f0 = *(const f32x4*)hin; p.f1 = *(const f32x4*)(hin + 4); p.f2 = *(const f32x4*)(hin + 128); p.f3 = *(const f32x4*)(hin + 132);
            p.g0 = *(const f32x4*)g1; p.g1 = *(const f32x4*)(g1 + 4); p.g2 = *(const f32x4*)(g1 + 128); p.g3 = *(const f32x4*)(g1 + 132); }
        return p;
    }
    __device__ __forceinline__ void epi(const Unit& u, int r, int c, f32x4 lo0, f32x4 lo1, f32x4 hi0, f32x4 hi1, const Pre& p) const {
        const int row = u.pm * 256 + r, col = u.pn * 256 + c;
        if (MODE == 0) {
            bf16* g = (bf16*)(a->ws + WS_P) + (size_t)row * PW + PGA + col;
            const v4u gl = p.q0, gh = p.q1; v4u w;
            w.x = pk2(bflo(gl.x) * lo0[0], bfhi(gl.x) * lo0[1]); w.y = pk2(bflo(gl.y) * lo0[2], bfhi(gl.y) * lo0[3]); w.z = pk2(bflo(gl.z) * lo1[0], bfhi(gl.z) * lo1[1]); w.w = pk2(bflo(gl.w) * lo1[2], bfhi(gl.w) * lo1[3]); *(v4u*)g = w;
            w.x = pk2(bflo(gh.x) * hi0[0], bfhi(gh.x) * hi0[1]); w.y = pk2(bflo(gh.y) * hi0[2], bfhi(gh.y) * hi0[3]); w.z = pk2(bflo(gh.z) * hi1[0], bfhi(gh.z) * hi1[1]); w.w = pk2(bflo(gh.w) * hi1[2], bfhi(gh.w) * hi1[3]); *(v4u*)(g + 128) = w;
        } else if (MODE == 1) {
            bf16* o = (bf16*)(a->ws + WS_XM) + (size_t)row * D + col;
            const v4u tl = p.q0, th = p.q1, gl = p.q2, gh = p.q3; v4u w;
            w.x = pk2(bflo(tl.x) + bflo(gl.x) * lo0[0], bfhi(tl.x) + bfhi(gl.x) * lo0[1]); w.y = pk2(bflo(tl.y) + bflo(gl.y) * lo0[2], bfhi(tl.y) + bfhi(gl.y) * lo0[3]);
            w.z = pk2(bflo(tl.z) + bflo(gl.z) * lo1[0], bfhi(tl.z) + bfhi(gl.z) * lo1[1]); w.w = pk2(bflo(tl.w) + bflo(gl.w) * lo1[2], bfhi(tl.w) + bfhi(gl.w) * lo1[3]); *(v4u*)o = w;
            w.x = pk2(bflo(th.x) + bflo(gh.x) * hi0[0], bfhi(th.x) + bfhi(gh.x) * hi0[1]); w.y = pk2(bflo(th.y) + bflo(gh.y) * hi0[2], bfhi(th.y) + bfhi(gh.y) * hi0[3]);
            w.z = pk2(bflo(th.z) + bflo(gh.z) * hi1[0], bfhi(th.z) + bfhi(gh.z) * hi1[1]); w.w = pk2(bflo(th.w) + bflo(gh.w) * hi1[2], bfhi(th.w) + bfhi(gh.w) * hi1[3]); *(v4u*)(o + 128) = w;
        } else {
            const bool lat = row < NLAT;
            float* hout = (lat ? a->out + (size_t)row * D : (float*)(a->ws + WS_HC) + (size_t)(row - NLAT) * D) + col;
            *(f32x4*)hout = p.f0 + p.g0 * lo0; *(f32x4*)(hout + 4) = p.f1 + p.g1 * lo1; *(f32x4*)(hout + 128) = p.f2 + p.g2 * hi0; *(f32x4*)(hout + 132) = p.f3 + p.g3 * hi1;
        }
    }
};

template <int MODE> struct ProbMoe {
    static constexpr bool GATHER = (MODE == 0), NOSCHED = true;
    const Args* a; int l;
    __device__ int nunits() const { const int per = MODE == 0 ? 8 : 4; return (256 + (l == 0 ? 32 : 0)) * per; }
    __device__ void unit(int L, Unit& u) const {
        constexpr int per = MODE == 0 ? 8 : 4;
        const int x = L & 7, off = L >> 3;
        int pn, t;
        if (off < 32 * per) { const int e = 2 * x + off / (16 * per), r = off % (16 * per); t = (r / per) * 16 + e; pn = r % per; }
        else { const int o = off - 32 * per; t = 256 + 4 * x + o / per; pn = o % per; }
        const int e = t < 256 ? (t & 15) : ((t - 256) >> 1);
        const int list0 = t < 256 ? t * 256 : LIST_C0 + (t - 256) * 256;
        u.pm = t; u.pn = pn; u.aux = list0;
        if (MODE == 0) { u.A = (const bf16*)(a->ws + WS_XM); u.lda = D; u.a_row0 = 0; u.gidx = (const int*)(a->ws + WS_IDX) + list0;
            u.B = (const bf16*)(a->ws + WS_P + PO_WGU) + ((size_t)e * 2048 + (size_t)pn * 256) * D; }
        else { u.A = (const bf16*)(a->ws + WS_P + PO_HID); u.lda = D; u.a_row0 = list0; u.gidx = nullptr;
            u.B = (const bf16*)(a->ws + WS_P + PO_WD) + ((size_t)e * 1024 + (size_t)pn * 256) * D; }
    }
    struct Pre { float gt; };
    __device__ __forceinline__ Pre pre(const Unit& u, int r, int) const { Pre p; p.gt = MODE == 1 ? ((const float*)(a->ws + WS_GATE))[(size_t)u.aux + r] : 0.f; return p; }
    __device__ __forceinline__ void epi(const Unit& u, int r, int c, f32x4 lo0, f32x4 lo1, f32x4 hi0, f32x4 hi1, const Pre& pr) const {
        const size_t hrow = (size_t)u.aux + r;
        if (MODE == 0) {
            bf16* o = (bf16*)(a->ws + WS_P + PO_HID) + hrow * D + u.pn * 128 + c;
            v4u w; w.x = pk2(siluf_(lo0[0]) * hi0[0], siluf_(lo0[1]) * hi0[1]); w.y = pk2(siluf_(lo0[2]) * hi0[2], siluf_(lo0[3]) * hi0[3]);
            w.z = pk2(siluf_(lo1[0]) * hi1[0], siluf_(lo1[1]) * hi1[1]); w.w = pk2(siluf_(lo1[2]) * hi1[2], siluf_(lo1[3]) * hi1[3]); *(v4u*)o = w;
        } else {
            const float gt = pr.gt;
            bf16* o = (bf16*)(a->ws + WS_P + PO_YM) + hrow * D + u.pn * 256 + c;
            v4u w; w.x = pk2(gt * lo0[0], gt * lo0[1]); w.y = pk2(gt * lo0[2], gt * lo0[3]); w.z = pk2(gt * lo1[0], gt * lo1[1]); w.w = pk2(gt * lo1[2], gt * lo1[3]); *(v4u*)o = w;
            w.x = pk2(gt * hi0[0], gt * hi0[1]); w.y = pk2(gt * hi0[2], gt * hi0[3]); w.z = pk2(gt * hi1[0], gt * hi1[1]); w.w = pk2(gt * hi1[2], gt * hi1[3]); *(v4u*)(o + 128) = w;
        }
    }
};


namespace pg8 {
constexpr int BM = 256, BK = 64, HALF = 128, HTB = HALF * BK * 2, STAGE_BYTES = 8 * HTB;
__device__ __forceinline__ int lds_byte(int r, int c) { const int st = (r >> 4) * 2 + (c >> 5), rr = r & 15, cc = c & 31, ob = rr * 64 + cc * 2; return st * 1024 + (ob ^ (((ob >> 9) & 1) << 5)); }
__device__ __forceinline__ void stage_rc(int b, int& R, int& C) { const int st = b / 1024, sb = b % 1024, swz = sb ^ (((sb >> 9) & 1) << 5); R = (st >> 1) * 16 + swz / 64; C = (st & 1) * 32 + (swz % 64) / 2; }
__device__ __forceinline__ int perm32(int rho) { const int n = rho >> 4, i = rho & 15; return 8 * (i >> 2) + 4 * n + (i & 3); }

template <bool GATHER> __device__ __forceinline__ void unit_voffA(const Unit& u, int tid, unsigned (&vo)[4]) {
#pragma unroll
    for (int h = 0; h < 2; ++h)
#pragma unroll
        for (int i = 0; i < 2; ++i) { int R, C; stage_rc(tid * 16 + i * 8192, R, C); const int r = h * HALF + R;
            if (GATHER) { int row = u.gidx[r]; row = (unsigned)row < (unsigned)NROW ? row : 0; vo[h * 2 + i] = ((unsigned)row * (unsigned)u.lda + (unsigned)C) * 2u; }
            else vo[h * 2 + i] = ((unsigned)r * (unsigned)u.lda + (unsigned)C) * 2u; }
}

__device__ __forceinline__ __amdgpu_buffer_rsrc_t mk_rsrc(const char* p) {
    const unsigned long long v = (unsigned long long)p;
    const unsigned lo = __builtin_amdgcn_readfirstlane((unsigned)v), hi = __builtin_amdgcn_readfirstlane((unsigned)(v >> 32));
    return __builtin_amdgcn_make_buffer_rsrc((void*)(((unsigned long long)hi << 32) | lo), 0, 0x7fffffff, 0x00020000);
}

template <class Prob>
__device__ __forceinline__ void gemm_phase(LAS unsigned char* lds, const Prob& prob, int G, int bid) {
    constexpr bool GATHER = Prob::GATHER;
    int tid_ = threadIdx.x; asm volatile("" : "+v"(tid_));
    const int tid = tid_, wid = __builtin_amdgcn_readfirstlane(tid >> 6), lane = tid & 63, wr = wid >> 2, wc = wid & 3, fr = lane & 15, fq = lane >> 4;
    constexpr int K = 1024, nt = K / BK;
    unsigned voffB[2];
#pragma unroll
    for (int i = 0; i < 2; ++i) { int R, C; stage_rc(tid * 16 + i * 8192, R, C); const int Rb = (R & ~31) + perm32(R & 31); voffB[i] = (unsigned)(Rb * K + C) * 2u; }
    constexpr int kstep = BK * 2;
    constexpr int hstep = HALF * K * 2;
    const unsigned ldsw = (unsigned)wid * 1024u;
    const int aoff = lds_byte(wr * 64 + fr, fq * 8), boff = lds_byte(wc * 32 + fr, fq * 8);
#define PG8_SA(b, h) (((b) * 2 + (h)) * HTB)
#define PG8_SB(b, h) ((4 + (b) * 2 + (h)) * HTB)
#define PG8_STAGE2(bufoff, rsrc, v0, v1, soff) do { \
        __builtin_amdgcn_raw_ptr_buffer_load_lds(rsrc, (LAS unsigned*)(lds + (bufoff) + ldsw), 16, (int)(v0), (int)(soff), 0, 0); \
        __builtin_amdgcn_raw_ptr_buffer_load_lds(rsrc, (LAS unsigned*)(lds + (bufoff) + ldsw + 8192), 16, (int)(v1), (int)(soff), 0, 0); } while (0)
#define PG8_STAGEB(bufoff, rsrc, soff) PG8_STAGE2(bufoff, rsrc, voffB[0], voffB[1], soff)
#define PG8_LDA(dst, b, h) do { _Pragma("unroll") for (int m = 0; m < 4; ++m) _Pragma("unroll") for (int k = 0; k < 2; ++k) dst[m][k] = *(const LAS bf16x8*)(lds + PG8_SA(b, h) + aoff + m * 2048 + k * 1024); } while (0)
#define PG8_LDB(dst, b, h) do { _Pragma("unroll") for (int n = 0; n < 2; ++n) _Pragma("unroll") for (int k = 0; k < 2; ++k) dst[n][k] = *(const LAS bf16x8*)(lds + PG8_SB(b, h) + boff + n * 2048 + k * 1024); } while (0)
#define PG8_MMA(ai, bj, At, Bt) do { __builtin_amdgcn_s_setprio(1); _Pragma("unroll") for (int m = 0; m < 4; ++m) _Pragma("unroll") for (int n = 0; n < 2; ++n) _Pragma("unroll") for (int k = 0; k < 2; ++k) \
        acc[ai][bj][m][n] = __builtin_amdgcn_mfma_f32_16x16x32_bf16(Bt[n][k], At[m][k], acc[ai][bj][m][n], 0, 0, 0); __builtin_amdgcn_s_setprio(0); } while (0)
#define PG8_WAIT_V(n) asm volatile("s_waitcnt vmcnt(" #n ")" ::: "memory")
#define PG8_WAIT_L(n) asm volatile("s_waitcnt lgkmcnt(" #n ")" ::: "memory")
#define PG8_BAR __builtin_amdgcn_s_barrier()
#define PG8_SCHED __builtin_amdgcn_sched_barrier(0)
    const int nun = prob.nunits();
    int L = bid;
    if (L >= nun) return;
    Unit cur, nxt; prob.unit(L, cur);
    unsigned voA[4], nvoA[4];
    unit_voffA<GATHER>(cur, tid, voA);
    const char* cA = (const char*)cur.A + (GATHER ? (size_t)0 : (size_t)cur.a_row0 * cur.lda * 2); const char* cB = (const char*)cur.B;
    {
        const __amdgpu_buffer_rsrc_t rA = mk_rsrc(cA), rB = mk_rsrc(cB);
        PG8_STAGEB(PG8_SB(0, 0), rB, 0); PG8_STAGEB(PG8_SB(0, 1), rB, hstep); PG8_STAGE2(PG8_SA(0, 0), rA, voA[0], voA[1], 0); PG8_STAGE2(PG8_SA(0, 1), rA, voA[2], voA[3], 0);
        if (wr == 1) PG8_BAR;
        PG8_WAIT_V(2); PG8_BAR;
        PG8_STAGEB(PG8_SB(1, 0), rB, kstep); PG8_STAGE2(PG8_SA(1, 0), rA, voA[0], voA[1], kstep); PG8_STAGEB(PG8_SB(1, 1), rB, hstep + kstep);
        PG8_WAIT_V(6); PG8_BAR; PG8_SCHED;
    }
    f32x4 acc[2][2][4][2];
#pragma unroll
    for (int a = 0; a < 2; ++a)
#pragma unroll
        for (int b = 0; b < 2; ++b)
#pragma unroll
            for (int m = 0; m < 4; ++m)
#pragma unroll
                for (int n = 0; n < 2; ++n) acc[a][b][m][n] = (f32x4){0.f, 0.f, 0.f, 0.f};
    bf16x8 At[4][2], B0[2][2], B1[2][2];
    for (;;) {
        const bool has_next = (L + G < nun);
        const char* nA = cA; const char* nB = cB;
#pragma unroll
        for (int i = 0; i < 4; ++i) nvoA[i] = voA[i];
        if (has_next) { prob.unit(L + G, nxt); if (GATHER) unit_voffA<GATHER>(nxt, tid, nvoA); nA = (const char*)nxt.A + (GATHER ? (size_t)0 : (size_t)nxt.a_row0 * nxt.lda * 2); nB = (const char*)nxt.B; }
        const __amdgpu_buffer_rsrc_t rA1 = mk_rsrc(cA);
        for (int t = 0; t < nt; t += 2) {
            const bool last = (t == nt - 2);
            const __amdgpu_buffer_rsrc_t rA2 = mk_rsrc(last ? nA : cA), rB2 = mk_rsrc(last ? nB : cB);
            const int o1 = (t + 1) * kstep, o2 = last ? 0 : (t + 2) * kstep, o3 = o2 + kstep;
            const unsigned s0 = (GATHER && last) ? nvoA[0] : voA[0], s1 = (GATHER && last) ? nvoA[1] : voA[1], s2 = (GATHER && last) ? nvoA[2] : voA[2], s3 = (GATHER && last) ? nvoA[3] : voA[3];
            PG8_LDB(B0, 0, 0); PG8_LDB(B1, 0, 1); PG8_SCHED; PG8_LDA(At, 0, 0); PG8_STAGE2(PG8_SA(1, 1), rA1, voA[2], voA[3], o1);
            PG8_WAIT_V(8); PG8_WAIT_L(0); PG8_BAR; PG8_MMA(0, 0, At, B0); PG8_MMA(0, 1, At, B1); PG8_BAR; PG8_SCHED;
            PG8_LDA(At, 0, 1); PG8_STAGEB(PG8_SB(0, 0), rB2, o2); PG8_STAGEB(PG8_SB(0, 1), rB2, o2 + hstep); PG8_STAGE2(PG8_SA(0, 0), rA2, s0, s1, o2);
            PG8_WAIT_V(8); PG8_WAIT_L(0); PG8_BAR; PG8_MMA(1, 0, At, B0); PG8_MMA(1, 1, At, B1); PG8_BAR; PG8_SCHED;
            PG8_LDB(B0, 1, 0); PG8_LDB(B1, 1, 1); PG8_SCHED; PG8_LDA(At, 1, 0); PG8_STAGE2(PG8_SA(0, 1), rA2, s2, s3, o2);
            PG8_WAIT_V(8); PG8_WAIT_L(0); PG8_BAR; PG8_MMA(0, 0, At, B0); PG8_MMA(0, 1, At, B1); PG8_BAR; PG8_SCHED;
            PG8_LDA(At, 1, 1); PG8_STAGEB(PG8_SB(1, 0), rB2, o3); PG8_STAGEB(PG8_SB(1, 1), rB2, o3 + hstep); PG8_STAGE2(PG8_SA(1, 0), rA2, s0, s1, o3);
            PG8_WAIT_V(8); PG8_WAIT_L(0); PG8_BAR; PG8_MMA(1, 0, At, B0); PG8_MMA(1, 1, At, B1); PG8_BAR; PG8_SCHED;
        }
        if (wr == 0) PG8_BAR;
        {
            typename Prob::Pre pcur = prob.pre(cur, wr * 64 + fr, wc * 32 + fq * 8);
#pragma unroll
            for (int q = 0; q < 8; ++q) { const int ai = q >> 2, m = q & 3, r = ai * HALF + wr * 64 + m * 16 + fr, qn = q < 7 ? q + 1 : 7, rn = (qn >> 2) * HALF + wr * 64 + (qn & 3) * 16 + fr;
                const typename Prob::Pre pnext = prob.pre(cur, rn, wc * 32 + fq * 8);
                prob.epi(cur, r, wc * 32 + fq * 8, acc[ai][0][m][0], acc[ai][0][m][1], acc[ai][1][m][0], acc[ai][1][m][1], pcur); if (Prob::GATHER || true) { if (!Prob::NOSCHED) PG8_SCHED; }
                pcur = pnext; }
        }
        if (!has_next) break;
#pragma unroll
        for (int a = 0; a < 2; ++a)
#pragma unroll
            for (int b = 0; b < 2; ++b)
#pragma unroll
                for (int m = 0; m < 4; ++m)
#pragma unroll
                    for (int n = 0; n < 2; ++n) acc[a][b][m][n] = (f32x4){0.f, 0.f, 0.f, 0.f};
        cur = nxt; cA = nA; cB = nB; L += G;
#pragma unroll
        for (int i = 0; i < 4; ++i) voA[i] = nvoA[i];
        if (wr == 1) PG8_BAR;
    }
    PG8_WAIT_V(0);
    PG8_BAR;
#undef PG8_SA
#undef PG8_SB
#undef PG8_STAGE2
#undef PG8_STAGEB
#undef PG8_LDA
#undef PG8_LDB
#undef PG8_MMA
#undef PG8_WAIT_V
#undef PG8_WAIT_L
#undef PG8_BAR
#undef PG8_SCHED
}
}

template <class P> __global__ void __launch_bounds__(256) k_gemm_simple(Args args, int layer) {
    __shared__ float As[32][68]; __shared__ float Bs[32][260];
    P prob{&args, layer};
    const int L = blockIdx.x >> 2, rb = blockIdx.x & 3, tid = threadIdx.x, ty = tid >> 4, tx = tid & 15;
    if (L >= prob.nunits()) return;
    Unit u; prob.unit(L, u);
    const int ar = tid >> 2, aq = tid & 3;
    int arow = u.gidx ? u.gidx[rb * 64 + ar] : (u.a_row0 + rb * 64 + ar);
    arow = arow < 0 ? 0 : (arow >= NROW + NLIST ? 0 : arow);
    const bf16* ap = u.A + (size_t)arow * u.lda + aq * 8;
    float acc[2][4][8];
#pragma unroll
    for (int h = 0; h < 2; ++h)
#pragma unroll
        for (int i = 0; i < 4; ++i)
#pragma unroll
            for (int j = 0; j < 8; ++j) acc[h][i][j] = 0.f;
    for (int k0 = 0; k0 < D; k0 += 32) {
        v4u av = *(const v4u*)(ap + k0); v4u bv[4];
#pragma unroll
        for (int j = 0; j < 4; ++j) { const int p = tid + 256 * j; bv[j] = *(const v4u*)(u.B + (size_t)(p >> 2) * D + k0 + (p & 3) * 8); }
        __syncthreads();
        { const int kk = aq * 8; As[kk + 0][ar] = bflo(av.x); As[kk + 1][ar] = bfhi(av.x); As[kk + 2][ar] = bflo(av.y); As[kk + 3][ar] = bfhi(av.y); As[kk + 4][ar] = bflo(av.z); As[kk + 5][ar] = bfhi(av.z); As[kk + 6][ar] = bflo(av.w); As[kk + 7][ar] = bfhi(av.w); }
#pragma unroll
        for (int j = 0; j < 4; ++j) { const int p = tid + 256 * j, br = p >> 2, kk = (p & 3) * 8; Bs[kk + 0][br] = bflo(bv[j].x); Bs[kk + 1][br] = bfhi(bv[j].x); Bs[kk + 2][br] = bflo(bv[j].y); Bs[kk + 3][br] = bfhi(bv[j].y);
            Bs[kk + 4][br] = bflo(bv[j].z); Bs[kk + 5][br] = bfhi(bv[j].z); Bs[kk + 6][br] = bflo(bv[j].w); Bs[kk + 7][br] = bfhi(bv[j].w); }
        __syncthreads();
#pragma unroll 4
        for (int k = 0; k < 32; ++k) {
            const f32x4 a4 = *(const f32x4*)&As[k][ty * 4];
            const f32x4 b0 = *(const f32x4*)&Bs[k][tx * 8], b1 = *(const f32x4*)&Bs[k][tx * 8 + 4], b2 = *(const f32x4*)&Bs[k][128 + tx * 8], b3 = *(const f32x4*)&Bs[k][128 + tx * 8 + 4];
#pragma unroll
            for (int i = 0; i < 4; ++i)
#pragma unroll
                for (int j = 0; j < 4; ++j) { acc[0][i][j] += a4[i] * b0[j]; acc[0][i][4 + j] += a4[i] * b1[j]; acc[1][i][j] += a4[i] * b2[j]; acc[1][i][4 + j] += a4[i] * b3[j]; }
        }
    }
#pragma unroll
    for (int i = 0; i < 4; ++i)
        prob.epi(u, rb * 64 + ty * 4 + i, tx * 8, (f32x4){acc[0][i][0], acc[0][i][1], acc[0][i][2], acc[0][i][3]}, (f32x4){acc[0][i][4], acc[0][i][5], acc[0][i][6], acc[0][i][7]},
                 (f32x4){acc[1][i][0], acc[1][i][1], acc[1][i][2], acc[1][i][3]}, (f32x4){acc[1][i][4], acc[1][i][5], acc[1][i][6], acc[1][i][7]}, prob.pre(u, rb * 64 + ty * 4 + i, tx * 8));
}

__global__ void __launch_bounds__(256) k_ssd_naive(Args args, int l) {
    __shared__ float xs[32][64]; __shared__ float Bsm[32][128]; __shared__ float Csm[32][128]; __shared__ float dts[32];
    const int b = blockIdx.x >> 4, h = blockIdx.x & 15, g = h >> 2, tid = threadIdx.x, p = tid >> 2, nq = tid & 3;
    const bf16* P = (const bf16*)(args.ws + WS_P); bf16* Y = (bf16*)(args.ws + WS_XM); const float* DT = (const float*)(args.ws + WS_DT);
    const float* cw = args.in[I_CONVW] + (size_t)l * 3 * 2048; const float* cb = args.in[I_CONVB] + (size_t)l * 2048;
    const float dskip = args.in[I_DSKIP][l * 16 + h];
    for (int dir = 0; dir < 2; ++dir) {
        float st[32];
#pragma unroll
        for (int i = 0; i < 32; ++i) st[i] = 0.f;
        const float Ah = -__expf(args.in[I_ALOG][(l * 2 + dir) * 16 + h]);
        for (int seg = 0; seg < 2; ++seg) {
            const int base = seg == 0 ? NLAT + b * CTXL : b * SEQ, len = seg == 0 ? CTXL : SEQ;
            const bool wy = !(l == 1 && seg == 0);
            for (int blk = 0; blk < len / 32; ++blk) {
                for (int idx = tid; idx < 32 * 320; idx += 256) {
                    const int tt = idx / 320, ch = idx % 320;
                    const int tok = dir == 0 ? blk * 32 + tt : len - 1 - (blk * 32 + tt);
                    const int col = ch < 64 ? PX + h * 64 + ch : (ch < 192 ? PB + g * 128 + (ch - 64) : PC + g * 128 + (ch - 192));
                    const bf16* pp = P + (size_t)(base + tok) * PW + col;
                    const float cur = bf2f(pp[0]), prv = tok > 0 ? bf2f(pp[-PW]) : 0.f, nxt = tok < len - 1 ? bf2f(pp[PW]) : 0.f;
                    const float v = siluf_(cw[col] * prv + cw[2048 + col] * cur + cw[4096 + col] * nxt + cb[col]);
                    if (ch < 64) xs[tt][ch] = v; else if (ch < 192) Bsm[tt][ch - 64] = v; else Csm[tt][ch - 192] = v;
                }
                if (tid < 32) { const int tok = dir == 0 ? blk * 32 + tid : len - 1 - (blk * 32 + tid); dts[tid] = DT[(size_t)(base + tok) * 32 + dir * 16 + h]; }
                __syncthreads();
                for (int tt = 0; tt < 32; ++tt) {
                    const float dt = dts[tt], dA = __expf(dt * Ah), xr = xs[tt][p], xv = xr * dt;
                    float ys = 0.f;
#pragma unroll
                    for (int i = 0; i < 32; ++i) { const int n = nq * 32 + i; st[i] = st[i] * dA + xv * Bsm[tt][n]; ys += st[i] * Csm[tt][n]; }
                    ys += __shfl_xor(ys, 1); ys += __shfl_xor(ys, 2);
                    if (nq == 0 && wy) { const int tok = dir == 0 ? blk * 32 + tt : len - 1 - (blk * 32 + tt); bf16* yp = Y + (size_t)(base + tok) * D + h * 64 + p;
                        if (dir == 0) *yp = (bf16)f2bf(ys + dskip * xr); else *yp = (bf16)f2bf(bf2f(*yp) + ys); }
                }
                __syncthreads();
            }
        }
    }
}

__global__ void __launch_bounds__(512) k_sgu_naive(Args args, int l) {
    extern __shared__ __attribute__((aligned(16))) unsigned char smem[];
    float* Vn = (float*)smem; float* mu = Vn + 128 * 128; float* rs = mu + 128;
    const int chunk = blockIdx.x >> 3, g = blockIdx.x & 7, tid = threadIdx.x, lane = tid & 63, wave = tid >> 6;
    const int row0 = chunk < 256 ? chunk * 128 : NLAT + (chunk - 256) * 128;
    bf16* P = (bf16*)(args.ws + WS_P);
    for (int rr = 0; rr < 16; ++rr) { const int j = wave * 16 + rr; const bf16* vp = P + (size_t)(row0 + j) * PW + PV;
        float v[16]; float s = 0.f;
#pragma unroll
        for (int q = 0; q < 2; ++q) { const v4u w = *(const v4u*)(vp + lane * 8 + 512 * q); v[q * 8 + 0] = bflo(w.x); v[q * 8 + 1] = bfhi(w.x); v[q * 8 + 2] = bflo(w.y); v[q * 8 + 3] = bfhi(w.y); v[q * 8 + 4] = bflo(w.z); v[q * 8 + 5] = bfhi(w.z); v[q * 8 + 6] = bflo(w.w); v[q * 8 + 7] = bfhi(w.w); }
#pragma unroll
        for (int i = 0; i < 16; ++i) s += v[i];
        const float m = wave_sum(s) * (1.f / D); float s2 = 0.f;
#pragma unroll
        for (int i = 0; i < 16; ++i) { const float d = v[i] - m; s2 += d * d; }
        const float var = wave_sum(s2) * (1.f / D);
        if (lane == 0) { mu[j] = m; rs[j] = rsqrtf(var + EPS); } }
    __syncthreads();
    const float* lnw = args.in[I_LNW] + l * D + g * 128; const float* lnb = args.in[I_LNB] + l * D + g * 128;
    for (int idx = tid; idx < 128 * 128; idx += 512) { const int j = idx >> 7, d = idx & 127; Vn[idx] = (bf2f(P[(size_t)(row0 + j) * PW + PV + g * 128 + d]) - mu[j]) * rs[j] * lnw[d] + lnb[d]; }
    __syncthreads();
    const float* Wsg = args.in[I_WS] + ((size_t)(l * 8 + g) * 128) * 128; const float* bsg = args.in[I_BS] + (l * 8 + g) * 128;
    for (int idx = tid; idx < 128 * 128; idx += 512) { const int i = idx >> 7, d = idx & 127; float s = 0.f;
        for (int j = 0; j < 128; ++j) s += Wsg[i * 128 + j] * Vn[j * 128 + d];
        bf16* up = P + (size_t)(row0 + i) * PW + PU + g * 128 + d; *up = (bf16)f2bf(bf2f(*up) * (s + bsg[i])); }
}

__device__ __forceinline__ void tr_item(const float* W, int ldw, bf16* WT, int K, int k0, int n0, int drow0, LAS float* scr, int lane) {
    float tv[32];
#pragma unroll
    for (int i = 0; i < 32; ++i) tv[i] = W[(size_t)(k0 + 2 * i + (lane >> 5)) * ldw + n0 + (lane & 31)];
#pragma unroll
    for (int i = 0; i < 32; ++i) scr[(2 * i + (lane >> 5)) * 33 + (lane & 31)] = tv[i];
    asm volatile("s_waitcnt lgkmcnt(0)" ::: "memory");
    const int c = lane & 7;
#pragma unroll
    for (int j = 0; j < 4; ++j) { const int n = (lane >> 3) + 8 * j; const LAS float* s = scr + (8 * c) * 33 + n;
        v4u o; o.x = pk2(s[0 * 33], s[1 * 33]); o.y = pk2(s[2 * 33], s[3 * 33]); o.z = pk2(s[4 * 33], s[5 * 33]); o.w = pk2(s[6 * 33], s[7 * 33]);
        *(v4u*)(WT + (size_t)(drow0 + n) * K + k0 + 8 * c) = o; }
    asm volatile("s_waitcnt lgkmcnt(0)" ::: "memory");
}

__device__ __forceinline__ void phase_prologue(const Frame& F) {
    const Args& a = *F.a;
    LAS float* sc = (LAS float*)F.lds; LAS float* red = sc + 17 * 1024;
    if (F.bid < 192) {
        for (int i = F.tid; i < 17 * 1024; i += 512) { const int r = i >> 10, k = i & 1023; const float v = r < 16 ? a.in[I_C][r * 1024 + k] : a.in[I_CCTX][k]; sc[i] = siluf_(v); }
        __syncthreads();
        for (int it = F.bid; it < 192; it += F.G) {
            const int l = it / 96, nb = it % 96, n = nb * 64 + F.lane;
            float acc[17];
#pragma unroll
            for (int r = 0; r < 17; ++r) acc[r] = 0.f;
            const float* W = a.in[I_ADAW] + (size_t)l * 1024 * 6144 + n;
#pragma unroll 4
            for (int kk = 0; kk < 128; ++kk) { const int k = F.wave * 128 + kk; const float wv = W[(size_t)k * 6144];
#pragma unroll
                for (int r = 0; r < 17; ++r) acc[r] += sc[r * 1024 + k] * wv; }
#pragma unroll
            for (int r = 0; r < 17; ++r) red[(F.wave * 17 + r) * 64 + F.lane] = acc[r];
            __syncthreads();
            for (int i = F.tid; i < 17 * 64; i += 512) { const int r = i >> 6, ln = i & 63; float s = 0.f;
#pragma unroll
                for (int w = 0; w < 8; ++w) s += red[(w * 17 + r) * 64 + ln];
                ((float*)(a.ws + WS_MOD))[(size_t)(l * 17 + r) * 6144 + nb * 64 + ln] = s + a.in[I_ADAB][l * 6144 + nb * 64 + ln]; }
            __syncthreads();
        }
    }
    __syncthreads();
    LAS float* scr = (LAS float*)(F.lds + F.wave * 8448);
    const int gw = F.bid * F.nw + F.wave, NGW = F.G * F.nw;
    constexpr int IT_IN = 16 * 225, IT_MX = 16 * 32, IT_L = IT_IN + 3 * IT_MX;
    for (int it = gw; it < 2 * IT_L; it += NGW) {
        const int l = it / IT_L; int r = it % IT_L;
        if (r < IT_IN) { const int kb = r / 225, nb = r % 225, n0 = nb * 32; const int d0 = n0 < 2048 ? n0 : (n0 < 2080 ? 7168 + (n0 - 2048) : n0 - 32);
            tr_item(a.in[I_WIN] + (size_t)l * D * NIN, NIN, (bf16*)(a.ws + WS_WIN) + (size_t)l * WIN_ROWS * D, D, kb * 64, n0, d0, scr, F.lane); }
        else { r -= IT_IN; const int m = r / IT_MX, q = r % IT_MX, kb = q / 32, nb = q % 32;
            const float* W = (m == 0 ? a.in[I_WPA] : (m == 1 ? a.in[I_WPB] : a.in[I_WO])) + (size_t)l * D * D;
            tr_item(W, D, (bf16*)(a.ws + WS_WMIX) + (size_t)(l * 3 + m) * D * D, D, kb * 64, nb * 32, nb * 32, scr, F.lane); }
    }
    for (int i = F.bid * 512 + F.tid; i < 2 * 224 * 128; i += F.G * 512) { const int l = i / (224 * 128), q = i % (224 * 128);
        *(v4u*)((bf16*)(a.ws + WS_WIN) + ((size_t)l * WIN_ROWS + 7200) * D + (size_t)q * 8) = (v4u){0u, 0u, 0u, 0u}; }
    for (int i = F.bid * 512 + F.tid; i < 2 * 8 * 128 * 128 / 4; i += F.G * 512) { const f32x4 v = *(const f32x4*)(a.in[I_WS] + (size_t)i * 4); *(v2u*)((bf16*)(a.ws + WS_WST) + (size_t)i * 4) = pack4(v); }
}

__device__ __forceinline__ void convert_experts(const Frame& F, int l) {
    const Args& a = *F.a;
    LAS float* scr = (LAS float*)(F.lds + 65536 + F.wave * 8448);
    const int gw = F.bid * F.nw + F.wave, NGW = F.G * F.nw;
    for (int it = gw; it < 16 * 3 * 512; it += NGW) {
        const int e = it / 1536, r = it % 1536, m = r / 512, q = r % 512, kb = q / 32, nb = q % 32, n0 = nb * 32;
        const float* W = (m == 0 ? a.in[I_WG] : (m == 1 ? a.in[I_WU] : a.in[I_WD])) + ((size_t)l * 16 + e) * D * D;
        if (m < 2) tr_item(W, D, (bf16*)(a.ws + WS_P + PO_WGU) + (size_t)e * 2048 * D, D, kb * 64, n0, (n0 >> 7) * 256 + m * 128 + (n0 & 127), scr, F.lane);
        else tr_item(W, D, (bf16*)(a.ws + WS_P + PO_WD) + (size_t)e * 1024 * D, D, kb * 64, n0, n0, scr, F.lane);
    }
}

__device__ __forceinline__ void moe_combine(const Frame& F, int lprev, int r, f32x4 (&v)[4]) {
    const Args& a = *F.a;
    const int* inv = (const int*)(a.ws + WS_INV) + (size_t)r * 16;
    const int myslot = F.lane < 16 ? inv[F.lane] : -1;
    const bool lat = r < NLAT; const int b = lat ? (r >> 11) : ((r - NLAT) >> 8);
    f32x4 s[4];
#pragma unroll
    for (int j = 0; j < 4; ++j) s[j] = (f32x4){0.f, 0.f, 0.f, 0.f};
    const bf16* YM = (const bf16*)(a.ws + WS_P + PO_YM);
    for (int e = 0; e < 16; ++e) {
        const int slot = __builtin_amdgcn_readlane(myslot, e);
        if (slot >= 0) { const size_t hrow = lat ? (size_t)((b * 16 + e) * 256 + slot) : (size_t)(LIST_C0 + e * 512 + b * 32 + slot);
            const bf16* yp = YM + hrow * D + 4 * F.lane;
#pragma unroll
            for (int j = 0; j < 4; ++j) s[j] += unpack4(*(const v2u*)(yp + 256 * j)); }
    }
    const float* g2 = modp(a, lprev, batch_row(r)) + 5120 + 4 * F.lane;
#pragma unroll
    for (int j = 0; j < 4; ++j) v[j] += *(const f32x4*)(g2 + 256 * j) * s[j];
}

__device__ __forceinline__ const float* hrow_in(const Args& a, int l, int r) {
    const bool lat = r < NLAT;
    return (l == 0) ? (lat ? a.in[I_X] + (size_t)r * D : a.in[I_CTX] + (size_t)(r - NLAT) * D) : (lat ? a.out + (size_t)r * D : (const float*)(a.ws + WS_HC) + (size_t)(r - NLAT) * D);
}
__device__ __forceinline__ void phase_norm1(const Frame& F, int l) {
    const Args& a = *F.a;
    const int gw = F.bid * F.nw + F.wave, NGW = F.G * F.nw;
    f32x4 v[4], vn[4];
    if (gw < NROW) { const float* hin = hrow_in(a, l, gw) + 4 * F.lane;
#pragma unroll
        for (int j = 0; j < 4; ++j) v[j] = *(const f32x4*)(hin + 256 * j); }
    for (int r = gw; r < NROW; r += NGW) {
        const bool lat = r < NLAT;
        { const int rn = r + NGW < NROW ? r + NGW : r; const float* hn = hrow_in(a, l, rn) + 4 * F.lane;
#pragma unroll
            for (int j = 0; j < 4; ++j) vn[j] = *(const f32x4*)(hn + 256 * j); }
        if (l > 0) { moe_combine(F, l - 1, r, v); float* ho = lat ? a.out + (size_t)r * D : (float*)(a.ws + WS_HC) + (size_t)(r - NLAT) * D;
#pragma unroll
            for (int j = 0; j < 4; ++j) *(f32x4*)(ho + 4 * F.lane + 256 * j) = v[j]; }
        float ss = 0.f;
#pragma unroll
        for (int j = 0; j < 4; ++j) ss += v[j].x * v[j].x + v[j].y * v[j].y + v[j].z * v[j].z + v[j].w * v[j].w;
        const float rstd = rsqrtf(wave_sum(ss) * (1.f / D) + EPS);
        const float* md = modp(a, l, batch_row(r)) + 4 * F.lane; const float* nw = a.in[I_N1W] + l * D + 4 * F.lane;
        bf16* o = (bf16*)(a.ws + WS_XM) + (size_t)r * D + 4 * F.lane;
#pragma unroll
        for (int j = 0; j < 4; ++j) { const f32x4 w = *(const f32x4*)(nw + 256 * j), sh = *(const f32x4*)(md + 256 * j), scl = *(const f32x4*)(md + 1024 + 256 * j);
            *(v2u*)(o + 256 * j) = pack4(v[j] * rstd * w * (scl + 1.0f) + sh); }
#pragma unroll
        for (int j = 0; j < 4; ++j) v[j] = vn[j];
    }
}

__device__ __forceinline__ void phase_ssdin(const Frame& F, int l) {
    const Args& a = *F.a;
    const int gw = F.bid * F.nw + F.wave, NGW = F.G * F.nw, nrows = l == 0 ? NROW : NLAT;
    const float* nw = a.in[I_SSDNW] + l * D + 4 * F.lane;
    v2u yv[4], zv[4], yn[4], zn[4];
    if (gw < nrows) {
#pragma unroll
        for (int j = 0; j < 4; ++j) { yv[j] = *(const v2u*)((const bf16*)(a.ws + WS_XM) + (size_t)gw * D + 4 * F.lane + 256 * j); zv[j] = *(const v2u*)((const bf16*)(a.ws + WS_P) + (size_t)gw * PW + PZ + 4 * F.lane + 256 * j); } }
    for (int r = gw; r < nrows; r += NGW) {
        const int rn = r + NGW < nrows ? r + NGW : r;
#pragma unroll
        for (int j = 0; j < 4; ++j) { yn[j] = *(const v2u*)((const bf16*)(a.ws + WS_XM) + (size_t)rn * D + 4 * F.lane + 256 * j); zn[j] = *(const v2u*)((const bf16*)(a.ws + WS_P) + (size_t)rn * PW + PZ + 4 * F.lane + 256 * j); }
        bf16* z = (bf16*)(a.ws + WS_P) + (size_t)r * PW + PZ + 4 * F.lane;
#pragma unroll
        for (int j = 0; j < 4; ++j) { const f32x4 g = unpack4(yv[j]) * unpack4(zv[j]);
            const float ms = wave_sum(g.x * g.x + g.y * g.y + g.z * g.z + g.w * g.w) * (1.f / 256.f);
            *(v2u*)(z + 256 * j) = pack4(g * rsqrtf(ms + EPS) * *(const f32x4*)(nw + 256 * j)); }
#pragma unroll
        for (int j = 0; j < 4; ++j) { yv[j] = yn[j]; zv[j] = zn[j]; }
    }
}

__device__ __forceinline__ void phase_norm2(const Frame& F, int l) {
    const Args& a = *F.a;
    LAS float* rwT = (LAS float*)F.lds;
    for (int i = F.tid; i < 16 * 1024; i += 512) { const int k = i >> 4, e = i & 15; rwT[e * 1024 + k] = a.in[I_RW][(size_t)l * D * 16 + i]; }
    __syncthreads();
    const int gw = F.bid * F.nw + F.wave, NGW = F.G * F.nw, nrows = l == 0 ? NROW : NLAT;
    f32x4 v[4], vn[4];
    if (gw < nrows) { const float* hin = hrow_in(a, 1, gw) + 4 * F.lane;
#pragma unroll
        for (int j = 0; j < 4; ++j) v[j] = *(const f32x4*)(hin + 256 * j); }
    for (int r = gw; r < nrows; r += NGW) {
        { const int rn = r + NGW < nrows ? r + NGW : r; const float* hn = hrow_in(a, 1, rn) + 4 * F.lane;
#pragma unroll
            for (int j = 0; j < 4; ++j) vn[j] = *(const f32x4*)(hn + 256 * j); }
        float ss = 0.f;
#pragma unroll
        for (int j = 0; j < 4; ++j) ss += v[j].x * v[j].x + v[j].y * v[j].y + v[j].z * v[j].z + v[j].w * v[j].w;
        const float rstd = rsqrtf(wave_sum(ss) * (1.f / D) + EPS);
        const float* md = modp(a, l, batch_row(r)) + 3072 + 4 * F.lane; const float* nw = a.in[I_N2W] + l * D + 4 * F.lane;
        bf16* o = (bf16*)(a.ws + WS_XM) + (size_t)r * D + 4 * F.lane;
#pragma unroll
        for (int j = 0; j < 4; ++j) { const f32x4 w = *(const f32x4*)(nw + 256 * j), sh = *(const f32x4*)(md + 256 * j), scl = *(const f32x4*)(md + 1024 + 256 * j);
            v[j] = v[j] * rstd * w * (scl + 1.0f) + sh; *(v2u*)(o + 256 * j) = pack4(v[j]); }
        float mine = 0.f;
#pragma unroll 1
        for (int e = 0; e < 16; ++e) { float s = 0.f;
#pragma unroll
            for (int j = 0; j < 4; ++j) { const f32x4 w = *(const LAS f32x4*)(rwT + e * 1024 + 4 * F.lane + 256 * j); s += v[j].x * w.x + v[j].y * w.y + v[j].z * w.z + v[j].w * w.w; }
            s = wave_sum(s); mine = (F.lane == e) ? s : mine; }
        float mx = mine;
#pragma unroll
        for (int o = 1; o < 16; o <<= 1) mx = fmaxf(mx, __shfl_xor(mx, o));
        const float ex = __expf(mine - mx); float den = ex;
#pragma unroll
        for (int o = 1; o < 16; o <<= 1) den += __shfl_xor(den, o);
        if (F.lane < 16) ((float*)(a.ws + WS_AFF))[(size_t)r * 16 + F.lane] = ex / den;
#pragma unroll
        for (int j = 0; j < 4; ++j) v[j] = vn[j];
    }
    __syncthreads();
    convert_experts(F, l);
}

__device__ __forceinline__ int block_excl_scan(int c, LAS int* slots, int wave, int lane, int& total) {
    int inc = c;
#pragma unroll
    for (int o = 1; o < 64; o <<= 1) { const int v = __shfl_up(inc, o); if (lane >= o) inc += v; }
    if (lane == 63) slots[wave] = inc;
    __syncthreads();
    int before = 0, tot = 0;
#pragma unroll
    for (int w2 = 0; w2 < 8; ++w2) { const int v = slots[w2]; tot += v; before += (w2 < wave) ? v : 0; }
    __syncthreads();
    total = tot;
    return before + inc - c;
}
__device__ __forceinline__ void phase_topk(const Frame& F, int l) {
    const Args& a = *F.a;
    LAS int* cnts = (LAS int*)F.lds;
    const int ntask = l == 0 ? 512 : 256;
    const float* AFF = (const float*)(a.ws + WS_AFF); int* INV = (int*)(a.ws + WS_INV); int* IDX = (int*)(a.ws + WS_IDX); float* GATE = (float*)(a.ws + WS_GATE);
    for (int task = F.bid; task < ntask; task += F.G) {
        const bool lat = task < 256; const int t = lat ? task : task - 256, b = t >> 4, e = t & 15;
        const int r0 = lat ? b * SEQ : NLAT + b * CTXL, n = lat ? SEQ : CTXL, cap = lat ? CAP_L : CAP_C;
        const int list0 = lat ? (b * 16 + e) * 256 : LIST_C0 + e * 512 + b * 32;
        unsigned k[4]; bool valid[4];
#pragma unroll
        for (int q = 0; q < 4; ++q) { const int i = 4 * F.tid + q; valid[q] = i < n; k[q] = valid[q] ? __builtin_bit_cast(unsigned, AFF[(size_t)(r0 + i) * 16 + e]) : 0u; }
        unsigned T = 0u;
        for (int bit = 30; bit >= 0; --bit) {
            const unsigned trial = T | (1u << bit);
            int c = 0;
#pragma unroll
            for (int q = 0; q < 4; ++q) c += __builtin_popcountll(__ballot(valid[q] && k[q] >= trial));
            LAS int* sl = cnts + (bit & 1) * 8;
            if (F.lane == 0) sl[F.wave] = c;
            __syncthreads();
            int tot = 0;
#pragma unroll
            for (int w2 = 0; w2 < 8; ++w2) tot += sl[w2];
            if (tot >= cap) T = trial;
        }
        __syncthreads();
        int cgt = 0, ceq = 0;
#pragma unroll
        for (int q = 0; q < 4; ++q) { cgt += (valid[q] && k[q] > T) ? 1 : 0; ceq += (valid[q] && k[q] == T) ? 1 : 0; }
        int ngt, neq;
        (void)block_excl_scan(cgt, cnts + 16, F.wave, F.lane, ngt);
        int eqr = block_excl_scan(ceq, cnts + 16, F.wave, F.lane, neq);
        const int need = cap - ngt;
        bool sel[4]; int csel = 0;
#pragma unroll
        for (int q = 0; q < 4; ++q) { const bool eq = valid[q] && k[q] == T; sel[q] = valid[q] && (k[q] > T || (eq && eqr < need)); eqr += eq ? 1 : 0; csel += sel[q] ? 1 : 0; }
        int nsel; int slot = block_excl_scan(csel, cnts + 16, F.wave, F.lane, nsel);
#pragma unroll
        for (int q = 0; q < 4; ++q) { const int i = 4 * F.tid + q;
            if (valid[q]) { const int sl = sel[q] ? slot : -1; INV[(size_t)(r0 + i) * 16 + e] = sl;
                if (sel[q]) { IDX[list0 + slot] = r0 + i; GATE[list0 + slot] = __builtin_bit_cast(float, k[q]); ++slot; } } }
    }
}

__device__ __forceinline__ void phase_final(const Frame& F) {
    const Args& a = *F.a;
    const int gw = F.bid * F.nw + F.wave, NGW = F.G * F.nw;
    for (int r = gw; r < NLAT; r += NGW) {
        float* h = a.out + (size_t)r * D + 4 * F.lane; f32x4 v[4];
#pragma unroll
        for (int j = 0; j < 4; ++j) v[j] = *(const f32x4*)(h + 256 * j);
        moe_combine(F, 1, r, v);
        float ss = 0.f;
#pragma unroll
        for (int j = 0; j < 4; ++j) ss += v[j].x * v[j].x + v[j].y * v[j].y + v[j].z * v[j].z + v[j].w * v[j].w;
        const float rstd = rsqrtf(wave_sum(ss) * (1.f / D) + EPS);
#pragma unroll
        for (int j = 0; j < 4; ++j) *(f32x4*)(h + 256 * j) = v[j] * rstd * *(const f32x4*)(a.in[I_FNW] + 4 * F.lane + 256 * j);
    }
}


__device__ __forceinline__ void phase_ssd_seq(const Frame& F, int l) {
    const Args& a = *F.a;
    LAS float* xs = (LAS float*)F.lds; LAS float* Bsm = xs + 32 * 64; LAS float* Csm = Bsm + 32 * 128; LAS float* dts = Csm + 32 * 128;
    const bf16* P = (const bf16*)(a.ws + WS_P); bf16* Y = (bf16*)(a.ws + WS_XM); const float* DT = (const float*)(a.ws + WS_DT);
    const float* cw = a.in[I_CONVW] + (size_t)l * 3 * 2048; const float* cb = a.in[I_CONVB] + (size_t)l * 2048;
    const int tid = F.tid, p = tid >> 3, nq = tid & 7;
    for (int task = F.bid; task < 256; task += F.G) {
        const int b = task >> 4, h = task & 15, g = h >> 2;
        const float dskip = a.in[I_DSKIP][l * 16 + h];
        for (int dir = 0; dir < 2; ++dir) {
            float st[16];
#pragma unroll
            for (int i = 0; i < 16; ++i) st[i] = 0.f;
            const float Ah = -__expf(a.in[I_ALOG][(l * 2 + dir) * 16 + h]);
            for (int seg = 0; seg < 2; ++seg) {
                const int base = seg == 0 ? NLAT + b * CTXL : b * SEQ, len = seg == 0 ? CTXL : SEQ;
                const bool wy = !(l == 1 && seg == 0);
                for (int blk = 0; blk < len / 32; ++blk) {
                    for (int idx = tid; idx < 32 * 320; idx += 512) {
                        const int tt = idx / 320, ch = idx % 320;
                        const int tok = dir == 0 ? blk * 32 + tt : len - 1 - (blk * 32 + tt);
                        const int col = ch < 64 ? PX + h * 64 + ch : (ch < 192 ? PB + g * 128 + (ch - 64) : PC + g * 128 + (ch - 192));
                        const bf16* pp = P + (size_t)(base + tok) * PW + col;
                        const float cur = bf2f(pp[0]), prv = tok > 0 ? bf2f(pp[-PW]) : 0.f, nxt = tok < len - 1 ? bf2f(pp[PW]) : 0.f;
                        const float v = siluf_(cw[col] * prv + cw[2048 + col] * cur + cw[4096 + col] * nxt + cb[col]);
                        if (ch < 64) xs[tt * 64 + ch] = v; else if (ch < 192) Bsm[tt * 128 + ch - 64] = v; else Csm[tt * 128 + ch - 192] = v;
                    }
                    if (tid < 32) { const int tok = dir == 0 ? blk * 32 + tid : len - 1 - (blk * 32 + tid); dts[tid] = DT[(size_t)(base + tok) * 32 + dir * 16 + h]; }
                    __syncthreads();
                    for (int tt = 0; tt < 32; ++tt) {
                        const float dt = dts[tt], dA = __expf(dt * Ah), xr = xs[tt * 64 + p], xv = xr * dt;
                        float ys = 0.f;
#pragma unroll
                        for (int i = 0; i < 16; ++i) { const int n = nq * 16 + i; st[i] = st[i] * dA + xv * Bsm[tt * 128 + n]; ys += st[i] * Csm[tt * 128 + n]; }
                        ys += __shfl_xor(ys, 1); ys += __shfl_xor(ys, 2); ys += __shfl_xor(ys, 4);
                        if (nq == 0 && wy) { const int tok = dir == 0 ? blk * 32 + tt : len - 1 - (blk * 32 + tt); bf16* yp = Y + (size_t)(base + tok) * D + h * 64 + p;
                            if (dir == 0) *yp = (bf16)f2bf(ys + dskip * xr); else *yp = (bf16)f2bf(bf2f(*yp) + ys); }
                    }
                    __syncthreads();
                }
            }
        }
    }
}


typedef short s16x4 __attribute__((ext_vector_type(4)));
__device__ __forceinline__ bf16x8 tr_frag(const LAS unsigned char* p, int stride4) {
    const s16x4 lo = __builtin_amdgcn_ds_read_tr16_b64_v4i16((LAS s16x4*)p), hi = __builtin_amdgcn_ds_read_tr16_b64_v4i16((LAS s16x4*)(p + stride4));
    return __builtin_shufflevector(lo, hi, 0, 1, 2, 3, 4, 5, 6, 7);
}
__device__ __forceinline__ void phase_ssd_chunked(const Frame& F, int l) {
    const Args& a = *F.a;
    constexpr int SB = 272, SX = 144;
    constexpr int O_BS = 0, O_CS = 34816, O_HS = 69632, O_XS = 87040, O_XW = 105472, O_DT = 123904, O_AC = 124416, O_SC = 124928, O_TOT = 125440;
    LAS unsigned char* Ls = F.lds;
    LAS float* dtl = (LAS float*)(Ls + O_DT); LAS float* acl = (LAS float*)(Ls + O_AC); LAS float* scl = (LAS float*)(Ls + O_SC); LAS float* totl = (LAS float*)(Ls + O_TOT);
    const bf16* P = (const bf16*)(a.ws + WS_P); bf16* Y = (bf16*)(a.ws + WS_XM); const float* DT = (const float*)(a.ws + WS_DT);
    const float* cw = a.in[I_CONVW] + (size_t)l * 3 * 2048; const float* cb = a.in[I_CONVB] + (size_t)l * 2048;
    const int tid = F.tid, lane = F.lane, w = F.wave, r16 = lane & 15, q4 = lane >> 4;
    for (int task = F.bid; task < 256; task += F.G) {
        const int b = task >> 4, h = task & 15, g = h >> 2;
        const float dskip = a.in[I_DSKIP][l * 16 + h];
        const int cg = tid % 40, rg = tid / 40;
        const int gcol = cg < 8 ? PX + h * 64 + cg * 8 : (cg < 24 ? PB + g * 128 + (cg - 8) * 8 : PC + g * 128 + (cg - 24) * 8);
        const int dstoff = cg < 8 ? O_XS + cg * 16 : (cg < 24 ? O_BS + (cg - 8) * 16 : O_CS + (cg - 24) * 16), dststr = cg < 8 ? SX : SB;
        for (int dir = 0; dir < 2; ++dir) {
            f32x4 acch[4];
#pragma unroll
            for (int i = 0; i < 4; ++i) acch[i] = (f32x4){0.f, 0.f, 0.f, 0.f};
            for (int i = tid; i < 64 * SB / 16; i += 512) *(LAS v4u*)(Ls + O_HS + i * 16) = (v4u){0u, 0u, 0u, 0u};
            const float Ah = -__expf(a.in[I_ALOG][(l * 2 + dir) * 16 + h]);
            v4u rows[13]; bool have_pref = false;
            for (int step = 0; step < 18; ++step) {
                const bool isctx = step < 2;
                const int chunk = dir == 0 ? (isctx ? step : step - 2) : (isctx ? 1 - step : 17 - step);
                const int len = isctx ? CTXL : SEQ, t0 = chunk * 128, base = (isctx ? NLAT + b * CTXL : b * SEQ) + t0;
                const bool wy = !(l == 1 && isctx);
                if (tid < 480) {
                    int gc = gcol; asm volatile("" : "+v"(gc));
                    float w0[8], w1[8], w2[8], bs[8];
#pragma unroll
                    for (int i = 0; i < 8; ++i) { w0[i] = cw[gc + i]; w1[i] = cw[2048 + gc + i]; w2[i] = cw[4096 + gc + i]; bs[i] = cb[gc + i]; }
                    const int i0 = rg * 11;
                    if (!have_pref) {
                        const bf16* pp = P + (size_t)(base + i0) * PW + gc;
#pragma unroll
                        for (int ii = 0; ii < 13; ++ii) { const int t = t0 + i0 + ii - 1; rows[ii] = (t >= 0 && t < len) ? *(const v4u*)(pp + (ptrdiff_t)(ii - 1) * PW) : (v4u){0u, 0u, 0u, 0u}; }
                    }
#pragma unroll
                    for (int ii = 0; ii < 11; ++ii) { const v4u p0 = rows[ii], p1 = rows[ii + 1], p2 = rows[ii + 2]; float o[8];
                        o[0] = w0[0] * bflo(p0.x) + w1[0] * bflo(p1.x) + w2[0] * bflo(p2.x) + bs[0]; o[1] = w0[1] * bfhi(p0.x) + w1[1] * bfhi(p1.x) + w2[1] * bfhi(p2.x) + bs[1];
                        o[2] = w0[2] * bflo(p0.y) + w1[2] * bflo(p1.y) + w2[2] * bflo(p2.y) + bs[2]; o[3] = w0[3] * bfhi(p0.y) + w1[3] * bfhi(p1.y) + w2[3] * bfhi(p2.y) + bs[3];
                        o[4] = w0[4] * bflo(p0.z) + w1[4] * bflo(p1.z) + w2[4] * bflo(p2.z) + bs[4]; o[5] = w0[5] * bfhi(p0.z) + w1[5] * bfhi(p1.z) + w2[5] * bfhi(p2.z) + bs[5];
                        o[6] = w0[6] * bflo(p0.w) + w1[6] * bflo(p1.w) + w2[6] * bflo(p2.w) + bs[6]; o[7] = w0[7] * bfhi(p0.w) + w1[7] * bfhi(p1.w) + w2[7] * bfhi(p2.w) + bs[7];
                        v4u ov; ov.x = pk2(siluf_(o[0]), siluf_(o[1])); ov.y = pk2(siluf_(o[2]), siluf_(o[3])); ov.z = pk2(siluf_(o[4]), siluf_(o[5])); ov.w = pk2(siluf_(o[6]), siluf_(o[7]));
                        if (i0 + ii < 128) *(LAS v4u*)(Ls + dstoff + (i0 + ii) * dststr) = ov; }
                }
                if (w == 7) {
                    const int t = 2 * lane;
                    const float d0 = DT[(size_t)(base + t) * 32 + dir * 16 + h], d1 = DT[(size_t)(base + t + 1) * 32 + dir * 16 + h];
                    const float a0 = d0 * Ah, a1 = d1 * Ah;
                    float incl = a0 + a1;
#pragma unroll
                    for (int o = 1; o < 64; o <<= 1) { const float v = __shfl_up(incl, o); if (lane >= o) incl += v; }
                    const float tot = __shfl(incl, 63), excl = incl - (a0 + a1);
                    float c0, c1;
                    if (dir == 0) { c0 = excl + a0; c1 = incl; } else { c0 = tot - excl; c1 = tot - excl - a0; }
                    dtl[t] = d0; dtl[t + 1] = d1; acl[t] = c0; acl[t + 1] = c1; scl[t] = d0 * __expf(tot - c0); scl[t + 1] = d1 * __expf(tot - c1);
                    if (lane == 0) totl[0] = tot;
                }
                __syncthreads();
                { const int j = tid >> 2, c0 = (tid & 3) * 16; const float sc = scl[j];
                    const v4u x0 = *(const LAS v4u*)(Ls + O_XS + j * SX + c0 * 2), x1 = *(const LAS v4u*)(Ls + O_XS + j * SX + c0 * 2 + 16); v4u y0, y1;
                    y0.x = pk2(bflo(x0.x) * sc, bfhi(x0.x) * sc); y0.y = pk2(bflo(x0.y) * sc, bfhi(x0.y) * sc); y0.z = pk2(bflo(x0.z) * sc, bfhi(x0.z) * sc); y0.w = pk2(bflo(x0.w) * sc, bfhi(x0.w) * sc);
                    y1.x = pk2(bflo(x1.x) * sc, bfhi(x1.x) * sc); y1.y = pk2(bflo(x1.y) * sc, bfhi(x1.y) * sc); y1.z = pk2(bflo(x1.z) * sc, bfhi(x1.z) * sc); y1.w = pk2(bflo(x1.w) * sc, bfhi(x1.w) * sc);
                    *(LAS v4u*)(Ls + O_XW + j * SX + c0 * 2) = y0; *(LAS v4u*)(Ls + O_XW + j * SX + c0 * 2 + 16) = y1; }
                float yold[4][4];
#pragma unroll
                for (int pt = 0; pt < 4; ++pt)
#pragma unroll
                    for (int rg4 = 0; rg4 < 4; ++rg4) yold[pt][rg4] = (wy && dir == 1) ? bf2f(Y[(size_t)(base + 16 * w + 4 * q4 + rg4) * D + h * 64 + 16 * pt + r16]) : 0.f;
                if (wy) {
                    bf16x8 cf[4];
#pragma unroll
                    for (int ks = 0; ks < 4; ++ks) cf[ks] = *(const LAS bf16x8*)(Ls + O_CS + (16 * w + r16) * SB + (32 * ks + 8 * q4) * 2);
                    f32x4 aoff[4];
#pragma unroll
                    for (int pt = 0; pt < 4; ++pt) { aoff[pt] = (f32x4){0.f, 0.f, 0.f, 0.f};
#pragma unroll
                        for (int ks = 0; ks < 4; ++ks) aoff[pt] = __builtin_amdgcn_mfma_f32_16x16x32_bf16(cf[ks], *(const LAS bf16x8*)(Ls + O_HS + (16 * pt + r16) * SB + (32 * ks + 8 * q4) * 2), aoff[pt], 0, 0, 0); }
                    float aci[4];
#pragma unroll
                    for (int rg4 = 0; rg4 < 4; ++rg4) aci[rg4] = acl[16 * w + 4 * q4 + rg4];
#pragma unroll
                    for (int jt = 0; jt < 8; ++jt) {
                        const bool live = dir == 0 ? (jt <= w) : (jt >= w);
                        f32x4 cbv = (f32x4){0.f, 0.f, 0.f, 0.f};
                        if (live) {
#pragma unroll
                            for (int ks = 0; ks < 4; ++ks) cbv = __builtin_amdgcn_mfma_f32_16x16x32_bf16(cf[ks], *(const LAS bf16x8*)(Ls + O_BS + (16 * jt + r16) * SB + (32 * ks + 8 * q4) * 2), cbv, 0, 0, 0);
                            const int j = 16 * jt + r16; const float acj = acl[j], dtj = dtl[j];
#pragma unroll
                            for (int rg4 = 0; rg4 < 4; ++rg4) { const int i = 16 * w + 4 * q4 + rg4; const bool ok = dir == 0 ? (j <= i) : (j >= i);
                                cbv[rg4] = ok ? cbv[rg4] * __expf(fminf(aci[rg4] - acj, 0.f)) * dtj : 0.f; }
                        }
#pragma unroll
                        for (int rg4 = 0; rg4 < 4; ++rg4) *(LAS bf16*)(Ls + O_CS + (16 * w + 4 * q4 + rg4) * SB + (16 * jt + r16) * 2) = (bf16)f2bf(cbv[rg4]);
                    }
                    f32x4 ad[4];
#pragma unroll
                    for (int pt = 0; pt < 4; ++pt) { ad[pt] = (f32x4){0.f, 0.f, 0.f, 0.f};
#pragma unroll
                        for (int ks = 0; ks < 4; ++ks) ad[pt] = __builtin_amdgcn_mfma_f32_16x16x32_bf16(*(const LAS bf16x8*)(Ls + O_CS + (16 * w + r16) * SB + (32 * ks + 8 * q4) * 2),
                            tr_frag(Ls + O_XS + (32 * ks + 8 * q4 + (r16 >> 2)) * SX + (16 * pt + 4 * (r16 & 3)) * 2, 4 * SX), ad[pt], 0, 0, 0); }
#pragma unroll
                    for (int pt = 0; pt < 4; ++pt)
#pragma unroll
                        for (int rg4 = 0; rg4 < 4; ++rg4) { const int i = 16 * w + 4 * q4 + rg4, p = 16 * pt + r16;
                            float v = ad[pt][rg4] + __expf(aci[rg4]) * aoff[pt][rg4];
                            bf16* yp = Y + (size_t)(base + i) * D + h * 64 + p;
                            if (dir == 0) v += dskip * bf2f(*(const LAS bf16*)(Ls + O_XS + i * SX + p * 2)); else v += yold[pt][rg4];
                            *yp = (bf16)f2bf(v); }
                }
                have_pref = false;
                if (step < 17 && tid < 480) {
                    const int ns = step + 1; const bool nctx = ns < 2;
                    const int nchunk = dir == 0 ? (nctx ? ns : ns - 2) : (nctx ? 1 - ns : 17 - ns);
                    const int nlen = nctx ? CTXL : SEQ, nt0 = nchunk * 128, nbase = (nctx ? NLAT + b * CTXL : b * SEQ) + nt0, i0 = rg * 11;
                    const bf16* pp = P + (size_t)(nbase + i0) * PW + gcol;
#pragma unroll
                    for (int ii = 0; ii < 13; ++ii) { const int t = nt0 + i0 + ii - 1; rows[ii] = (t >= 0 && t < nlen) ? *(const v4u*)(pp + (ptrdiff_t)(ii - 1) * PW) : (v4u){0u, 0u, 0u, 0u}; }
                    have_pref = true;
                }
                __syncthreads();
                {
                    const float dec = __expf(totl[0]);
                    bf16x8 bfr[4];
#pragma unroll
                    for (int ks = 0; ks < 4; ++ks) bfr[ks] = tr_frag(Ls + O_BS + (32 * ks + 8 * q4 + (r16 >> 2)) * SB + (16 * w + 4 * (r16 & 3)) * 2, 4 * SB);
#pragma unroll
                    for (int pt = 0; pt < 4; ++pt) { acch[pt] *= dec;
#pragma unroll
                        for (int ks = 0; ks < 4; ++ks) acch[pt] = __builtin_amdgcn_mfma_f32_16x16x32_bf16(tr_frag(Ls + O_XW + (32 * ks + 8 * q4 + (r16 >> 2)) * SX + (16 * pt + 4 * (r16 & 3)) * 2, 4 * SX), bfr[ks], acch[pt], 0, 0, 0);
#pragma unroll
                        for (int rg4 = 0; rg4 < 4; ++rg4) *(LAS bf16*)(Ls + O_HS + (16 * pt + 4 * q4 + rg4) * SB + (16 * w + r16) * 2) = (bf16)f2bf(acch[pt][rg4]); }
                }
                __syncthreads();
            }
        }
    }
}


__device__ __forceinline__ void phase_vstats(const Frame& F, int l) {
    const Args& a = *F.a;
    const int gw = F.bid * F.nw + F.wave, NGW = F.G * F.nw, nrows = l == 0 ? NROW : NLAT;
    for (int r = gw; r < nrows; r += NGW) {
        const bf16* vp = (const bf16*)(a.ws + WS_P) + (size_t)r * PW + PV + F.lane * 8;
        const v4u w0 = *(const v4u*)vp, w1 = *(const v4u*)(vp + 512);
        float v[16] = {bflo(w0.x), bfhi(w0.x), bflo(w0.y), bfhi(w0.y), bflo(w0.z), bfhi(w0.z), bflo(w0.w), bfhi(w0.w), bflo(w1.x), bfhi(w1.x), bflo(w1.y), bfhi(w1.y), bflo(w1.z), bfhi(w1.z), bflo(w1.w), bfhi(w1.w)};
        float sm = 0.f;
#pragma unroll
        for (int i = 0; i < 16; ++i) sm += v[i];
        const float m = wave_sum(sm) * (1.f / D); float s2 = 0.f;
#pragma unroll
        for (int i = 0; i < 16; ++i) { const float d = v[i] - m; s2 += d * d; }
        const float var = wave_sum(s2) * (1.f / D);
        if (F.lane == 0) *(f32x2*)((float*)(a.ws + WS_VSTAT) + (size_t)r * 2) = (f32x2){m, rsqrtf(var + EPS)};
    }
}

__device__ __forceinline__ void phase_sgu_mfma(const Frame& F, int l) {
    const Args& a = *F.a;
    constexpr int SV = 272, SO = 528;
    constexpr int O_VN = 0, O_OUT = 34816;
    LAS unsigned char* Ls = F.lds;
    bf16* P = (bf16*)(a.ws + WS_P);
    const int ntask = (l == 0 ? 288 : 256) * 8, tid = F.tid, lane = F.lane, w = F.wave, r16 = lane & 15, q4 = lane >> 4;
    for (int task = F.bid; task < ntask; task += F.G) {
        const int chunk = task >> 3, g = task & 7;
        const int row0 = chunk < 256 ? chunk * 128 : NLAT + (chunk - 256) * 128;
        const float* lnw = a.in[I_LNW] + l * D + g * 128; const float* lnb = a.in[I_LNB] + l * D + g * 128;
#pragma unroll
        for (int q = 0; q < 4; ++q) { const int piece = tid + 512 * q, j = piece >> 4, d8 = (piece & 15) * 8;
            const v4u vv = *(const v4u*)(P + (size_t)(row0 + j) * PW + PV + g * 128 + d8);
            const f32x2 st = *(const f32x2*)((const float*)(a.ws + WS_VSTAT) + (size_t)(row0 + j) * 2);
            const f32x4 w0 = *(const f32x4*)(lnw + d8), w1 = *(const f32x4*)(lnw + d8 + 4), b0 = *(const f32x4*)(lnb + d8), b1 = *(const f32x4*)(lnb + d8 + 4);
            v4u o; o.x = pk2((bflo(vv.x) - st.x) * st.y * w0.x + b0.x, (bfhi(vv.x) - st.x) * st.y * w0.y + b0.y); o.y = pk2((bflo(vv.y) - st.x) * st.y * w0.z + b0.z, (bfhi(vv.y) - st.x) * st.y * w0.w + b0.w);
            o.z = pk2((bflo(vv.z) - st.x) * st.y * w1.x + b1.x, (bfhi(vv.z) - st.x) * st.y * w1.y + b1.y); o.w = pk2((bflo(vv.w) - st.x) * st.y * w1.z + b1.z, (bfhi(vv.w) - st.x) * st.y * w1.w + b1.w);
            *(LAS v4u*)(Ls + O_VN + j * SV + d8 * 2) = o; }
        bf16x8 af[4];
        const bf16* wsg = (const bf16*)(a.ws + WS_WST) + ((size_t)(l * 8 + g) * 128 + 16 * w + r16) * 128 + 8 * q4;
#pragma unroll
        for (int ks = 0; ks < 4; ++ks) af[ks] = *(const bf16x8*)(wsg + 32 * ks);
        float bi[4];
#pragma unroll
        for (int rg4 = 0; rg4 < 4; ++rg4) bi[rg4] = a.in[I_BS][(l * 8 + g) * 128 + 16 * w + 4 * q4 + rg4];
        __syncthreads();
#pragma unroll
        for (int dt = 0; dt < 8; ++dt) { f32x4 acc = (f32x4){0.f, 0.f, 0.f, 0.f};
#pragma unroll
            for (int ks = 0; ks < 4; ++ks) acc = __builtin_amdgcn_mfma_f32_16x16x32_bf16(af[ks], tr_frag(Ls + O_VN + (32 * ks + 8 * q4 + (r16 >> 2)) * SV + (16 * dt + 4 * (r16 & 3)) * 2, 4 * SV), acc, 0, 0, 0);
#pragma unroll
            for (int rg4 = 0; rg4 < 4; ++rg4) *(LAS float*)(Ls + O_OUT + (16 * w + 4 * q4 + rg4) * SO + (16 * dt + r16) * 4) = acc[rg4] + bi[rg4]; }
        __syncthreads();
#pragma unroll
        for (int q = 0; q < 4; ++q) { const int piece = tid + 512 * q, i = piece >> 4, d8 = (piece & 15) * 8;
            bf16* up = P + (size_t)(row0 + i) * PW + PU + g * 128 + d8; const v4u uv = *(const v4u*)up;
            const f32x4 m0 = *(const LAS f32x4*)(Ls + O_OUT + i * SO + d8 * 4), m1 = *(const LAS f32x4*)(Ls + O_OUT + i * SO + d8 * 4 + 16);
            v4u o; o.x = pk2(bflo(uv.x) * m0.x, bfhi(uv.x) * m0.y); o.y = pk2(bflo(uv.y) * m0.z, bfhi(uv.y) * m0.w); o.z = pk2(bflo(uv.z) * m1.x, bfhi(uv.z) * m1.y); o.w = pk2(bflo(uv.w) * m1.z, bfhi(uv.w) * m1.w);
            *(v4u*)up = o; }
        __syncthreads();
    }
}

__device__ __forceinline__ void phase_sgu_simple(const Frame& F, int l) {
    const Args& a = *F.a;
    LAS float* Vn = (LAS float*)F.lds; LAS float* mu = Vn + 128 * 128; LAS float* rs = mu + 128;
    bf16* P = (bf16*)(a.ws + WS_P);
    const int ntask = (l == 0 ? 288 : 256) * 8, tid = F.tid, lane = F.lane, wave = F.wave;
    for (int task = F.bid; task < ntask; task += F.G) {
        const int chunk = task >> 3, g = task & 7;
        const int row0 = chunk < 256 ? chunk * 128 : NLAT + (chunk - 256) * 128;
        for (int rr = 0; rr < 16; ++rr) { const int j = wave * 16 + rr; const bf16* vp = P + (size_t)(row0 + j) * PW + PV;
            float v[16]; float sm = 0.f;
#pragma unroll
            for (int q = 0; q < 2; ++q) { const v4u w = *(const v4u*)(vp + lane * 8 + 512 * q); v[q * 8 + 0] = bflo(w.x); v[q * 8 + 1] = bfhi(w.x); v[q * 8 + 2] = bflo(w.y); v[q * 8 + 3] = bfhi(w.y); v[q * 8 + 4] = bflo(w.z); v[q * 8 + 5] = bfhi(w.z); v[q * 8 + 6] = bflo(w.w); v[q * 8 + 7] = bfhi(w.w); }
#pragma unroll
            for (int i = 0; i < 16; ++i) sm += v[i];
            const float m = wave_sum(sm) * (1.f / D); float s2 = 0.f;
#pragma unroll
            for (int i = 0; i < 16; ++i) { const float d = v[i] - m; s2 += d * d; }
            const float var = wave_sum(s2) * (1.f / D);
            if (lane == 0) { mu[j] = m; rs[j] = rsqrtf(var + EPS); } }
        __syncthreads();
        const float* lnw = a.in[I_LNW] + l * D + g * 128; const float* lnb = a.in[I_LNB] + l * D + g * 128;
        for (int idx = tid; idx < 128 * 128; idx += 512) { const int j = idx >> 7, d = idx & 127; Vn[idx] = (bf2f(P[(size_t)(row0 + j) * PW + PV + g * 128 + d]) - mu[j]) * rs[j] * lnw[d] + lnb[d]; }
        __syncthreads();
        const float* Wsg = a.in[I_WS] + ((size_t)(l * 8 + g) * 128) * 128; const float* bsg = a.in[I_BS] + (l * 8 + g) * 128;
        for (int idx = tid; idx < 128 * 128; idx += 512) { const int i = idx >> 7, d = idx & 127; float sm = 0.f;
#pragma unroll 8
            for (int j = 0; j < 128; ++j) sm += Wsg[i * 128 + j] * Vn[j * 128 + d];
            bf16* up = P + (size_t)(row0 + i) * PW + PU + g * 128 + d; *up = (bf16)f2bf(bf2f(*up) * (sm + bsg[i])); }
        __syncthreads();
    }
}

#define XB_TMO      128
#define XB_XCNT(j)  (256  + 64 * (j))
#define XB_XSUB(j)  (1280 + 64 * (j))
#define XB_XGEN(j)  (2304 + 64 * (j))
#define XB_TOP      3328
#define XB_TOPGEN   3392
#define XCD_BAR_WORDS 3456
#define XB_SPIN_CAP (1u << 22)
__device__ __forceinline__ unsigned xb_ld(unsigned* p)              { return __hip_atomic_load(p, __ATOMIC_RELAXED, __HIP_MEMORY_SCOPE_AGENT); }
__device__ __forceinline__ unsigned xb_add(unsigned* p, unsigned v) { return __hip_atomic_fetch_add(p, v, __ATOMIC_RELAXED, __HIP_MEMORY_SCOPE_AGENT); }
__device__ __forceinline__ unsigned xb_xcc_id() { return (unsigned)__builtin_amdgcn_s_getreg((3 << 11) | 20) & 0xFu; }
#define XB_SPIN(cond, bar) do { unsigned _sp = 0; while (cond) { __builtin_amdgcn_s_sleep(1); \
    if ((++_sp & 255u) == 0u) { if (xb_ld(&(bar)[XB_TMO])) break; if (_sp > XB_SPIN_CAP) { atomicAdd(&(bar)[XB_TMO], 1u); break; } } } } while (0)
struct XcdBarrier { unsigned* bar; unsigned x; volatile LAS unsigned* st; };
__device__ __forceinline__ XcdBarrier xcd_barrier_post(unsigned* bar, volatile LAS unsigned* st) {
    XcdBarrier b; b.bar = bar; b.x = xb_xcc_id(); b.st = st;
    if (threadIdx.x == 0) (void)xb_add(&bar[XB_XCNT(b.x)], 1u);
    return b;
}
__device__ __forceinline__ void xcd_barrier_complete(unsigned* bar, unsigned x, unsigned& nloc, unsigned& nx) {
    const unsigned G = gridDim.x * gridDim.y * gridDim.z;
    unsigned sum, cnt, mine, sp = 0u;
    for (;;) {
        sum = 0u; cnt = 0u; mine = 0u;
#pragma unroll
        for (unsigned j = 0; j < 16; ++j) { const unsigned c = xb_ld(&bar[XB_XCNT(j)]); sum += c; cnt += (c > 0u) ? 1u : 0u; mine = (j == x) ? c : mine; }
        if (sum == G) break;
        __builtin_amdgcn_s_sleep(1);
        if ((++sp & 255u) == 0u) { if (xb_ld(&bar[XB_TMO])) break; if (sp > XB_SPIN_CAP) { atomicAdd(&bar[XB_TMO], 1u); break; } }
    }
    nloc = mine > 0u ? mine : 1u; nx = cnt > 0u ? cnt : 1u;
}
__device__ __forceinline__ void xcd_barrier(const XcdBarrier& b) {
    asm volatile("s_waitcnt vmcnt(0)" ::: "memory");
    __syncthreads();
    if (threadIdx.x == 0) {
        unsigned* bar = b.bar;
        __builtin_amdgcn_s_waitcnt(0);
        unsigned nloc = b.st[0], nx = b.st[1];
        if (nloc == 0u) { xcd_barrier_complete(bar, b.x, nloc, nx); b.st[0] = nloc; b.st[1] = nx; }
        const unsigned old = xb_add(&bar[XB_XSUB(b.x)], 1u);
        const unsigned gen = old / nloc;
        if (old + 1u == (gen + 1u) * nloc) {
            __builtin_amdgcn_fence(__ATOMIC_RELEASE, "agent");
            asm volatile("s_waitcnt vmcnt(0)" ::: "memory");
            const unsigned og = xb_add(&bar[XB_TOP], 1u);
            const unsigned tg = og / nx;
            if (og + 1u == (tg + 1u) * nx) xb_add(&bar[XB_TOPGEN], 1u);
            else XB_SPIN(xb_ld(&bar[XB_TOPGEN]) == tg, bar);
            __builtin_amdgcn_fence(__ATOMIC_ACQUIRE, "agent");
            xb_add(&bar[XB_XGEN(b.x)], 1u);
            asm volatile("s_waitcnt vmcnt(0)" ::: "memory");
        } else {
            XB_SPIN(xb_ld(&bar[XB_XGEN(b.x)]) == gen, bar);
            __builtin_amdgcn_fence(__ATOMIC_ACQUIRE, "agent");
            asm volatile("s_waitcnt vmcnt(0)" ::: "memory");
        }
    }
    __syncthreads();
}

constexpr int LDS_BYTES = 147456, LDS_MISC = 139264;
constexpr int CW_BAR = 4096;
constexpr int NPHASE = 22;
__global__ void __launch_bounds__(512, 2) mk_fwd(Args args) {
    extern __shared__ __attribute__((aligned(16))) unsigned char lds[];
    Frame F; F.lds = (LAS unsigned char*)lds; F.tid = threadIdx.x; F.lane = F.tid & 63; F.wave = __builtin_amdgcn_readfirstlane(F.tid >> 6); F.nw = 8; F.G = gridDim.x; F.bid = blockIdx.x; F.a = &args;
    const int lo = args.ph_lo, hi = args.ph_hi;
    volatile LAS unsigned* MISC = (volatile LAS unsigned*)(F.lds + LDS_MISC);
    if (F.tid < 64) MISC[F.tid] = 0u;
    __syncthreads();
    XcdBarrier bar; bar.bar = (unsigned*)(args.ws + WS_CTL) + CW_BAR; bar.x = 0; bar.st = MISC + 8;
    if (hi - lo > 1) bar = xcd_barrier_post((unsigned*)(args.ws + WS_CTL) + CW_BAR, MISC + 8);
#define IN(k) (lo <= (k) && (k) < hi)
#define SEAM(k) do { if (IN(k) && IN((k) + 1)) { XcdBarrier b2_ = bar; asm volatile("" : "+s"(b2_.bar)); xcd_barrier(b2_); } } while (0)
#define REP(k) for (int rep_ = 0; rep_ < ((k) == REPEAT_PH ? 2 : 1); ++rep_)
#define FRESH(Fp) Frame Fp = F; { int t_ = threadIdx.x; asm volatile("" : "+v"(t_)); Fp.tid = t_; Fp.lane = t_ & 63; Fp.wave = __builtin_amdgcn_readfirstlane(t_ >> 6); }
    if (IN(0)) REP(0) { FRESH(Fp); phase_prologue(Fp); __syncthreads(); } SEAM(0);
#pragma unroll 1
    for (int l = 0; l < 2; ++l) {
        const int base = 1 + 10 * l;
        if (IN(base + 0)) { FRESH(Fp); phase_norm1(Fp, l); } SEAM(base + 0);
        if (IN(base + 1)) REP(base + 1) { ProbIn p{&args, l}; pg8::gemm_phase(F.lds, p, F.G, F.bid); } SEAM(base + 1);
        if (IN(base + 2)) REP(base + 2) { FRESH(Fp); if (USE_SSD_SEQ) phase_ssd_seq(Fp, l); else phase_ssd_chunked(Fp, l); __syncthreads(); phase_vstats(Fp, l); } SEAM(base + 2);
        if (IN(base + 3)) { { FRESH(Fp); phase_ssdin(Fp, l); } { FRESH(Fp); phase_sgu_mfma(Fp, l); } } SEAM(base + 3);
        if (IN(base + 4)) { { ProbMix<0> p{&args, l}; pg8::gemm_phase(F.lds, p, F.G, F.bid); } { ProbMix<1> p{&args, l}; pg8::gemm_phase(F.lds, p, F.G, F.bid); } } SEAM(base + 4);
        if (IN(base + 5)) { ProbMix<2> p{&args, l}; pg8::gemm_phase(F.lds, p, F.G, F.bid); } SEAM(base + 5);
        if (IN(base + 6)) REP(base + 6) { FRESH(Fp); phase_norm2(Fp, l); } SEAM(base + 6);
        if (IN(base + 7)) REP(base + 7) { FRESH(Fp); phase_topk(Fp, l); } SEAM(base + 7);
        if (IN(base + 8)) REP(base + 8) { ProbMoe<0> p{&args, l}; pg8::gemm_phase(F.lds, p, F.G, F.bid); } SEAM(base + 8);
        if (IN(base + 9)) REP(base + 9) { ProbMoe<1> p{&args, l}; pg8::gemm_phase(F.lds, p, F.G, F.bid); } SEAM(base + 9);
    }
    if (IN(21)) { FRESH(Fp); phase_final(Fp); }
#undef IN
#undef SEAM
#undef FRESH
#undef REP
}

#ifndef USE_SSD_SEQ
#define USE_SSD_SEQ 0
#endif
#ifndef MK_ONE_LAUNCH
#define MK_ONE_LAUNCH 1
#endif
#ifndef STOP_AT
#define STOP_AT 99
#endif
__global__ void k_dump(float* o, size_t base, const unsigned char* src, int mode, size_t n) { for (size_t i = (size_t)blockIdx.x * blockDim.x + threadIdx.x; i < n; i += (size_t)gridDim.x * blockDim.x) {
    float v = mode == 0 ? bf2f(((const bf16*)src)[i]) : (mode == 1 ? ((const float*)src)[i] : (float)((const int*)src)[i]); o[base + i] = v; } }
#ifndef DUMP_SET
#define DUMP_SET 0
#endif
__global__ void k_fill(float* o, size_t n) { for (size_t i = (size_t)blockIdx.x * blockDim.x + threadIdx.x; i < n; i += (size_t)gridDim.x * blockDim.x) o[i] = 0.f; }
extern "C" void kernel_launch(void* const* d_in, const int* in_sizes, int n_in, void* d_out, int out_size, void* d_ws, size_t ws_size, hipStream_t stream) {
    static int grid = 0;
    if (grid == 0) {
        if (n_in != 27 || out_size != NLAT * D || ws_size < WS_END) { fprintf(stderr, "kernel_launch: unexpected shapes (n_in %d, out %d, ws %zu < %zu)\n", n_in, out_size, ws_size, (size_t)WS_END); grid = -1; return; }
        int dev = 0, cus = 0;
        if (hipGetDevice(&dev) != hipSuccess || hipDeviceGetAttribute(&cus, hipDeviceAttributeMultiprocessorCount, dev) != hipSuccess) { grid = -1; return; }
        if (hipFuncSetAttribute((const void*)mk_fwd, hipFuncAttributeMaxDynamicSharedMemorySize, LDS_BYTES) != hipSuccess) { grid = -1; return; }
        if (hipFuncSetAttribute((const void*)k_sgu_naive, hipFuncAttributeMaxDynamicSharedMemorySize, 128 * 128 * 4 + 1024) != hipSuccess) { grid = -1; return; }
        (void)hipGetLastError();
        grid = cus;
    }
    if (grid < 0) return;
    (void)hipMemsetAsync((char*)d_ws + WS_CTL, 0, CTL_ZERO_BYTES, stream);
    Args a{};
    for (int i = 0; i < 27; ++i) a.in[i] = (const float*)d_in[i];
    a.out = (float*)d_out; a.ws = (unsigned char*)d_ws;
    auto run = [&](int lo, int hi) { a.ph_lo = lo; a.ph_hi = hi; hipLaunchKernelGGL(mk_fwd, dim3(grid), dim3(512), LDS_BYTES, stream, a); };
#if MK_ONE_LAUNCH
    run(0, NPHASE);
#else
    for (int ph = 0; ph < NPHASE; ++ph) run(ph, ph + 1);
#endif
}
```
